# Optimizing an MI355X kernel written in HIP

```python
import jax
import jax.numpy as jnp
from jax import lax
import numpy as np

D_MODEL = 1024
BATCH = 4
SEQ = 8192
DEPTH = 1

CHUNK = 64
MIX_WIDTH = D_MODEL
GLA_HEADS = 4
GLA_DV = (MIX_WIDTH // 2) // GLA_HEADS
GLA_DK = GLA_DV // 2
GLA_GATE_RANK = 16
GLA_GATE_NORM = 16.0
RET_HEADS = 4
RET_DV = (MIX_WIDTH // 2) // RET_HEADS
RET_DK = RET_DV // 2
ROPE_BASE = 10000.0
N_EXPERTS = 32
TOP_K = 4
D_FF = D_MODEL
SWIGLU_ALPHA = 1.702
SWIGLU_LIMIT = 7.0
MOE_BLOCK = 256
LN_EPS = 1e-5
MAX_STREAM_OFFSET = 4096
DEEPNORM_ALPHA = (2.0 * DEPTH) ** 0.25
DEEPNORM_BETA = (8.0 * DEPTH) ** -0.25
PROJ_SIZES = (GLA_HEADS * GLA_DK, GLA_HEADS * GLA_DK, GLA_HEADS * GLA_DV, GLA_HEADS * GLA_DV, GLA_GATE_RANK,
              RET_HEADS * RET_DK, RET_HEADS * RET_DK, RET_HEADS * RET_DV, RET_HEADS * RET_DV)
PROJ_WIDTH = sum(PROJ_SIZES)
VALUE_BLOCKS = (2, 7)

kernel_name = 'hybrid_gla_retention_moe_deepnorm'


def layer_norm(x, g, b):
    xf = x.astype(jnp.float32)
    mu = jnp.mean(xf, -1, keepdims=True)
    var = jnp.mean(jnp.square(xf - mu), -1, keepdims=True)
    y = (xf - mu) * lax.rsqrt(var + LN_EPS) * g.astype(jnp.float32) + b.astype(jnp.float32)
    return y.astype(x.dtype)


def split_cols(t, sizes):
    idx = np.cumsum(sizes)[:-1].tolist()
    return jnp.split(t, idx, axis=-1)


def rotary(t, positions):
    half = t.shape[-1] // 2
    inv_freq = 1.0 / (ROPE_BASE ** jnp.linspace(0.0, 1.0, half, dtype=jnp.float32))
    ang = positions.astype(jnp.float32)[:, :, None, None] * inv_freq
    cos, sin = jnp.cos(ang), jnp.sin(ang)
    t1, t2 = t[..., :half], t[..., half:]
    return jnp.concatenate([t1 * cos - t2 * sin, t1 * sin + t2 * cos], axis=-1)


def chunk_decay_linear_attention(q, k, v, log_a):
    bsz, seq, heads, dk = q.shape
    dv = v.shape[-1]
    n = seq // CHUNK
    q = q.reshape(bsz, n, CHUNK, heads, dk)
    k = k.reshape(bsz, n, CHUNK, heads, dk)
    v = v.reshape(bsz, n, CHUNK, heads, dv)
    b = jnp.cumsum(log_a.reshape(bsz, n, CHUNK, heads, dk), axis=2)
    b_last = b[:, :, -1:]
    eb, enb = jnp.exp(b), jnp.exp(-b)
    qe = q * eb
    s_lo = jnp.einsum('bnihd,bnjhd->bnhij', qe, k * enb)
    s_up = jnp.einsum('bnihd,bnjhd->bnhij', q * enb, k * eb)
    lower = jnp.arange(CHUNK)[:, None] >= jnp.arange(CHUNK)[None, :]
    scores = jnp.where(lower, s_lo, s_up)
    o_intra = jnp.einsum('bnhij,bnjhe->bnihe', scores, v)
    kv = jnp.einsum('bnjhd,bnjhe->bnhde', k * jnp.exp(b_last - b), v)
    dec = jnp.exp(b_last[:, :, 0])

    def step(state, inp):
        kv_c, dec_c = inp
        return state * dec_c[..., None] + kv_c, state

    init = jnp.zeros((bsz, heads, dk, dv), jnp.float32)
    _, prev = lax.scan(step, init, (jnp.moveaxis(kv, 1, 0), jnp.moveaxis(dec, 1, 0)))
    prev = jnp.moveaxis(prev, 0, 1)
    o_inter = jnp.einsum('bnihd,bnhde->bnihe', qe, prev)
    return (o_intra + o_inter).reshape(bsz, seq, heads, dv)


def head_rms_norm(o, g):
    o = o * lax.rsqrt(jnp.mean(jnp.square(o), -1, keepdims=True) + LN_EPS)
    return (o * g).reshape(o.shape[0], o.shape[1], -1)


def head_group_norm(o, g, b):
    mu = jnp.mean(o, -1, keepdims=True)
    var = jnp.mean(jnp.square(o - mu), -1, keepdims=True)
    o = ((o - mu) * lax.rsqrt(var + LN_EPS)).reshape(o.shape[0], o.shape[1], -1)
    return o * g + b


def moe_ffn(h, router_w, router_b, w1, b1, w2, b2):
    bsz, seq, d = h.shape
    xt = h.reshape(-1, d)
    t = xt.shape[0]
    tk = t * TOP_K
    logits = (xt @ router_w + router_b).astype(jnp.float32)
    top_val, top_idx = lax.top_k(logits, TOP_K)
    gates = jax.nn.softmax(top_val, axis=-1)
    flat_e = top_idx.reshape(-1).astype(jnp.int32)
    flat_tok = jnp.repeat(jnp.arange(t, dtype=jnp.int32), TOP_K)
    flat_gate = gates.reshape(-1)
    order = jnp.argsort(flat_e)
    sorted_e = flat_e[order]
    counts = jnp.bincount(flat_e, length=N_EXPERTS).astype(jnp.int32)
    padded = ((counts + MOE_BLOCK - 1) // MOE_BLOCK) * MOE_BLOCK
    start_sorted = jnp.cumsum(counts) - counts
    pad_end = jnp.cumsum(padded)
    pad_start = pad_end - padded
    rank = jnp.arange(tk, dtype=jnp.int32) - start_sorted[sorted_e]
    dest = (pad_start[sorted_e] + rank).astype(jnp.int32)
    n_slots = ((tk + MOE_BLOCK - 1) // MOE_BLOCK) * MOE_BLOCK + N_EXPERTS * MOE_BLOCK
    n_blocks = n_slots // MOE_BLOCK
    slot_tok = jnp.zeros((n_slots,), jnp.int32).at[dest].set(flat_tok[order])
    slot_gate = jnp.zeros((n_slots,), jnp.float32).at[dest].set(flat_gate[order])
    block_start = jnp.arange(n_blocks, dtype=jnp.int32) * MOE_BLOCK
    block_expert = jnp.minimum(jnp.searchsorted(pad_end, block_start, side='right'),
                               N_EXPERTS - 1).astype(jnp.int32)

    def expert_block(args):
        tok, e = args
        xb = xt[tok]
        hh = xb @ w1[e] + b1[e]
        x_glu = jnp.minimum(hh[:, :D_FF], SWIGLU_LIMIT)
        x_lin = jnp.clip(hh[:, D_FF:], -SWIGLU_LIMIT, SWIGLU_LIMIT)
        act = x_glu * jax.nn.sigmoid(SWIGLU_ALPHA * x_glu) * (x_lin + 1.0)
        return act @ w2[e] + b2[e]

    y = lax.map(expert_block, (slot_tok.reshape(n_blocks, MOE_BLOCK), block_expert))
    y = y.reshape(n_slots, d) * slot_gate[:, None].astype(y.dtype)
    out = jnp.zeros((t, d), y.dtype).at[slot_tok].add(y)
    return out.reshape(bsz, seq, d)


def setup_inputs(seed: int = 0) -> dict:
    key = jax.random.key(seed)
    ks = jax.random.split(key, 24)
    f32 = jnp.float32

    def nrm(k, shape, scale):
        return jax.random.normal(k, shape, f32) * scale

    x = nrm(ks[0], (BATCH, SEQ, D_MODEL), 1.0)
    offsets = jax.random.randint(ks[1], (BATCH, 1), 0, MAX_STREAM_OFFSET, dtype=jnp.int32)
    positions = (offsets + jnp.arange(SEQ, dtype=jnp.int32)[None, :]).astype(jnp.int32)
    ln_in_g = 1.0 + nrm(ks[2], (D_MODEL,), 0.02)
    ln_in_b = nrm(ks[3], (D_MODEL,), 0.02)
    col_scale = jnp.concatenate([jnp.full((s,), DEEPNORM_BETA if i in VALUE_BLOCKS else 1.0, f32)
                                 for i, s in enumerate(PROJ_SIZES)])
    w_in = nrm(ks[4], (DEPTH, D_MODEL, PROJ_WIDTH), D_MODEL ** -0.5) * col_scale
    gla_gate_w = nrm(ks[5], (DEPTH, GLA_GATE_RANK, GLA_HEADS * GLA_DK), GLA_GATE_RANK ** -0.5)
    gla_gate_b = nrm(ks[6], (DEPTH, GLA_HEADS * GLA_DK), 0.1)
    gla_norm_g = 1.0 + nrm(ks[7], (DEPTH, GLA_DV), 0.02)
    ret_norm_g = 1.0 + nrm(ks[8], (DEPTH, RET_HEADS * RET_DV), 0.02)
    ret_norm_b = nrm(ks[9], (DEPTH, RET_HEADS * RET_DV), 0.02)
    w_out = nrm(ks[10], (DEPTH, MIX_WIDTH, D_MODEL), MIX_WIDTH ** -0.5 * DEEPNORM_BETA)
    ln1_g = 1.0 + nrm(ks[11], (DEPTH, D_MODEL), 0.02)
    ln1_b = nrm(ks[12], (DEPTH, D_MODEL), 0.02)
    router_w = nrm(ks[13], (DEPTH, D_MODEL, N_EXPERTS), D_MODEL ** -0.5)
    router_b = nrm(ks[14], (DEPTH, N_EXPERTS), 0.01)
    moe_w1 = nrm(ks[15], (DEPTH, N_EXPERTS, D_MODEL, 2 * D_FF), D_MODEL ** -0.5 * DEEPNORM_BETA)
    moe_b1 = nrm(ks[16], (DEPTH, N_EXPERTS, 2 * D_FF), 0.02)
    moe_w2 = nrm(ks[17], (DEPTH, N_EXPERTS, D_FF, D_MODEL), D_FF ** -0.5 * DEEPNORM_BETA)
    moe_b2 = nrm(ks[18], (DEPTH, N_EXPERTS, D_MODEL), 0.02)
    ln2_g = 1.0 + nrm(ks[19], (DEPTH, D_MODEL), 0.02)
    ln2_b = nrm(ks[20], (DEPTH, D_MODEL), 0.02)
    return {'x': x, 'positions': positions, 'ln_in_g': ln_in_g, 'ln_in_b': ln_in_b,
            'w_in': w_in, 'gla_gate_w': gla_gate_w, 'gla_gate_b': gla_gate_b,
            'gla_norm_g': gla_norm_g, 'ret_norm_g': ret_norm_g, 'ret_norm_b': ret_norm_b,
            'w_out': w_out, 'ln1_g': ln1_g, 'ln1_b': ln1_b, 'router_w': router_w,
            'router_b': router_b, 'moe_w1': moe_w1, 'moe_b1': moe_b1, 'moe_w2': moe_w2,
            'moe_b2': moe_b2, 'ln2_g': ln2_g, 'ln2_b': ln2_b}


def reference(x, positions, ln_in_g, ln_in_b, w_in, gla_gate_w, gla_gate_b, gla_norm_g,
              ret_norm_g, ret_norm_b, w_out, ln1_g, ln1_b, router_w, router_b,
              moe_w1, moe_b1, moe_w2, moe_b2, ln2_g, ln2_b):
    bsz, seq, _ = x.shape
    f32 = jnp.float32
    log_gamma = jnp.log1p(-jnp.exp2(-5.0 - jnp.arange(RET_HEADS, dtype=f32)))
    h = layer_norm(x, ln_in_g, ln_in_b)
    for l in range(DEPTH):
        proj = (h @ w_in[l]).astype(f32)
        gq, gk, gv, gg, glr, rq, rk, rv, rg = split_cols(proj, PROJ_SIZES)
        q = gq.reshape(bsz, seq, GLA_HEADS, GLA_DK) * GLA_DK ** -0.5
        k = gk.reshape(bsz, seq, GLA_HEADS, GLA_DK)
        v = gv.reshape(bsz, seq, GLA_HEADS, GLA_DV)
        log_a = jax.nn.log_sigmoid(glr @ gla_gate_w[l].astype(f32) + gla_gate_b[l].astype(f32)) / GLA_GATE_NORM
        log_a = log_a.reshape(bsz, seq, GLA_HEADS, GLA_DK)
        o_gla = chunk_decay_linear_attention(q, k, v, log_a)
        o_gla = head_rms_norm(o_gla, gla_norm_g[l].astype(f32)) * jax.nn.silu(gg)
        q = rotary(rq.reshape(bsz, seq, RET_HEADS, RET_DK), positions)
        k = rotary(rk.reshape(bsz, seq, RET_HEADS, RET_DK), positions) * RET_DK ** -0.5
        v = rv.reshape(bsz, seq, RET_HEADS, RET_DV)
        log_d = jnp.broadcast_to(log_gamma[None, None, :, None], q.shape)
        o_ret = chunk_decay_linear_attention(q, k, v, log_d)
        o_ret = head_group_norm(o_ret, ret_norm_g[l].astype(f32), ret_norm_b[l].astype(f32)) * jax.nn.silu(rg)
        mix = jnp.concatenate([o_gla, o_ret], axis=-1).astype(x.dtype) @ w_out[l]
        h = layer_norm(DEEPNORM_ALPHA * h + mix, ln1_g[l], ln1_b[l])
        ffn = moe_ffn(h, router_w[l], router_b[l], moe_w1[l], moe_b1[l], moe_w2[l], moe_b2[l])
        h = layer_norm(DEEPNORM_ALPHA * h + ffn.astype(h.dtype), ln2_g[l], ln2_b[l])
    return h
```

```cpp
#include <hip/hip_runtime.h>
#include <stdint.h>
#include <stdio.h>

namespace {
constexpr int NB = 4, SEQ = 8192, D = 1024, M = NB * SEQ, CH = 64, NCH = SEQ / CH;
constexpr int PW = 3088, NE = 32, DFF = 1024;
constexpr float LN_EPS = 1e-5f;
constexpr float ALPHA = 1.189207115002721f;
constexpr size_t MiB = 1u << 20;
constexpr size_t WS_CTL = 0, WS_STATS0 = 1 * MiB, WS_H0B = 2 * MiB, WS_P = 66 * MiB, WS_PROJ = 452 * MiB;
constexpr size_t WS_ORAW = 66 * MiB, WS_MIXED = 194 * MiB, WS_P2 = 258 * MiB;
constexpr size_t WS_H1F = 648 * MiB, WS_H1B = 776 * MiB, WS_LIST = 840 * MiB, WS_GATES = 844 * MiB;
constexpr size_t WS_XS = 66 * MiB, WS_ACT = 338 * MiB, WS_Y = 66 * MiB, WS_END = 848 * MiB;
constexpr size_t PJ_GQ = 0, PJ_GK = 16 * MiB, PJ_GV = 32 * MiB, PJ_GG = 64 * MiB, PJ_RQ = 96 * MiB, PJ_RK = 112 * MiB, PJ_RV = 128 * MiB, PJ_RG = 160 * MiB, PJ_GLR = 192 * MiB;
constexpr int MAXSLOT = M * 4 + NE * 256;

typedef unsigned short bf16;
__device__ __forceinline__ bf16 f2bf(float f) { unsigned u = __builtin_bit_cast(unsigned, f); return (bf16)((u + 0x7fffu + ((u >> 16) & 1u)) >> 16); }
__device__ __forceinline__ float bf2f(bf16 h) { return __builtin_bit_cast(float, (unsigned)h << 16); }
__device__ __forceinline__ float wave_sum(float v) {
#pragma unroll
    for (int o = 1; o < 64; o <<= 1) v += __shfl_xor(v, o);
    return v;
}

__global__ void __launch_bounds__(256) k_ln0(const float* __restrict__ x, const float* __restrict__ g, const float* __restrict__ b, bf16* __restrict__ h0b, float* __restrict__ stats) {
    const int row = blockIdx.x * 4 + (threadIdx.x >> 6), lane = threadIdx.x & 63;
    const float* xr = x + (size_t)row * D;
    float v[16]; float s = 0.f;
#pragma unroll
    for (int j = 0; j < 4; ++j) { const float4 t = *(const float4*)(xr + 4 * lane + 256 * j); v[4 * j] = t.x; v[4 * j + 1] = t.y; v[4 * j + 2] = t.z; v[4 * j + 3] = t.w; s += (t.x + t.y) + (t.z + t.w); }
    const float mean = wave_sum(s) * (1.f / D); float q = 0.f;
#pragma unroll
    for (int i = 0; i < 16; ++i) { const float d = v[i] - mean; q += d * d; }
    const float rstd = 1.0f / sqrtf(wave_sum(q) * (1.f / D) + LN_EPS);
    if (lane == 0) { stats[2 * row] = mean; stats[2 * row + 1] = rstd; }
#pragma unroll
    for (int j = 0; j < 4; ++j)
#pragma unroll
        for (int i = 0; i < 4; ++i) { const int c = 4 * lane + 256 * j + i; h0b[(size_t)row * D + c] = f2bf((v[4 * j + i] - mean) * rstd * g[c] + b[c]); }
}

__global__ void __launch_bounds__(256) k_gemm_naive(const bf16* __restrict__ A, const float* __restrict__ W, float* __restrict__ C, int N, int K) {
    __shared__ float As[32][68];
    const int n = blockIdx.x * 256 + threadIdx.x, r0 = blockIdx.y * 32;
    float acc[32];
#pragma unroll
    for (int r = 0; r < 32; ++r) acc[r] = 0.f;
    for (int k0 = 0; k0 < K; k0 += 64) {
        __syncthreads();
        for (int i = threadIdx.x; i < 32 * 64; i += 256) { const int r = i >> 6, k = i & 63; As[r][k] = bf2f(A[(size_t)(r0 + r) * K + k0 + k]); }
        __syncthreads();
        if (n < N) {
            for (int k = 0; k < 64; k += 4) {
                const float w0 = W[(size_t)(k0 + k) * N + n], w1 = W[(size_t)(k0 + k + 1) * N + n], w2 = W[(size_t)(k0 + k + 2) * N + n], w3 = W[(size_t)(k0 + k + 3) * N + n];
#pragma unroll
                for (int r = 0; r < 32; ++r) { const float4 a = *(const float4*)&As[r][k]; acc[r] += a.x * w0 + a.y * w1 + a.z * w2 + a.w * w3; }
            }
        }
    }
    if (n < N) {
#pragma unroll
        for (int r = 0; r < 32; ++r) C[(size_t)(r0 + r) * N + n] = acc[r];
    }
}

__global__ void __launch_bounds__(256) k_proj_post(const float* __restrict__ P, const int* __restrict__ positions, unsigned char* __restrict__ pj) {
    const int t = blockIdx.x, tid = threadIdx.x;
    const float* p = P + (size_t)t * PW;
    bf16* GQ = (bf16*)(pj + PJ_GQ) + (size_t)t * 256; bf16* GK = (bf16*)(pj + PJ_GK) + (size_t)t * 256;
    bf16* GV = (bf16*)(pj + PJ_GV) + (size_t)t * 512; bf16* GG = (bf16*)(pj + PJ_GG) + (size_t)t * 512;
    bf16* RQ = (bf16*)(pj + PJ_RQ) + (size_t)t * 256; bf16* RK = (bf16*)(pj + PJ_RK) + (size_t)t * 256;
    bf16* RV = (bf16*)(pj + PJ_RV) + (size_t)t * 512; bf16* RG = (bf16*)(pj + PJ_RG) + (size_t)t * 512;
    float* GLR = (float*)(pj + PJ_GLR) + (size_t)t * 16;
    GQ[tid] = f2bf(p[tid] * 0.125f); GK[tid] = f2bf(p[256 + tid]);
    for (int c = tid; c < 512; c += 256) { GV[c] = f2bf(p[512 + c]); GG[c] = f2bf(p[1024 + c]); RV[c] = f2bf(p[2064 + c]); RG[c] = f2bf(p[2576 + c]); }
    if (tid < 16) GLR[tid] = p[1536 + tid];
    if (tid < 128) {
        const int h = tid >> 5, i = tid & 31;
        const double inv = pow(10000.0, -(double)i / 31.0);
        const double ang = (double)positions[t] * inv;
        const float c = (float)cos(ang), s = (float)sin(ang);
        const float q1 = p[1552 + h * 64 + i], q2 = p[1552 + h * 64 + 32 + i];
        RQ[h * 64 + i] = f2bf(q1 * c - q2 * s); RQ[h * 64 + 32 + i] = f2bf(q1 * s + q2 * c);
        const float k1 = p[1808 + h * 64 + i], k2 = p[1808 + h * 64 + 32 + i];
        RK[h * 64 + i] = f2bf((k1 * c - k2 * s) * 0.125f); RK[h * 64 + 32 + i] = f2bf((k1 * s + k2 * c) * 0.125f);
    }
}

__global__ void __launch_bounds__(256) k_mixer_naive(const unsigned char* __restrict__ pj, const float* __restrict__ gate_w, const float* __restrict__ gate_b, float* __restrict__ oraw) {
    __shared__ float q[64][65], k[64][65], bb[64][65], v[64][17], sc[64][65], st[64][17], glr[64][16];
    const int es = blockIdx.x, h8 = blockIdx.y, b = blockIdx.z, tid = threadIdx.x;
    const bool gla = h8 < 4; const int h = h8 & 3;
    const bf16* Q = (const bf16*)(pj + (gla ? PJ_GQ : PJ_RQ)); const bf16* K = (const bf16*)(pj + (gla ? PJ_GK : PJ_RK)); const bf16* V = (const bf16*)(pj + (gla ? PJ_GV : PJ_RV));
    const float* GLR = (const float*)(pj + PJ_GLR);
    const float log_gamma = log1pf(-exp2f(-5.0f - (float)h));
    for (int i = tid; i < 64 * 16; i += 256) st[i >> 4][i & 15] = 0.f;
    for (int c = 0; c < NCH; ++c) {
        const size_t t0 = (size_t)b * SEQ + (size_t)c * CH;
        __syncthreads();
        for (int i = tid; i < 4096; i += 256) { const int j = i >> 6, d = i & 63; q[j][d] = bf2f(Q[(t0 + j) * 256 + h * 64 + d]); k[j][d] = bf2f(K[(t0 + j) * 256 + h * 64 + d]); }
        for (int i = tid; i < 1024; i += 256) { const int j = i >> 4, e = i & 15; v[j][e] = bf2f(V[(t0 + j) * 512 + h * 128 + es * 16 + e]); }
        if (gla) for (int i = tid; i < 1024; i += 256) glr[i >> 4][i & 15] = GLR[(t0 + (i >> 4)) * 16 + (i & 15)];
        __syncthreads();
        for (int i = tid; i < 4096; i += 256) { const int j = i >> 6, d = i & 63; float la;
            if (gla) { float z = gate_b[h * 64 + d];
                for (int r = 0; r < 16; ++r) z += glr[j][r] * gate_w[r * 256 + h * 64 + d];
                const float ls = fminf(z, 0.f) - log1pf(expf(-fabsf(z)));
                la = ls * (1.0f / 16.0f);
            } else la = log_gamma;
            bb[j][d] = la; }
        __syncthreads();
        if (tid < 64) { float s = 0.f; for (int j = 0; j < 64; ++j) { s += bb[j][tid]; bb[j][tid] = s; } }
        __syncthreads();
        for (int i = tid; i < 4096; i += 256) { const int ii = i >> 6, jj = i & 63; float s = 0.f;
            for (int d = 0; d < 64; ++d) s += q[ii][d] * k[jj][d] * expf(-fabsf(bb[ii][d] - bb[jj][d]));
            sc[ii][jj] = s; }
        __syncthreads();
        for (int i = tid; i < 1024; i += 256) { const int ii = i >> 4, e = i & 15; float o = 0.f;
            for (int j = 0; j < 64; ++j) o += sc[ii][j] * v[j][e];
            for (int d = 0; d < 64; ++d) o += q[ii][d] * expf(bb[ii][d]) * st[d][e];
            oraw[(t0 + ii) * 1024 + h8 * 128 + es * 16 + e] = o; }
        __syncthreads();
        for (int i = tid; i < 1024; i += 256) { const int d = i >> 4, e = i & 15; float s = st[d][e] * expf(bb[63][d]);
            for (int j = 0; j < 64; ++j) s += k[j][d] * expf(bb[63][d] - bb[j][d]) * v[j][e];
            st[d][e] = s; }
    }
}

__global__ void __launch_bounds__(256) k_norm_gate(const float* __restrict__ oraw, const unsigned char* __restrict__ pj, const float* __restrict__ gla_g, const float* __restrict__ ret_g, const float* __restrict__ ret_b, bf16* __restrict__ mixed) {
    const int t = blockIdx.x, tid = threadIdx.x, h8 = tid >> 5, l = tid & 31;
    const bf16* GG = (const bf16*)(pj + PJ_GG) + (size_t)t * 512; const bf16* RG = (const bf16*)(pj + PJ_RG) + (size_t)t * 512;
    float o[4]; float s = 0.f;
#pragma unroll
    for (int i = 0; i < 4; ++i) { o[i] = oraw[(size_t)t * 1024 + h8 * 128 + l + 32 * i]; s += o[i]; }
    if (h8 < 4) {
        float ss = 0.f;
#pragma unroll
        for (int i = 0; i < 4; ++i) ss += o[i] * o[i];
#pragma unroll
        for (int m = 1; m < 32; m <<= 1) ss += __shfl_xor(ss, m);
        const float r = 1.0f / sqrtf(ss * (1.f / 128.f) + LN_EPS);
#pragma unroll
        for (int i = 0; i < 4; ++i) { const int e = l + 32 * i; const float gt = bf2f(GG[h8 * 128 + e]); const float sl = gt / (1.f + expf(-gt));
            mixed[(size_t)t * 1024 + h8 * 128 + e] = f2bf(o[i] * r * gla_g[e] * sl); }
    } else {
        const int h = h8 - 4;
#pragma unroll
        for (int m = 1; m < 32; m <<= 1) s += __shfl_xor(s, m);
        const float mu = s * (1.f / 128.f); float ss = 0.f;
#pragma unroll
        for (int i = 0; i < 4; ++i) { const float d = o[i] - mu; ss += d * d; }
#pragma unroll
        for (int m = 1; m < 32; m <<= 1) ss += __shfl_xor(ss, m);
        const float r = 1.0f / sqrtf(ss * (1.f / 128.f) + LN_EPS);
#pragma unroll
        for (int i = 0; i < 4; ++i) { const int e = l + 32 * i; const float gt = bf2f(RG[h * 128 + e]); const float sl = gt / (1.f + expf(-gt));
            mixed[(size_t)t * 1024 + 512 + h * 128 + e] = f2bf(((o[i] - mu) * r * ret_g[h * 128 + e] + ret_b[h * 128 + e]) * sl); }
    }
}

__global__ void __launch_bounds__(256) k_ln1_route(const float* __restrict__ x, const float* __restrict__ stats0, const float* __restrict__ g0, const float* __restrict__ b0,
                                                   const float* __restrict__ mixp, const float* __restrict__ g1, const float* __restrict__ b1,
                                                   const float* __restrict__ rw, const float* __restrict__ rb,
                                                   float* __restrict__ h1f, bf16* __restrict__ h1b, float* __restrict__ gates, int* __restrict__ list, unsigned* __restrict__ counts) {
    const int row = blockIdx.x * 4 + (threadIdx.x >> 6), lane = threadIdx.x & 63;
    const float mean0 = stats0[2 * row], rstd0 = stats0[2 * row + 1];
    float v[16]; float s = 0.f;
#pragma unroll
    for (int j = 0; j < 4; ++j)
#pragma unroll
        for (int i = 0; i < 4; ++i) { const int c = 4 * lane + 256 * j + i; const float h0 = (x[(size_t)row * D + c] - mean0) * rstd0 * g0[c] + b0[c];
            v[4 * j + i] = ALPHA * h0 + mixp[(size_t)row * D + c]; s += v[4 * j + i]; }
    const float mean = wave_sum(s) * (1.f / D); float q = 0.f;
#pragma unroll
    for (int i = 0; i < 16; ++i) { const float d = v[i] - mean; q += d * d; }
    const float rstd = 1.0f / sqrtf(wave_sum(q) * (1.f / D) + LN_EPS);
#pragma unroll
    for (int j = 0; j < 4; ++j)
#pragma unroll
        for (int i = 0; i < 4; ++i) { const int c = 4 * lane + 256 * j + i; const float h = (v[4 * j + i] - mean) * rstd * g1[c] + b1[c]; v[4 * j + i] = h;
            h1f[(size_t)row * D + c] = h; h1b[(size_t)row * D + c] = f2bf(h); }
    float mylogit = -1e30f;
    for (int e = 0; e < NE; ++e) { float p = 0.f;
#pragma unroll
        for (int j = 0; j < 4; ++j)
#pragma unroll
            for (int i = 0; i < 4; ++i) { const int c = 4 * lane + 256 * j + i; p += v[4 * j + i] * rw[c * NE + e]; }
        p = wave_sum(p) + rb[e];
        if (lane == e) mylogit = p; }
    float tv[4]; int ti[4]; float cur = mylogit;
#pragma unroll
    for (int k = 0; k < 4; ++k) { float m = cur; int idx = lane;
#pragma unroll
        for (int o = 1; o < 64; o <<= 1) { const float om = __shfl_xor(m, o); const int oi = __shfl_xor(idx, o); if (om > m || (om == m && oi < idx)) { m = om; idx = oi; } }
        tv[k] = m; ti[k] = idx; if (lane == idx) cur = -1e30f; }
    const float e0 = 1.f, e1 = expf(tv[1] - tv[0]), e2 = expf(tv[2] - tv[0]), e3 = expf(tv[3] - tv[0]);
    const float inv = 1.f / (e0 + e1 + e2 + e3);
    if (lane < 4) { const float gk = (lane == 0 ? e0 : lane == 1 ? e1 : lane == 2 ? e2 : e3) * inv; const int ek = (lane == 0 ? ti[0] : lane == 1 ? ti[1] : lane == 2 ? ti[2] : ti[3]);
        gates[row * 4 + lane] = gk;
        const unsigned pos = atomicAdd(&counts[ek], 1u);
        list[(size_t)ek * M + pos] = row * 4 + lane; }
}

__device__ __forceinline__ void expert_of_tile256(const unsigned* counts, int tile, int& e, int& local) {
    int acc = 0; e = -1; local = 0;
    for (int i = 0; i < NE; ++i) { const int nt = (int)((counts[i] + 255u) >> 8); if (tile < acc + nt) { e = i; local = tile - acc; return; } acc += nt; }
}

__global__ void __launch_bounds__(256) k_moe_gather(const bf16* __restrict__ h1b, const int* __restrict__ list, const unsigned* __restrict__ counts, bf16* __restrict__ xs) {
    const int g = blockIdx.x, tile = g >> 3; int e, local; expert_of_tile256(counts, tile, e, local);
    if (e < 0) return;
    const int cnt = (int)counts[e];
    for (int r = 0; r < 32; ++r) { const int lr = local * 256 + (g & 7) * 32 + r; const size_t slot = (size_t)tile * 256 + (g & 7) * 32 + r;
        uint2* dst = (uint2*)(xs + slot * D) + threadIdx.x;
        if (lr < cnt) { const int tok = list[(size_t)e * M + lr] >> 2; *dst = *((const uint2*)(h1b + (size_t)tok * D) + threadIdx.x); }
        else *dst = make_uint2(0u, 0u); }
}

__global__ void __launch_bounds__(256) k_moe1_naive(const bf16* __restrict__ xs, const float* __restrict__ w1, const float* __restrict__ b1, const unsigned* __restrict__ counts, bf16* __restrict__ act) {
    __shared__ float As[32][68];
    const int g = blockIdx.y, tile = g >> 3; int e, local; expert_of_tile256(counts, tile, e, local);
    if (e < 0) return;
    const int n = blockIdx.x * 256 + threadIdx.x; const size_t r0 = (size_t)tile * 256 + (g & 7) * 32;
    const float* W = w1 + (size_t)e * D * 2 * DFF;
    float ag[32], al[32];
#pragma unroll
    for (int r = 0; r < 32; ++r) { ag[r] = 0.f; al[r] = 0.f; }
    for (int k0 = 0; k0 < D; k0 += 64) {
        __syncthreads();
        for (int i = threadIdx.x; i < 32 * 64; i += 256) { const int r = i >> 6, k = i & 63; As[r][k] = bf2f(xs[(r0 + r) * D + k0 + k]); }
        __syncthreads();
        for (int k = 0; k < 64; ++k) { const float wg = W[(size_t)(k0 + k) * 2 * DFF + n], wl = W[(size_t)(k0 + k) * 2 * DFF + DFF + n];
#pragma unroll
            for (int r = 0; r < 32; ++r) { const float a = As[r][k]; ag[r] += a * wg; al[r] += a * wl; } }
    }
    const float bg = b1[e * 2 * DFF + n], bl = b1[e * 2 * DFF + DFF + n];
#pragma unroll
    for (int r = 0; r < 32; ++r) { const float xg = fminf(ag[r] + bg, 7.0f); const float xl = fminf(fmaxf(al[r] + bl, -7.0f), 7.0f);
        const float a = xg / (1.f + expf(-1.702f * xg)) * (xl + 1.0f);
        act[(r0 + r) * DFF + n] = f2bf(a); }
}

__global__ void __launch_bounds__(256) k_moe2_naive(const bf16* __restrict__ act, const float* __restrict__ w2, const float* __restrict__ b2, const unsigned* __restrict__ counts, const int* __restrict__ list, const float* __restrict__ gates, bf16* __restrict__ Y) {
    __shared__ float As[32][68];
    const int g = blockIdx.y, tile = g >> 3; int e, local; expert_of_tile256(counts, tile, e, local);
    if (e < 0) return;
    const int n = blockIdx.x * 256 + threadIdx.x; const size_t r0 = (size_t)tile * 256 + (g & 7) * 32; const int lr0 = local * 256 + (g & 7) * 32;
    const float* W = w2 + (size_t)e * DFF * D; const int cnt = (int)counts[e];
    if (lr0 >= cnt) return;
    float acc[32];
#pragma unroll
    for (int r = 0; r < 32; ++r) acc[r] = 0.f;
    for (int k0 = 0; k0 < DFF; k0 += 64) {
        __syncthreads();
        for (int i = threadIdx.x; i < 32 * 64; i += 256) { const int r = i >> 6, k = i & 63; As[r][k] = bf2f(act[(r0 + r) * DFF + k0 + k]); }
        __syncthreads();
        for (int k = 0; k < 64; ++k) { const float w = W[(size_t)(k0 + k) * D + n];
#pragma unroll
            for (int r = 0; r < 32; ++r) acc[r] += As[r][k] * w; }
    }
    const float bb = b2[e * D + n];
#pragma unroll
    for (int r = 0; r < 32; ++r) if (lr0 + r < cnt) { const int tk = list[(size_t)e * M + lr0 + r]; Y[(size_t)tk * D + n] = f2bf((acc[r] + bb) * gates[tk]); }
}

__global__ void __launch_bounds__(256) k_final(const float* __restrict__ h1f, const bf16* __restrict__ Y, const float* __restrict__ g2, const float* __restrict__ b2, float* __restrict__ out) {
    const int row = blockIdx.x * 4 + (threadIdx.x >> 6), lane = threadIdx.x & 63;
    float v[16]; float s = 0.f;
#pragma unroll
    for (int j = 0; j < 4; ++j)
#pragma unroll
        for (int i = 0; i < 4; ++i) { const int c = 4 * lane + 256 * j + i; float f = 0.f;
#pragma unroll
            for (int k = 0; k < 4; ++k) f += bf2f(Y[((size_t)row * 4 + k) * D + c]);
            v[4 * j + i] = ALPHA * h1f[(size_t)row * D + c] + f; s += v[4 * j + i]; }
    const float mean = wave_sum(s) * (1.f / D); float q = 0.f;
#pragma unroll
    for (int i = 0; i < 16; ++i) { const float d = v[i] - mean; q += d * d; }
    const float rstd = 1.0f / sqrtf(wave_sum(q) * (1.f / D) + LN_EPS);
#pragma unroll
    for (int j = 0; j < 4; ++j)
#pragma unroll
        for (int i = 0; i < 4; ++i) { const int c = 4 * lane + 256 * j + i; out[(size_t)row * D + c] = (v[4 * j + i] - mean) * rstd * g2[c] + b2[c]; }
}
}

extern "C" void kernel_launch(void* const* d_in, const int* in_sizes, int n_in, void* d_out, int out_size, void* d_ws, size_t ws_size, hipStream_t stream) {
    if (n_in != 21 || ws_size < WS_END) { fprintf(stderr, "kernel_launch: unexpected n_in %d / ws_size %zu\n", n_in, ws_size); return; }
    const float* x = (const float*)d_in[0]; const int* positions = (const int*)d_in[1];
    const float* ln_in_g = (const float*)d_in[2]; const float* ln_in_b = (const float*)d_in[3];
    const float* w_in = (const float*)d_in[4]; const float* gate_w = (const float*)d_in[5]; const float* gate_b = (const float*)d_in[6];
    const float* gla_g = (const float*)d_in[7]; const float* ret_g = (const float*)d_in[8]; const float* ret_b = (const float*)d_in[9];
    const float* w_out = (const float*)d_in[10]; const float* ln1_g = (const float*)d_in[11]; const float* ln1_b = (const float*)d_in[12];
    const float* router_w = (const float*)d_in[13]; const float* router_b = (const float*)d_in[14];
    const float* w1 = (const float*)d_in[15]; const float* b1 = (const float*)d_in[16]; const float* w2 = (const float*)d_in[17]; const float* b2 = (const float*)d_in[18];
    const float* ln2_g = (const float*)d_in[19]; const float* ln2_b = (const float*)d_in[20];
    unsigned char* ws = (unsigned char*)d_ws;
    hipMemsetAsync(ws + WS_CTL, 0, 4096, stream);
    unsigned* counts = (unsigned*)(ws + WS_CTL);
    float* stats0 = (float*)(ws + WS_STATS0); bf16* h0b = (bf16*)(ws + WS_H0B); float* P = (float*)(ws + WS_P); unsigned char* pj = ws + WS_PROJ;
    float* oraw = (float*)(ws + WS_ORAW); bf16* mixed = (bf16*)(ws + WS_MIXED); float* P2 = (float*)(ws + WS_P2);
    float* h1f = (float*)(ws + WS_H1F); bf16* h1b = (bf16*)(ws + WS_H1B); int* list = (int*)(ws + WS_LIST); float* gates = (float*)(ws + WS_GATES);
    bf16* xs = (bf16*)(ws + WS_XS); bf16* act = (bf16*)(ws + WS_ACT); bf16* Y = (bf16*)(ws + WS_Y);
    k_ln0<<<M / 4, 256, 0, stream>>>(x, ln_in_g, ln_in_b, h0b, stats0);
    k_gemm_naive<<<dim3((PW + 255) / 256, M / 32), 256, 0, stream>>>(h0b, w_in, P, PW, D);
    k_proj_post<<<M, 256, 0, stream>>>(P, positions, pj);
    k_mixer_naive<<<dim3(8, 8, NB), 256, 0, stream>>>(pj, gate_w, gate_b, oraw);
    k_norm_gate<<<M, 256, 0, stream>>>(oraw, pj, gla_g, ret_g, ret_b, mixed);
    k_gemm_naive<<<dim3(D / 256, M / 32), 256, 0, stream>>>(mixed, w_out, P2, D, D);
    k_ln1_route<<<M / 4, 256, 0, stream>>>(x, stats0, ln_in_g, ln_in_b, P2, ln1_g, ln1_b, router_w, router_b, h1f, h1b, gates, list, counts);
    k_moe_gather<<<MAXSLOT / 32, 256, 0, stream>>>(h1b, list, counts, xs);
    k_moe1_naive<<<dim3(DFF / 256, MAXSLOT / 32), 256, 0, stream>>>(xs, w1, b1, counts, act);
    k_moe2_naive<<<dim3(D / 256, MAXSLOT / 32), 256, 0, stream>>>(act, w2, b2, counts, list, gates, Y);
    k_final<<<M / 4, 256, 0, stream>>>(h1f, Y, ln2_g, ln2_b, (float*)d_out);
}
```

```cpp
#include <hip/hip_runtime.h>
#include <cstdio>
#include <cstdint>

#ifndef MK_N_LAUNCHES
#define MK_N_LAUNCHES 1
#endif

constexpr int NB = 4, SEQ = 8192, D = 1024, M = NB * SEQ, CH = 64, NCH = SEQ / CH;
constexpr int PW = 3088, NE = 32, DFF = 1024;
constexpr int NPROJ_T = 12;
constexpr float LN_EPS = 1e-5f;
constexpr float ALPHA = 1.189207115002721f;
constexpr int MAXTILES = (M * 4) / 256 + NE;
constexpr int NITEM = NB * 8 * NCH;
constexpr float QS_H1 = 16.0f, QS_W = 256.0f, QS_ACT = 4.0f, QS_Y = 64.0f;
__device__ __forceinline__ float clamp448(float v) { return __builtin_fminf(__builtin_fmaxf(v, -448.0f), 448.0f); }
__device__ __forceinline__ unsigned pk4_fp8(float a, float b, float c, float d) {
    int w = __builtin_amdgcn_cvt_pk_fp8_f32(clamp448(a), clamp448(b), 0, false); w = __builtin_amdgcn_cvt_pk_fp8_f32(clamp448(c), clamp448(d), w, true); return (unsigned)w; }

namespace pg8 {
#define PG8_LAS __attribute__((address_space(3)))
typedef unsigned short bf16_t;
typedef short bf16x8 __attribute__((ext_vector_type(8)));
typedef float f32x4 __attribute__((ext_vector_type(4)));
typedef unsigned u32x4 __attribute__((ext_vector_type(4)));
typedef int i32x4 __attribute__((ext_vector_type(4)));
typedef int i32x8 __attribute__((ext_vector_type(8)));
__device__ __forceinline__ i32x8 cat8(bf16x8 lo, bf16x8 hi) { return __builtin_shufflevector(__builtin_bit_cast(i32x4, lo), __builtin_bit_cast(i32x4, hi), 0, 1, 2, 3, 4, 5, 6, 7); }
constexpr int BM = 256, BK = 64, HALF = 128, HTB = HALF * BK * 2  , STAGE_BYTES = 8 * HTB, NXCD = 8, WGM = 8;

__host__ __device__ __forceinline__ int lds_byte(int r, int c) { const int st = (r >> 4) * 2 + (c >> 5), rr = r & 15, cc = c & 31, ob = rr * 64 + cc * 2; return st * 1024 + (ob ^ (((ob >> 9) & 1) << 5)); }
__host__ __device__ __forceinline__ void stage_rc(int b, int& R, int& C) { const int st = b / 1024, sb = b % 1024, swz = sb ^ (((sb >> 9) & 1) << 5); R = (st >> 1) * 16 + swz / 64; C = (st & 1) * 32 + (swz % 64) / 2; }
__host__ __device__ __forceinline__ int perm32(int rho) { const int n = rho >> 4, i = rho & 15; return 8 * (i >> 2) + 4 * n + (i & 3); }

struct Unit { int pm, pn, e, lt, ui; };
struct Gemm { const bf16_t* A; const bf16_t* Bt; int M, N, K; const PG8_LAS unsigned* gtab; };

struct StaticOrder {
    int nM, nN, nwg, G, c;
    __host__ __device__ void init(int M, int N, int G_, int c_) { nM = M / BM; nN = N / BM; nwg = nM * nN; G = G_; c = c_; }
    __host__ __device__ bool next(int i, Unit& u) const {
        const int L = i * G + c; if (L >= nwg) return false;
        int wgid = L; { const int q = nwg / NXCD, r = nwg % NXCD, xcd = wgid % NXCD, off = wgid / NXCD; wgid = (xcd < r ? xcd * (q + 1) : r * (q + 1) + (xcd - r) * q) + off; }
        const int nig = WGM * nN, gid = wgid / nig, fm = gid * WGM, gsz = (nM - fm) < WGM ? (nM - fm) : WGM;
        u.pm = fm + ((wgid % nig) % gsz); u.pn = (wgid % nig) / gsz; u.e = 0; u.lt = 0; u.ui = i; return true;
    }
    __device__ __forceinline__ void a_ready(const Unit&) const {}
    __device__ __forceinline__ void done(const Unit&) const {}
};


struct GroupedOrder {
    StaticOrder so; const PG8_LAS int* tstart; int nN;
    __device__ __forceinline__ void init(int total_tiles, int nN_, int G_, int c_, const PG8_LAS int* ts) { so.init(total_tiles * BM, nN_ * BM, G_, c_); nN = nN_; tstart = ts; }
    __device__ __forceinline__ bool next(int i, Unit& u) const {
        if (!so.next(i, u)) return false;
        int e = 0;
#pragma unroll
        for (int k = 1; k < 32; ++k) e += (u.pm >= tstart[k]) ? 1 : 0;
        e = __builtin_amdgcn_readfirstlane(e);
        u.e = e; u.lt = u.pm - __builtin_amdgcn_readfirstlane(tstart[e]); u.pn = e * nN + u.pn; return true;
    }
    __device__ __forceinline__ void a_ready(const Unit&) const {}
    __device__ __forceinline__ void done(const Unit&) const {}
};

struct RowMajorOrder {
    const PG8_LAS int* tstart; int nN, ntiles, G, vcu;
    __device__ __forceinline__ void init(int total_tiles, int nN_, int G_, int vcu_, const PG8_LAS int* ts) { ntiles = total_tiles; nN = nN_; G = G_; vcu = vcu_; tstart = ts; }
    __device__ __forceinline__ bool next(int i, Unit& u) const {
        const int full = ntiles / G;
        int pm, j;
        if (i < full * nN) { pm = vcu + G * (i / nN); j = i % nN; }
        else { const int r = (i - full * nN) * G + vcu; pm = full * G + r / nN; j = r % nN; if (pm >= ntiles) return false; }
        int e = 0;
#pragma unroll
        for (int k = 1; k < 32; ++k) e += (pm >= tstart[k]) ? 1 : 0;
        e = __builtin_amdgcn_readfirstlane(e);
        u.pm = pm; u.e = e; u.lt = pm - __builtin_amdgcn_readfirstlane(tstart[e]); u.pn = e * nN + j; u.ui = i; return true;
    }
    __device__ __forceinline__ void a_ready(const Unit&) const {}
    __device__ __forceinline__ void done(const Unit&) const {}
};

__device__ __forceinline__ unsigned cvt_pk_bf16(float lo, float hi) { unsigned r; asm volatile("v_cvt_pk_bf16_f32 %0, %1, %2" : "=v"(r) : "v"(lo), "v"(hi)); return r; }
__device__ __forceinline__ u32x4 pack8(const f32x4 a, const f32x4 b) { u32x4 w; w.x = cvt_pk_bf16(a[0], a[1]); w.y = cvt_pk_bf16(a[2], a[3]); w.z = cvt_pk_bf16(b[0], b[1]); w.w = cvt_pk_bf16(b[2], b[3]); return w; }


typedef float f2 __attribute__((ext_vector_type(2)));
struct NoPre {};
struct NoSeed {};
#define PG8_ZERO_ACC(acc) do { _Pragma("unroll") for (int a_ = 0; a_ < 2; ++a_) _Pragma("unroll") for (int b_ = 0; b_ < 2; ++b_) _Pragma("unroll") for (int m_ = 0; m_ < 4; ++m_) _Pragma("unroll") for (int n_ = 0; n_ < 2; ++n_) acc[a_][b_][m_][n_] = (f32x4){0.f, 0.f, 0.f, 0.f}; } while (0)
struct EpiProj {
    static constexpr bool PERM = true, AFTER_DRAIN = false; static constexpr int NST = 16;     typedef NoPre Pre; typedef NoSeed Seed;
    __device__ __forceinline__ void seed_load(Seed&, const Unit&, int, int, int, int) const {}
    __device__ __forceinline__ void seed_acc(f32x4 (&acc)[2][2][4][2], const Seed&) const { PG8_ZERO_ACC(acc); }
    __device__ __forceinline__ void prefetch(Pre&, const Unit&, int, int, int, int) const {}
    bf16_t *GQ, *GK, *GV, *GG, *RQ, *RK, *RV, *RG; float* GLR; const float* cosT; const float* sinT;
    __device__ __forceinline__ void operator()(const f32x4 (&acc)[2][2][4][2], const Unit& u, int wr, int wc, int fr, int fq, const Pre& pre) const {
        asm volatile("" : "+v"(fr), "+v"(fq));
        const int row0 = u.pm * BM + wr * 64 + fr; const int t = u.pn;
        if (t == 6 || t == 7) {
            bf16_t* O = (t == 6) ? RQ : RK; const float sc = (t == 6) ? 1.0f : 0.125f;
#pragma unroll
            for (int ai = 0; ai < 2; ++ai)
#pragma unroll
                for (int m = 0; m < 4; ++m) { const int row = row0 + ai * HALF + m * 16;
                    const f32x4 c0 = *(const f32x4*)(cosT + (size_t)row * 32 + 8 * fq), c1 = *(const f32x4*)(cosT + (size_t)row * 32 + 8 * fq + 4);
                    const f32x4 s0 = *(const f32x4*)(sinT + (size_t)row * 32 + 8 * fq), s1 = *(const f32x4*)(sinT + (size_t)row * 32 + 8 * fq + 4);
                    const f32x4 a0 = acc[ai][0][m][0], a1 = acc[ai][0][m][1], b0 = acc[ai][1][m][0], b1 = acc[ai][1][m][1];
                    const f32x4 o10 = (a0 * c0 - b0 * s0) * sc, o11 = (a1 * c1 - b1 * s1) * sc, o20 = (a0 * s0 + b0 * c0) * sc, o21 = (a1 * s1 + b1 * c1) * sc;
                    bf16_t* rp = O + (size_t)row * 256 + wc * 64 + 8 * fq;
                    *(u32x4*)rp = pack8(o10, o11); *(u32x4*)(rp + 32) = pack8(o20, o21); }
        } else {
            bf16_t* O; int ldc, cb; float sc = 1.0f;
            if (t == 0) { O = GQ; ldc = 256; cb = 0; sc = 0.125f; } else if (t == 1) { O = GK; ldc = 256; cb = 0; }
            else if (t < 4) { O = GV; ldc = 512; cb = (t - 2) * 256; } else if (t < 6) { O = GG; ldc = 512; cb = (t - 4) * 256; }
            else if (t < 10) { O = RV; ldc = 512; cb = (t - 8) * 256; } else { O = RG; ldc = 512; cb = (t - 10) * 256; }
            const int col0 = cb + wc * 32 + 8 * fq;
#pragma unroll
            for (int ai = 0; ai < 2; ++ai)
#pragma unroll
                for (int m = 0; m < 4; ++m) { bf16_t* rp = O + (size_t)(row0 + ai * HALF + m * 16) * ldc + col0;
#pragma unroll
                    for (int bj = 0; bj < 2; ++bj) *(u32x4*)(rp + bj * HALF) = pack8(acc[ai][bj][m][0] * sc, acc[ai][bj][m][1] * sc); }
        }
    }
};

struct EpiOutProj {
    static constexpr bool PERM = true, AFTER_DRAIN = false; static constexpr int NST = 16;     typedef NoPre Pre; typedef NoSeed Seed;
    __device__ __forceinline__ void seed_load(Seed&, const Unit&, int, int, int, int) const {}
    __device__ __forceinline__ void seed_acc(f32x4 (&acc)[2][2][4][2], const Seed&) const { PG8_ZERO_ACC(acc); }
    __device__ __forceinline__ void prefetch(Pre&, const Unit&, int, int, int, int) const {}
    const bf16_t* h0b; bf16_t* out; float alpha;
    __device__ __forceinline__ void operator()(const f32x4 (&acc)[2][2][4][2], const Unit& u, int wr, int wc, int fr, int fq, const Pre& pre) const {
        asm volatile("" : "+v"(fr), "+v"(fq));
        const int row0 = u.pm * BM + wr * 64 + fr, col0 = u.pn * BM + wc * 32 + 8 * fq;
#pragma unroll
        for (int ai = 0; ai < 2; ++ai)
#pragma unroll
            for (int m = 0; m < 4; ++m) { const size_t off = (size_t)(row0 + ai * HALF + m * 16) * D + col0;
                u32x4 hv[2];
#pragma unroll
                for (int bj = 0; bj < 2; ++bj) hv[bj] = *(const u32x4*)(h0b + off + bj * HALF);
#pragma unroll
                for (int bj = 0; bj < 2; ++bj) { f32x4 a0, a1;
                    a0[0] = __builtin_bit_cast(float, hv[bj].x << 16); a0[1] = __builtin_bit_cast(float, hv[bj].x & 0xffff0000u); a0[2] = __builtin_bit_cast(float, hv[bj].y << 16); a0[3] = __builtin_bit_cast(float, hv[bj].y & 0xffff0000u);
                    a1[0] = __builtin_bit_cast(float, hv[bj].z << 16); a1[1] = __builtin_bit_cast(float, hv[bj].z & 0xffff0000u); a1[2] = __builtin_bit_cast(float, hv[bj].w << 16); a1[3] = __builtin_bit_cast(float, hv[bj].w & 0xffff0000u);
                    *(u32x4*)(out + off + bj * HALF) = pack8(a0 * alpha + acc[ai][bj][m][0], a1 * alpha + acc[ai][bj][m][1]); }
                asm volatile("" ::: "memory"); }
    }
};

struct EpiSwiGLU {
    static constexpr bool PERM = true, AFTER_DRAIN = false; static constexpr int NST = -1;     typedef NoPre Pre;
    struct Seed { f32x4 g0, g1, l0, l1; };
    __device__ __forceinline__ void seed_load(Seed& sd, const Unit& u, int wr, int wc, int fr, int fq) const {
        asm volatile("" : "+v"(fq));
        const int e = u.e, jt = u.pn - e * 8; const int colc = jt * 128 + wc * 32 + 8 * fq; const float* bp = b1 + (size_t)e * 2048 + colc;
        sd.g0 = *(const f32x4*)bp; sd.g1 = *(const f32x4*)(bp + 4); sd.l0 = *(const f32x4*)(bp + 1024); sd.l1 = *(const f32x4*)(bp + 1028);
    }
    __device__ __forceinline__ void seed_acc(f32x4 (&acc)[2][2][4][2], const Seed& sd) const {
        const float inv = QS_H1 * QS_W; const f32x4 g0 = sd.g0 * inv, g1 = sd.g1 * inv, l0 = sd.l0 * inv, l1 = sd.l1 * inv;
#pragma unroll
        for (int ai = 0; ai < 2; ++ai)
#pragma unroll
            for (int m = 0; m < 4; ++m) { acc[ai][0][m][0] = g0; acc[ai][0][m][1] = g1; acc[ai][1][m][0] = l0; acc[ai][1][m][1] = l1; }
    }
    __device__ __forceinline__ void prefetch(Pre&, const Unit&, int, int, int, int) const {}
    unsigned char* ACT; const float* b1; float asc;
    __device__ __forceinline__ void operator()(const f32x4 (&acc)[2][2][4][2], const Unit& u, int wr, int wc, int fr, int fq, const Pre& pre) const {
        asm volatile("" : "+v"(fr), "+v"(fq));
        const int e = u.e, jt = u.pn - e * 8; const int colc = jt * 128 + wc * 32 + 8 * fq;
        const int row0 = u.pm * BM + wr * 64 + fr;
        const float inv = QS_H1 * QS_W; const f2 kc = {asc * (-1.702f * 1.4426950408889634f), asc * (-1.702f * 1.4426950408889634f)}, one = {1.0f, 1.0f}, q2 = {QS_ACT * asc * asc, QS_ACT * asc * asc}, q1 = {QS_ACT * asc, QS_ACT * asc};
#pragma unroll
        for (int ai = 0; ai < 2; ++ai)
#pragma unroll
            for (int m = 0; m < 4; ++m) { typedef unsigned u32x2_t __attribute__((ext_vector_type(2))); u32x2_t w;
#pragma unroll
                for (int n = 0; n < 2; ++n) { int wv = 0;
#pragma unroll
                    for (int p = 0; p < 2; ++p) {
                        f2 mg, ml, ex, rc; const f32x4 ag = acc[ai][0][m][n], al = acc[ai][1][m][n];
                        mg.x = __builtin_amdgcn_fmed3f(ag[2 * p], -3.0e38f, 7.0f * inv); mg.y = __builtin_amdgcn_fmed3f(ag[2 * p + 1], -3.0e38f, 7.0f * inv);
                        ml.x = __builtin_amdgcn_fmed3f(al[2 * p], -7.0f * inv, 7.0f * inv); ml.y = __builtin_amdgcn_fmed3f(al[2 * p + 1], -7.0f * inv, 7.0f * inv);
                        const f2 t = mg * kc;
                        ex.x = __builtin_amdgcn_exp2f(t.x); ex.y = __builtin_amdgcn_exp2f(t.y);
                        const f2 dn = ex + one;
                        rc.x = __builtin_amdgcn_rcpf(dn.x); rc.y = __builtin_amdgcn_rcpf(dn.y);
                        const f2 o = (mg * rc) * (ml * q2 + q1);
                        wv = p ? __builtin_amdgcn_cvt_pk_fp8_f32(o.x, o.y, wv, true) : __builtin_amdgcn_cvt_pk_fp8_f32(o.x, o.y, 0, false); }
                    w[n] = (unsigned)wv; }
                *(u32x2_t*)(ACT + (size_t)(row0 + ai * HALF + m * 16) * DFF + colc) = w; }
    }
};

struct EpiMoeOut {
    static constexpr bool PERM = true, AFTER_DRAIN = false; static constexpr int NST = 8;     typedef NoPre Pre;
    struct Seed { f32x4 bv[2][2]; };
    __device__ __forceinline__ void seed_load(Seed& sd, const Unit& u, int wr, int wc, int fr, int fq) const {
        asm volatile("" : "+v"(fq));
        const int e = u.e, jt = u.pn - e * 4; const int col0 = jt * 256 + wc * 32 + 8 * fq;
#pragma unroll
        for (int bj = 0; bj < 2; ++bj)
#pragma unroll
            for (int n = 0; n < 2; ++n) sd.bv[bj][n] = *(const f32x4*)(b2 + (size_t)e * D + col0 + bj * HALF + 4 * n);
    }
    __device__ __forceinline__ void seed_acc(f32x4 (&acc)[2][2][4][2], const Seed& sd) const {
        const float inv = QS_ACT * QS_W;
#pragma unroll
        for (int bj = 0; bj < 2; ++bj)
#pragma unroll
            for (int n = 0; n < 2; ++n) { const f32x4 v = sd.bv[bj][n] * inv;
#pragma unroll
                for (int ai = 0; ai < 2; ++ai)
#pragma unroll
                    for (int m = 0; m < 4; ++m) acc[ai][bj][m][n] = v; }
    }
    __device__ __forceinline__ void prefetch(Pre&, const Unit&, int, int, int, int) const {}
    unsigned char* Y; const float* b2; const PG8_LAS float* gtab; float asc;
    __device__ __forceinline__ void operator()(const f32x4 (&acc)[2][2][4][2], const Unit& u, int wr, int wc, int fr, int fq, const Pre& pre) const {
        asm volatile("" : "+v"(fr), "+v"(fq));
        const int e = u.e, jt = u.pn - e * 4; const int colp = jt * 256 + wc * 64 + 16 * fq;
        const int row0 = u.pm * BM + wr * 64 + fr; const PG8_LAS float* gp = gtab + u.ui * 256 + wr * 64 + fr;
#pragma unroll
        for (int ai = 0; ai < 2; ++ai)
#pragma unroll
            for (int m = 0; m < 4; ++m) { const float gt = gp[ai * HALF + m * 16] * (QS_Y * asc); u32x4 w;
#pragma unroll
                for (int bj = 0; bj < 2; ++bj) { const f32x4 v0 = acc[ai][bj][m][0] * gt, v1 = acc[ai][bj][m][1] * gt;
                    const unsigned lo = pk4_fp8(v0[0], v0[1], v0[2], v0[3]), hi = pk4_fp8(v1[0], v1[1], v1[2], v1[3]);
                    if (bj == 0) { w.x = lo; w.y = hi; } else { w.z = lo; w.w = hi; } }
                *(u32x4*)(Y + (size_t)(row0 + ai * HALF + m * 16) * D + colp) = w; }
    }
};

template <class Epi, class Sched, bool ALIGN_EPI = false, bool SP2 = false, int ES = 2, bool GATHER = false>
__device__ __forceinline__ void gemm_phase(PG8_LAS unsigned char* lds, const Gemm g, const Sched& S, const Epi& E) {
    const int tid = threadIdx.x, wid = __builtin_amdgcn_readfirstlane(tid >> 6), lane = tid & 63, wr = wid >> 2, wc = wid & 3, fr = lane & 15, fq = lane >> 4;
    const int K = g.K * ES / 2, nt = K / BK;
    unsigned voffA[2], voffB[2]; int gR[2]; unsigned gC[2];
#pragma unroll
    for (int i = 0; i < 2; ++i) { int R, C; stage_rc(tid * 16 + i * 8192, R, C); const int Rb = Epi::PERM ? ((R & ~31) + perm32(R & 31)) : R;
        voffA[i] = (unsigned)(R * K + C) * 2u; voffB[i] = (unsigned)(Rb * K + C) * 2u; gR[i] = R; gC[i] = (unsigned)C * 2u; }
    unsigned vAc[2][2], vAn[2][2], vAs[2][2];
#define PG8_GLOAD(dst, ui_) do { _Pragma("unroll") for (int h_ = 0; h_ < 2; ++h_) _Pragma("unroll") for (int i_ = 0; i_ < 2; ++i_) dst[h_][i_] = g.gtab[(ui_) * 256 + h_ * HALF + gR[i_]] + gC[i_]; } while (0)
#define PG8_STAGE_A(b, h, soff, V) do { if constexpr (GATHER) { PG8_STAGE_R(PG8_SA(b, h), rA, soff, V[h]); } else { PG8_STAGE_R(PG8_SA(b, h), rA, (soff) + (h) * hstep, voffA); } } while (0)
    const unsigned kstep = (unsigned)(BK * 2);
    const unsigned hstep = (unsigned)HALF * K * 2;
    const unsigned tstep = 2 * hstep;
    const unsigned ldsw = (unsigned)wid * 1024u;
    const int aoff = lds_byte(wr * 64 + fr, fq * 8), boff = lds_byte(wc * 32 + fr, fq * 8);
#define PG8_SA(b, h) (((b) * 2 + (h)) * HTB)
#define PG8_SB(b, h) ((4 + (b) * 2 + (h)) * HTB)
    const __amdgpu_buffer_rsrc_t rA = __builtin_amdgcn_make_buffer_rsrc((void*)g.A, (short)0, 0x7fffffff, 0x00020000);
    const __amdgpu_buffer_rsrc_t rB = __builtin_amdgcn_make_buffer_rsrc((void*)g.Bt, (short)0, 0x7fffffff, 0x00020000);
#define PG8_STAGE_R(bufoff, rsrc, soff, voff) do { _Pragma("unroll") for (int _i = 0; _i < 2; ++_i) \
        __builtin_amdgcn_raw_ptr_buffer_load_lds(rsrc, (PG8_LAS void*)(lds + (bufoff) + ldsw + _i * 8192), 16, (int)(voff)[_i], (int)(soff), 0, 0); } while (0)
#define PG8_LDA(dst, b, h) do { _Pragma("unroll") for (int m = 0; m < 4; ++m) _Pragma("unroll") for (int k = 0; k < 2; ++k) dst[m][k] = *(const PG8_LAS bf16x8*)(lds + PG8_SA(b, h) + aoff + m * 2048 + k * 1024); } while (0)
#define PG8_LDB(dst, b, h) do { _Pragma("unroll") for (int n = 0; n < 2; ++n) _Pragma("unroll") for (int k = 0; k < 2; ++k) dst[n][k] = *(const PG8_LAS bf16x8*)(lds + PG8_SB(b, h) + boff + n * 2048 + k * 1024); } while (0)
#define PG8_PIN12(At, Bt) asm volatile("" : "+v"(At[0][0]), "+v"(At[0][1]), "+v"(At[1][0]), "+v"(At[1][1]), "+v"(At[2][0]), "+v"(At[2][1]), "+v"(At[3][0]), "+v"(At[3][1]), "+v"(Bt[0][0]), "+v"(Bt[0][1]), "+v"(Bt[1][0]), "+v"(Bt[1][1]))
#define PG8_PINACC(ai, bj) asm volatile("" : "+v"(acc[ai][bj][0][0]), "+v"(acc[ai][bj][0][1]), "+v"(acc[ai][bj][1][0]), "+v"(acc[ai][bj][1][1]), "+v"(acc[ai][bj][2][0]), "+v"(acc[ai][bj][2][1]), "+v"(acc[ai][bj][3][0]), "+v"(acc[ai][bj][3][1]))
#define PG8_MMA(ai, bj, At, Bt) do { if constexpr (ES == 1) { PG8_PIN12(At, Bt); __builtin_amdgcn_sched_barrier(0); } __builtin_amdgcn_s_setprio(1); _Pragma("unroll") for (int m = 0; m < 4; ++m) _Pragma("unroll") for (int n = 0; n < 2; ++n) { \
        if constexpr (ES == 2) { _Pragma("unroll") for (int k = 0; k < 2; ++k) acc[ai][bj][m][n] = __builtin_amdgcn_mfma_f32_16x16x32_bf16(Bt[n][k], At[m][k], acc[ai][bj][m][n], 0, 0, 0); } \
        else { acc[ai][bj][m][n] = __builtin_amdgcn_mfma_scale_f32_16x16x128_f8f6f4(cat8(Bt[n][0], Bt[n][1]), cat8(At[m][0], At[m][1]), acc[ai][bj][m][n], 0, 0, 0, 0x7f7f7f7f, 0, 0x7f7f7f7f); } } \
        __builtin_amdgcn_s_setprio(0); if constexpr (ES == 1) { PG8_PINACC(ai, bj); __builtin_amdgcn_sched_barrier(0); } } while (0)
#define PG8_WAIT_V(n) asm volatile("s_waitcnt vmcnt(" #n ")" ::: "memory")
#define PG8_WAIT_L(n) asm volatile("s_waitcnt lgkmcnt(" #n ")" ::: "memory")
#define PG8_BAR __builtin_amdgcn_s_barrier()
#define PG8_SCHED __builtin_amdgcn_sched_barrier(0)
    Unit cur, nxt; int ui = 0;
    if (!S.next(0, cur)) return;
    typename Epi::Pre pre; E.prefetch(pre, cur, wr, wc, fr, fq);
    typename Epi::Seed sd; E.seed_load(sd, cur, wr, wc, fr, fq);
    f32x4 acc[2][2][4][2]; E.seed_acc(acc, sd);
    bf16x8 At[4][2], B0[2][2], B1[2][2];
    unsigned cA = GATHER ? 0u : (unsigned)cur.pm * tstep, cB = (unsigned)cur.pn * tstep;
    if constexpr (GATHER) PG8_GLOAD(vAc, 0);
    S.a_ready(cur);
    if constexpr (SP2) {
        PG8_STAGE_R(PG8_SB(0, 0), rB, cB, voffB); PG8_STAGE_R(PG8_SB(0, 1), rB, cB + hstep, voffB); PG8_STAGE_A(0, 0, cA, vAc); PG8_STAGE_A(0, 1, cA, vAc);
        if (wr == 1) PG8_BAR;
        PG8_WAIT_V(2); PG8_BAR;
        PG8_STAGE_R(PG8_SB(1, 0), rB, cB + kstep, voffB); PG8_STAGE_A(1, 0, cA + kstep, vAc); PG8_STAGE_R(PG8_SB(1, 1), rB, cB + hstep + kstep, voffB);
        if constexpr (Epi::NST >= 0) PG8_WAIT_V(0); else PG8_WAIT_V(6);
        PG8_BAR;
    } else {
        PG8_STAGE_R(PG8_SB(0, 0), rB, cB, voffB); PG8_STAGE_A(0, 0, cA, vAc); PG8_STAGE_R(PG8_SB(0, 1), rB, cB + hstep, voffB); PG8_STAGE_A(0, 1, cA, vAc);
        if (wr == 1) PG8_BAR;
        PG8_WAIT_V(4); PG8_BAR;
        PG8_STAGE_R(PG8_SB(1, 0), rB, cB + kstep, voffB); PG8_STAGE_A(1, 0, cA + kstep, vAc); PG8_STAGE_R(PG8_SB(1, 1), rB, cB + hstep + kstep, voffB);
        PG8_WAIT_V(6); PG8_BAR;
    }
    for (;;) {
        const bool has_next = S.next(ui + 1, nxt);
        const unsigned nA = (has_next && !GATHER) ? (unsigned)nxt.pm * tstep : cA, nB = has_next ? (unsigned)nxt.pn * tstep : cB;
        if constexpr (GATHER) { if (has_next) PG8_GLOAD(vAn, ui + 1); else { _Pragma("unroll") for (int h_ = 0; h_ < 2; ++h_) _Pragma("unroll") for (int i_ = 0; i_ < 2; ++i_) vAn[h_][i_] = vAc[h_][i_]; } }
#define PG8_ITER_HEAD(t, LAST) \
            const bool last = (LAST); \
            if constexpr (GATHER) { _Pragma("unroll") for (int h_ = 0; h_ < 2; ++h_) _Pragma("unroll") for (int i_ = 0; i_ < 2; ++i_) vAs[h_][i_] = last ? vAn[h_][i_] : vAc[h_][i_]; } \
            const unsigned a1 = cA + (unsigned)((t) + 1) * kstep;                                             \
            const unsigned a2 = last ? nA : cA + (unsigned)((t) + 2) * kstep, b2 = last ? nB : cB + (unsigned)((t) + 2) * kstep;     \
            const unsigned a3 = a2 + kstep, b3 = b2 + kstep;                                \
            if (last && has_next) S.a_ready(nxt);
#define PG8_ITER_SP2(W01) \
            PG8_LDB(B0, 0, 0); PG8_LDB(B1, 0, 1); PG8_SCHED; PG8_LDA(At, 0, 0); PG8_STAGE_A(1, 1, a1, vAc); \
            W01; PG8_WAIT_L(0); PG8_BAR; PG8_MMA(0, 0, At, B0); PG8_MMA(0, 1, At, B1); PG8_BAR; PG8_SCHED; \
            PG8_LDA(At, 0, 1); PG8_STAGE_R(PG8_SB(0, 0), rB, b2, voffB); PG8_STAGE_R(PG8_SB(0, 1), rB, b2 + hstep, voffB); PG8_STAGE_A(0, 0, a2, vAs); \
            W01; PG8_WAIT_L(0); PG8_BAR; PG8_MMA(1, 0, At, B0); PG8_MMA(1, 1, At, B1); PG8_BAR; PG8_SCHED; \
            PG8_LDB(B0, 1, 0); PG8_LDB(B1, 1, 1); PG8_SCHED; PG8_LDA(At, 1, 0); PG8_STAGE_A(0, 1, a2, vAs); \
            PG8_WAIT_V(8); PG8_WAIT_L(0); PG8_BAR; PG8_MMA(0, 0, At, B0); PG8_MMA(0, 1, At, B1); PG8_BAR; PG8_SCHED; \
            PG8_LDA(At, 1, 1); PG8_STAGE_R(PG8_SB(1, 0), rB, b3, voffB); PG8_STAGE_R(PG8_SB(1, 1), rB, b3 + hstep, voffB); PG8_STAGE_A(1, 0, a3, vAs); \
            PG8_WAIT_V(8); PG8_WAIT_L(0); PG8_BAR; PG8_MMA(1, 0, At, B0); PG8_MMA(1, 1, At, B1); PG8_BAR; PG8_SCHED;
        if constexpr (SP2 && Epi::NST >= 0) {
            { PG8_ITER_HEAD(0, false) PG8_ITER_SP2(asm volatile("s_waitcnt vmcnt(%0)" :: "n"(8 + Epi::NST) : "memory")) }
            for (int t = 2; t < nt; t += 2) { PG8_ITER_HEAD(t, t == nt - 2) PG8_ITER_SP2(PG8_WAIT_V(8)) }
        } else if constexpr (SP2) {
            for (int t = 0; t < nt; t += 2) { PG8_ITER_HEAD(t, t == nt - 2) PG8_ITER_SP2(PG8_WAIT_V(8)) }
        } else {
            for (int t = 0; t < nt; t += 2) { PG8_ITER_HEAD(t, t == nt - 2)
            PG8_LDB(B0, 0, 0); PG8_SCHED; PG8_LDA(At, 0, 0); PG8_STAGE_A(1, 1, a1, vAc);
            PG8_WAIT_L(8); PG8_BAR; PG8_WAIT_L(0); PG8_MMA(0, 0, At, B0); PG8_BAR; PG8_SCHED;
            PG8_LDB(B1, 0, 1); PG8_STAGE_R(PG8_SB(0, 0), rB, b2, voffB);
            PG8_BAR; PG8_WAIT_L(0); PG8_MMA(0, 1, At, B1); PG8_BAR;
            PG8_LDA(At, 0, 1); PG8_STAGE_A(0, 0, a2, vAs);
            PG8_BAR; PG8_WAIT_L(0); PG8_MMA(1, 0, At, B0); PG8_BAR; PG8_SCHED;
            PG8_STAGE_R(PG8_SB(0, 1), rB, b2 + hstep, voffB);
            PG8_WAIT_V(6); PG8_BAR; PG8_MMA(1, 1, At, B1); PG8_BAR;
            PG8_LDB(B0, 1, 0); PG8_SCHED; PG8_LDA(At, 1, 0); PG8_STAGE_A(0, 1, a2, vAs);
            PG8_WAIT_L(8); PG8_BAR; PG8_WAIT_L(0); PG8_MMA(0, 0, At, B0); PG8_BAR; PG8_SCHED;
            PG8_LDB(B1, 1, 1); PG8_STAGE_R(PG8_SB(1, 0), rB, b3, voffB);
            PG8_BAR; PG8_WAIT_L(0); PG8_MMA(0, 1, At, B1); PG8_BAR;
            PG8_LDA(At, 1, 1); PG8_STAGE_A(1, 0, a3, vAs);
            PG8_BAR; PG8_WAIT_L(0); PG8_MMA(1, 0, At, B0); PG8_BAR; PG8_SCHED;
            PG8_STAGE_R(PG8_SB(1, 1), rB, b3 + hstep, voffB);
            PG8_WAIT_V(6); PG8_BAR; PG8_MMA(1, 1, At, B1); PG8_BAR;
            }
        }
#undef PG8_ITER_HEAD
#undef PG8_ITER_SP2
        if constexpr (ALIGN_EPI) { if (wr == 0) PG8_BAR; }
        if (has_next) E.seed_load(sd, nxt, wr, wc, fr, fq);
        if constexpr (!Epi::AFTER_DRAIN) { E(acc, cur, wr, wc, fr, fq, pre); S.done(cur); }
        if (!has_next) break;
        E.seed_acc(acc, sd);
        cur = nxt; cA = nA; cB = nB; ++ui;
        if constexpr (GATHER) { _Pragma("unroll") for (int h_ = 0; h_ < 2; ++h_) _Pragma("unroll") for (int i_ = 0; i_ < 2; ++i_) vAc[h_][i_] = vAn[h_][i_]; }
        E.prefetch(pre, cur, wr, wc, fr, fq);
        if constexpr (ALIGN_EPI) { if (wr == 1) PG8_BAR; }
    }
    PG8_WAIT_V(0);
    if constexpr (!ALIGN_EPI) { if (wr == 0) PG8_BAR; }
    PG8_BAR;
#undef PG8_SA
#undef PG8_SB
#undef PG8_STAGE_R
#undef PG8_STAGE_A
#undef PG8_GLOAD
#undef PG8_LDA
#undef PG8_LDB
#undef PG8_MMA
#undef PG8_PIN12
#undef PG8_PINACC
#undef PG8_WAIT_V
#undef PG8_WAIT_L
#undef PG8_BAR
#undef PG8_SCHED
}
}


constexpr size_t MiB = 1u << 20;
constexpr size_t WS_CTL = 0, CTL_ZERO_BYTES = 1 * MiB;
constexpr size_t WS_STATS0 = 1 * MiB, WS_COS = 2 * MiB, WS_SIN = 6 * MiB;
constexpr size_t WS_WINT = 10 * MiB, WS_WOT = 17 * MiB, WS_W1T = 20 * MiB, WS_W2T = 148 * MiB;
constexpr size_t WS_H0B = 212 * MiB, WS_MIXED = 534 * MiB;
constexpr size_t WS_PROJ = 276 * MiB;
constexpr size_t WS_ST = 470 * MiB, WS_DEC = 598 * MiB;
constexpr size_t WS_PRE1 = 212 * MiB;
constexpr size_t WS_AGG = 599 * MiB, WS_SINS = 615 * MiB, WS_DAGG = 631 * MiB;
constexpr size_t WS_H1B = 599 * MiB, WS_LIST = 663 * MiB, WS_GATES = 667 * MiB;
constexpr size_t WS_XS = 276 * MiB, WS_SLOTG = 668 * MiB, WS_ACT = 672 * MiB, WS_Y = 276 * MiB, WS_END = 940 * MiB;
constexpr size_t PJ_GQ = 0, PJ_GK = 16 * MiB, PJ_GV = 32 * MiB, PJ_GG = 64 * MiB, PJ_RQ = 96 * MiB, PJ_RK = 112 * MiB, PJ_RV = 128 * MiB, PJ_RG = 160 * MiB, PJ_GLR = 192 * MiB;
constexpr int CW_TMO = 0, CW_CODE = 1, CW_COUNTS = 64, CW_BAR = 4096;
constexpr int RING_OFF = 0, RING_BYTES = 131072;
constexpr int LDSCTL_OFF = RING_BYTES, MISC_OFF = LDSCTL_OFF + 320;
constexpr int X_TSTART = LDSCTL_OFF + 512, X_CNT = LDSCTL_OFF + 768, X_LCNT = LDSCTL_OFF + 1024, X_LBASE = LDSCTL_OFF + 1280, X_NASG = LDSCTL_OFF + 1536, X_ASG = LDSCTL_OFF + 2048;
constexpr int X_GTAB = LDSCTL_OFF + 8192, GT_MAXU = 17;
constexpr int LDS_BYTES = 157696;
constexpr int NWAVES = 8;
constexpr int NPH = 11;
#define GAS __attribute__((address_space(1)))
#define LAS __attribute__((address_space(3)))
typedef unsigned short bf16;
typedef unsigned v4u __attribute__((ext_vector_type(4)));
typedef float f32x4 __attribute__((ext_vector_type(4)));
typedef short bf16x8 __attribute__((ext_vector_type(8)));
typedef GAS unsigned gu32;
typedef GAS unsigned long long gu64;
#define RLX_AGENT __ATOMIC_RELAXED, __HIP_MEMORY_SCOPE_AGENT
#define LDS_WAIT() asm volatile("s_waitcnt lgkmcnt(0)" ::: "memory")
#define VM_WAIT() asm volatile("s_waitcnt vmcnt(0)" ::: "memory")
__device__ __forceinline__ unsigned long long rt() { return __builtin_amdgcn_s_memrealtime(); }
typedef __bf16 hwbf16x2 __attribute__((ext_vector_type(2)));
typedef float f32x2_t __attribute__((ext_vector_type(2)));
__device__ __forceinline__ unsigned pk2(float lo, float hi) { return __builtin_bit_cast(unsigned, __builtin_convertvector((f32x2_t){lo, hi}, hwbf16x2)); }
__device__ __forceinline__ unsigned f2bf(float f) { return pk2(f, 0.f) & 0xffffu; }

#define XB_TMO      128
#define XB_XCNT(j)  (256  + 64 * (j))
#define XB_XSUB(j)  (1280 + 64 * (j))
#define XB_XGEN(j)  (2304 + 64 * (j))
#define XB_TOP      3328
#define XB_TOPGEN   3392
#define XCD_BAR_WORDS 3456
#define XB_SPIN_CAP (1u << 18)

__device__ __forceinline__ unsigned xb_ld(unsigned* p)              { return __hip_atomic_load(p, __ATOMIC_RELAXED, __HIP_MEMORY_SCOPE_AGENT); }
__device__ __forceinline__ unsigned xb_add(unsigned* p, unsigned v) { return __hip_atomic_fetch_add(p, v, __ATOMIC_RELAXED, __HIP_MEMORY_SCOPE_AGENT); }
__device__ __forceinline__ unsigned xb_xcc_id() { return (unsigned)__builtin_amdgcn_s_getreg((3 << 11) | 20) & 0xFu; }
#define XB_SPIN(cond, bar) do { unsigned _sp = 0; while (cond) { __builtin_amdgcn_s_sleep(1); \
    if ((++_sp & 255u) == 0u) { if (xb_ld(&(bar)[XB_TMO])) break; if (_sp > XB_SPIN_CAP) { atomicAdd(&(bar)[XB_TMO], 1u); break; } } } } while (0)

struct XcdBarrier {
    unsigned* bar; unsigned x;
    volatile LAS unsigned* st;
};

__device__ __forceinline__ XcdBarrier xcd_barrier_post(unsigned* bar, volatile LAS unsigned* st) {
    XcdBarrier b; b.bar = bar; b.x = xb_xcc_id(); b.st = st;
    if (threadIdx.x == 0) (void)xb_add(&bar[XB_XCNT(b.x)], 1u);
    return b;
}
__device__ __forceinline__ void xcd_barrier_complete(unsigned* bar, unsigned x, unsigned& nloc, unsigned& nx) {
    const unsigned G = gridDim.x * gridDim.y * gridDim.z;
    unsigned sum, cnt, mine, sp = 0u;
    for (;;) {
        sum = 0u; cnt = 0u; mine = 0u;
#pragma unroll
        for (unsigned j = 0; j < 16; ++j) { const unsigned c = xb_ld(&bar[XB_XCNT(j)]); sum += c; cnt += (c > 0u) ? 1u : 0u; mine = (j == x) ? c : mine; }
        if (sum == G) break;
        __builtin_amdgcn_s_sleep(1);
        if ((++sp & 255u) == 0u) { if (xb_ld(&bar[XB_TMO])) break; if (sp > XB_SPIN_CAP) { atomicAdd(&bar[XB_TMO], 1u); break; } }
    }
    nloc = mine > 0u ? mine : 1u; nx = cnt > 0u ? cnt : 1u;
}

__device__ __forceinline__ void xcd_barrier(const XcdBarrier& b) {
    asm volatile("s_waitcnt vmcnt(0)" ::: "memory");
    __syncthreads();
    if (threadIdx.x == 0) {
        unsigned* bar = b.bar;
        __builtin_amdgcn_s_waitcnt(0);
        unsigned nloc = b.st[0], nx = b.st[1];
        if (nloc == 0u) { xcd_barrier_complete(bar, b.x, nloc, nx); b.st[0] = nloc; b.st[1] = nx; }
        const unsigned old = xb_add(&bar[XB_XSUB(b.x)], 1u);
        const unsigned gen = old / nloc;
        if (old + 1u == (gen + 1u) * nloc) {
            __builtin_amdgcn_fence(__ATOMIC_RELEASE, "agent");
            asm volatile("s_waitcnt vmcnt(0)" ::: "memory");
            const unsigned og = xb_add(&bar[XB_TOP], 1u);
            const unsigned tg = og / nx;
            if (og + 1u == (tg + 1u) * nx) xb_add(&bar[XB_TOPGEN], 1u);
            else XB_SPIN(xb_ld(&bar[XB_TOPGEN]) == tg, bar);
            __builtin_amdgcn_fence(__ATOMIC_ACQUIRE, "agent");
            xb_add(&bar[XB_XGEN(b.x)], 1u);
            asm volatile("s_waitcnt vmcnt(0)" ::: "memory");
        } else {
            XB_SPIN(xb_ld(&bar[XB_XGEN(b.x)]) == gen, bar);
            __builtin_amdgcn_fence(__ATOMIC_ACQUIRE, "agent");
            asm volatile("s_waitcnt vmcnt(0)" ::: "memory");
        }
    }
    __syncthreads();
}

struct Frame {
    LAS unsigned char* lds;
    volatile LAS unsigned* MISC;
    gu32* ctl;
    int tid, lane, wave, vcu, G;
    const float *x; const int* positions; const float *ln_in_g, *ln_in_b, *w_in, *gate_w, *gate_b, *gla_g, *ret_g, *ret_b, *w_out, *ln1_g, *ln1_b, *router_w, *router_b, *w1, *b1, *w2, *b2, *ln2_g, *ln2_b;
    float* out;
    float *stats0, *cosT, *sinT, *ST, *DEC, *PRE1, *GLR, *gates, *AGG, *DAGG; bf16* SIN;
    bf16 *WinT, *WoT, *W1T, *W2T, *H0B, *MIXED, *GQ, *GK, *GV, *GG, *RQ, *RK, *RV, *RG, *H1B, *XS, *ACT, *Y;
    int* list; unsigned* counts; float* slotg; int* tkslot;
};
template <int CTRL> __device__ __forceinline__ float dppf(float v) { return __builtin_bit_cast(float, __builtin_amdgcn_update_dpp(0, __builtin_bit_cast(int, v), CTRL, 0xF, 0xF, true)); }
template <int CTRL> __device__ __forceinline__ int dppi(int v) { return __builtin_amdgcn_update_dpp(0, v, CTRL, 0xF, 0xF, true); }
__device__ __forceinline__ float wave_sum(float v) {
    v += dppf<0xB1>(v); v += dppf<0x4E>(v); v += dppf<0x141>(v); v += dppf<0x140>(v);
    const float s0 = __builtin_bit_cast(float, __builtin_amdgcn_readlane(__builtin_bit_cast(int, v), 0)), s1 = __builtin_bit_cast(float, __builtin_amdgcn_readlane(__builtin_bit_cast(int, v), 16));
    const float s2 = __builtin_bit_cast(float, __builtin_amdgcn_readlane(__builtin_bit_cast(int, v), 32)), s3 = __builtin_bit_cast(float, __builtin_amdgcn_readlane(__builtin_bit_cast(int, v), 48));
    return (s0 + s1) + (s2 + s3);
}
__device__ __forceinline__ float bf2f(unsigned h) { return __builtin_bit_cast(float, h << 16); }

struct WinMap { __device__ __forceinline__ int operator()(int n) const {
    if (n < 1536) return n;
    if (n < 1552) return -1;
    if (n < 2064) { const int q = n < 1808 ? 0 : 1, l = n - (q ? 1808 : 1552); return 1536 + 256 * q + ((l >> 5) & 1) * 128 + (l >> 6) * 32 + (l & 31); }
    if (n < 2576) return 2048 + (n - 2064);
    return 2560 + (n - 2576); } };
struct IdMap { int off; __device__ __forceinline__ int operator()(int n) const { return off + n; } };
struct W1Map { int off; __device__ __forceinline__ int operator()(int n) const { const int l = n & 1023; return off + (l >> 7) * 256 + (n >> 10) * 128 + (l & 127); } };
template <bool FP8, class RowMap>
__device__ __forceinline__ void p0_transpose_item(const float* W, int K, int N, bf16* WT, const RowMap rm, int item, int lane) {
    const int nblk = (N + 31) / 32, kb = item / nblk, nb = item % nblk, k0 = 128 * kb, n0 = 32 * nb;
    const int q = lane & 7, n4 = n0 + 4 * (lane >> 3);
    f32x4 a[16];
    if (n4 < N) {
#pragma unroll
        for (int i = 0; i < 16; ++i) a[i] = __builtin_nontemporal_load((const GAS f32x4*)(W + (size_t)(k0 + 16 * q + i) * N + n4)); }
    else {
#pragma unroll
        for (int i = 0; i < 16; ++i) a[i] = (f32x4){0.f, 0.f, 0.f, 0.f}; }
#pragma unroll
    for (int c = 0; c < 4; ++c) { const int n = n4 + c; const int row = (n < N) ? rm(n) : -1;
        if (row >= 0) {
            if constexpr (FP8) { v4u w;
                w.x = pk4_fp8(a[0][c] * QS_W, a[1][c] * QS_W, a[2][c] * QS_W, a[3][c] * QS_W); w.y = pk4_fp8(a[4][c] * QS_W, a[5][c] * QS_W, a[6][c] * QS_W, a[7][c] * QS_W);
                w.z = pk4_fp8(a[8][c] * QS_W, a[9][c] * QS_W, a[10][c] * QS_W, a[11][c] * QS_W); w.w = pk4_fp8(a[12][c] * QS_W, a[13][c] * QS_W, a[14][c] * QS_W, a[15][c] * QS_W);
                *(GAS v4u*)((GAS unsigned char*)WT + (size_t)row * K + k0 + 16 * q) = w; }
            else { GAS v4u* dst = (GAS v4u*)(WT + (size_t)row * K + k0 + 16 * q);
                dst[0] = (v4u){pk2(a[0][c], a[1][c]), pk2(a[2][c], a[3][c]), pk2(a[4][c], a[5][c]), pk2(a[6][c], a[7][c])};
                dst[1] = (v4u){pk2(a[8][c], a[9][c]), pk2(a[10][c], a[11][c]), pk2(a[12][c], a[13][c]), pk2(a[14][c], a[15][c])}; } } }
}
__device__ __forceinline__ void p0_prologue(Frame& F) {
    const int gw = F.vcu * NWAVES + F.wave, NGW = F.G * NWAVES;
    constexpr int I_IN = (D / 128) * ((PW + 31) / 32), I_OUT = (D / 128) * (D / 32), I_1 = (D / 128) * (2 * DFF / 32), I_2 = (DFF / 128) * (D / 32);
    constexpr int NITEMS = I_IN + I_OUT + NE * (I_1 + I_2);
    for (int it = gw; it < NITEMS; it += NGW) {
        int r = it;
        if (r < I_IN) { p0_transpose_item<false>(F.w_in, D, PW, F.WinT, WinMap{}, r, F.lane); continue; } r -= I_IN;
        if (r < I_OUT) { p0_transpose_item<false>(F.w_out, D, D, F.WoT, IdMap{0}, r, F.lane); continue; } r -= I_OUT;
        if (r < NE * I_1) { const int e = r / I_1; p0_transpose_item<true>(F.w1 + (size_t)e * D * 2 * DFF, D, 2 * DFF, F.W1T, W1Map{e * 2 * DFF}, r % I_1, F.lane); continue; } r -= NE * I_1;
        { const int e = r / I_2; p0_transpose_item<true>(F.w2 + (size_t)e * DFF * D, DFF, D, F.W2T, IdMap{e * D}, r % I_2, F.lane); }
    }
    __syncthreads();
    { LAS float* WG = (LAS float*)(F.lds + RING_OFF);
        for (int idx = F.tid; idx < D * 4; idx += 512) { const int c = idx >> 2, ch = idx & 3; *(LAS f32x4*)(WG + c * 20 + ((ch + ((c >> 4) & 3)) & 3) * 4) = *(const GAS f32x4*)(F.w_in + (size_t)c * PW + 1536 + 4 * ch); } }
    __syncthreads();
    { f32x4 g4[4], b4[4];
#pragma unroll
        for (int j = 0; j < 4; ++j) { g4[j] = *((const GAS f32x4*)F.ln_in_g + F.lane + 64 * j); b4[j] = *((const GAS f32x4*)F.ln_in_b + F.lane + 64 * j); }
        f32x4 nx[4]; int m = gw;
        if (m < M) {
#pragma unroll
            for (int j = 0; j < 4; ++j) nx[j] = __builtin_nontemporal_load((const GAS f32x4*)(F.x + (size_t)m * D) + F.lane + 64 * j); }
        for (; m < M; m += NGW) {
            f32x4 v[4]; float s = 0.f;
#pragma unroll
            for (int j = 0; j < 4; ++j) { v[j] = nx[j]; s += (v[j].x + v[j].y) + (v[j].z + v[j].w); }
            if (m + NGW < M) {
#pragma unroll
                for (int j = 0; j < 4; ++j) nx[j] = __builtin_nontemporal_load((const GAS f32x4*)(F.x + (size_t)(m + NGW) * D) + F.lane + 64 * j); }
            const float mean = wave_sum(s) * (1.f / D); float s2 = 0.f;
#pragma unroll
            for (int j = 0; j < 4; ++j) { v[j] = v[j] - mean; s2 += (v[j].x * v[j].x + v[j].y * v[j].y) + (v[j].z * v[j].z + v[j].w * v[j].w); }
            const float rstd = 1.f / sqrtf(wave_sum(s2) * (1.f / D) + LN_EPS);
            if (F.lane == 0) { F.stats0[2 * m] = mean; F.stats0[2 * m + 1] = rstd; }
            GAS unsigned long long* o8 = (GAS unsigned long long*)(F.H0B + (size_t)m * D) + F.lane;
#pragma unroll
            for (int j = 0; j < 4; ++j) { const f32x4 h = v[j] * rstd * g4[j] + b4[j]; v[j] = h;
                o8[64 * j] = (unsigned long long)pk2(h.x, h.y) | ((unsigned long long)pk2(h.z, h.w) << 32); }
            { const LAS float* WG = (const LAS float*)(F.lds + RING_OFF); float acc[16];
#pragma unroll
                for (int r = 0; r < 16; ++r) acc[r] = 0.f;
#pragma unroll
                for (int ci = 0; ci < 16; ++ci) { const int c = 4 * F.lane + 256 * (ci >> 2) + (ci & 3); const float hv = v[ci >> 2][ci & 3]; f32x4 wc[4];
#pragma unroll
                    for (int ch = 0; ch < 4; ++ch) wc[ch] = *(const LAS f32x4*)(WG + c * 20 + ((ch + ((c >> 4) & 3)) & 3) * 4);
#pragma unroll
                    for (int ch = 0; ch < 4; ++ch)
#pragma unroll
                        for (int x = 0; x < 4; ++x) acc[4 * ch + x] += hv * wc[ch][x];
                    if ((ci & 3) == 3) asm volatile("" ::: "memory"); }
                float red[8];
#pragma unroll
                for (int e = 0; e < 8; ++e) { float pa = acc[e], pb = acc[e + 8]; asm volatile("v_nop\n\tv_nop\n\tv_permlane32_swap_b32 %0, %1" : "+v"(pa), "+v"(pb)); red[e] = pa + pb; }
#define P0_SEL(MSK, A, B) __builtin_bit_cast(float, (__builtin_bit_cast(unsigned, (A)) & (MSK)) | (__builtin_bit_cast(unsigned, (B)) & ~(MSK)))
                { const unsigned hm = (F.lane & 16) ? 0xffffffffu : 0u; float snd[4], rcv[4];
#pragma unroll
                    for (int e = 0; e < 4; ++e) snd[e] = P0_SEL(hm, red[e], red[e + 4]);
#pragma unroll
                    for (int e = 0; e < 4; ++e) rcv[e] = __shfl_xor(snd[e], 16);
#pragma unroll
                    for (int e = 0; e < 4; ++e) red[e] = P0_SEL(hm, red[e + 4], red[e]) + rcv[e]; }
                { const unsigned hm = (F.lane & 8) ? 0xffffffffu : 0u;
#pragma unroll
                    for (int e = 0; e < 2; ++e) { const float keep = P0_SEL(hm, red[e + 2], red[e]), snd = P0_SEL(hm, red[e], red[e + 2]); red[e] = keep + dppf<0x128>(snd); } }
                { const unsigned hm = (F.lane & 4) ? 0xffffffffu : 0u; const float keep = P0_SEL(hm, red[1], red[0]), snd = P0_SEL(hm, red[0], red[1]); red[0] = keep + dppf<0x141>(snd); }
#undef P0_SEL
                red[0] += dppf<0x4E>(red[0]); red[0] += dppf<0xB1>(red[0]);
                if ((F.lane & 3) == 0) F.GLR[(size_t)m * 16 + ((F.lane >> 5) * 8 + ((F.lane >> 4) & 1) * 4 + ((F.lane >> 3) & 1) * 2 + ((F.lane >> 2) & 1))] = red[0]; }
        } }
    const double inv_freq = pow(10000.0, -(double)(F.tid & 31) / 31.0);
    for (int idx = F.vcu * 512 + F.tid; idx < M * 32; idx += F.G * 512) { const int t = idx >> 5;
        const double ang = (double)F.positions[t] * inv_freq;
        F.cosT[idx] = (float)cos(ang); F.sinT[idx] = (float)sin(ang); }
}

constexpr int MS = 72;
constexpr int MX_QE = 0, MX_QN = 9216, MX_KE = 18432, MX_KN = 27648, MX_VT = 36864, MX_PT = 55296, MX_B = 73728, MX_RED = 90368, MX_GW = 91392, MX_P = 95744;
constexpr int MX_OUT = MX_P, OUTS = 132;
static_assert(MX_GW + 4096 + 256 <= MX_P && MX_OUT + 64 * OUTS * 4 <= RING_BYTES, "mixer LDS");
constexpr float LOG2E = 1.4426950408889634f, LN2 = 0.6931471805599453f;
__device__ __forceinline__ float log2_gamma(int h) { return log2f(1.0f - exp2f(-5.0f - (float)h)); }
__device__ __forceinline__ float fexp2(float x) { return __builtin_amdgcn_exp2f(x); }
__device__ __forceinline__ float bflo(unsigned w) { return __builtin_bit_cast(float, w << 16); }
__device__ __forceinline__ float bfhi(unsigned w) { return __builtin_bit_cast(float, w & 0xffff0000u); }
__device__ __forceinline__ int tsw(int row, int j) { return row * MS + ((((j >> 3) ^ (row >> 3)) & 7) << 3) + (j & 7); }
struct MixItem { int b, h, h8, c, item; bool gla; size_t t0; };
__device__ __forceinline__ MixItem mix_item(int vb, int k) {
    MixItem m; m.b = vb >> 6; m.h = (vb >> 4) & 3; m.c = (vb & 15) * 8 + (k >> 1); m.gla = (k & 1) == 0; m.h8 = m.gla ? m.h : 4 + m.h;
    m.item = ((m.b * 8 + m.h8) << 7) + m.c; m.t0 = (size_t)m.b * SEQ + (size_t)m.c * CH; return m; }
__device__ __forceinline__ void mixer_stage_gate(Frame& F, int h) {
    LAS float* GW = (LAS float*)(F.lds + MX_GW);
    for (int i = F.tid; i < 1024; i += 512) { const int d = i >> 4, r = i & 15; GW[d * 16 + r] = F.gate_w[r * 256 + h * 64 + d]; }
    if (F.tid < 64) GW[1024 + F.tid] = F.gate_b[h * 64 + F.tid];
}
__device__ __forceinline__ void mixer_bcum(Frame& F, const f32x4 (&g)[4]) {
    LAS float* B = (LAS float*)(F.lds + MX_B); const LAS float* GW = (const LAS float*)(F.lds + MX_GW);
#pragma unroll
    for (int dd = 0; dd < 8; ++dd) { const int d = F.wave * 8 + dd; const LAS f32x4* w = (const LAS f32x4*)(GW + d * 16);
        const f32x4 w0 = w[0], w1 = w[1], w2 = w[2], w3 = w[3];
        float z = GW[1024 + d];
        z += (g[0][0] * w0[0] + g[0][1] * w0[1]) + (g[0][2] * w0[2] + g[0][3] * w0[3]);
        z += (g[1][0] * w1[0] + g[1][1] * w1[1]) + (g[1][2] * w1[2] + g[1][3] * w1[3]);
        z += (g[2][0] * w2[0] + g[2][1] * w2[1]) + (g[2][2] * w2[2] + g[2][3] * w2[3]);
        z += (g[3][0] * w3[0] + g[3][1] * w3[1]) + (g[3][2] * w3[2] + g[3][3] * w3[3]);
        float la = (fminf(z, 0.f) * LOG2E - __builtin_amdgcn_logf(1.0f + fexp2(-fabsf(z) * LOG2E))) * (1.0f / 16.0f);
        la += dppf<0x111>(la); la += dppf<0x112>(la); la += dppf<0x114>(la); la += dppf<0x118>(la);
        la += __builtin_bit_cast(float, __builtin_amdgcn_update_dpp(0, __builtin_bit_cast(int, la), 0x142, 0xA, 0xF, false));
        la += __builtin_bit_cast(float, __builtin_amdgcn_update_dpp(0, __builtin_bit_cast(int, la), 0x143, 0xC, 0xF, false));
        B[F.lane * 65 + d] = la; }
}
struct MixKvRegs { v4u k8, v8[2]; f32x4 g[4]; };
__device__ __forceinline__ void mixer_kv_load(Frame& F, const MixItem& m, MixKvRegs& R) {
    const bf16* K = m.gla ? F.GK : F.RK; const bf16* V = m.gla ? F.GV : F.RV;
    const int jq = F.tid >> 3, dq = (F.tid & 7) * 8;
    R.k8 = *(const GAS v4u*)(K + (m.t0 + jq) * 256 + m.h * 64 + dq);
#pragma unroll
    for (int i = 0; i < 2; ++i) { const int p = F.tid + 512 * i; R.v8[i] = *(const GAS v4u*)(V + (m.t0 + (p >> 4)) * 512 + m.h * 128 + (p & 15) * 8); }
    if (m.gla) { const GAS f32x4* gr = (const GAS f32x4*)(F.GLR + (m.t0 + F.lane) * 16); R.g[0] = gr[0]; R.g[1] = gr[1]; R.g[2] = gr[2]; R.g[3] = gr[3]; }
}
__device__ __forceinline__ void mixer_vt_write(Frame& F, const v4u (&v8)[2]) {
    LAS bf16* VT = (LAS bf16*)(F.lds + MX_VT);
#pragma unroll
    for (int i = 0; i < 2; ++i) { const int p = F.tid + 512 * i, jv = p >> 4, ev = (p & 15) * 8;
#pragma unroll
        for (int x = 0; x < 8; ++x) { const unsigned wv = (x < 2 ? v8[i].x : x < 4 ? v8[i].y : x < 6 ? v8[i].z : v8[i].w); VT[tsw(ev + x, jv)] = (bf16)((x & 1) ? (wv >> 16) : (wv & 0xffffu)); } }
}
#define KV_ITEM(K, GLA, ACC) do { const MixItem m = mix_item(vb, (K)); \
        if (GLA) mixer_bcum(F, R.g); \
        const v4u k8 = R.k8, va = R.v8[0], vbv = R.v8[1]; \
        __syncthreads();                                                      \
        { const int jq = F.tid >> 3, dq = (F.tid & 7) * 8; \
          _Pragma("unroll") for (int x = 0; x < 8; ++x) { const int d = dq + x; const unsigned wk = (x < 2 ? k8.x : x < 4 ? k8.y : x < 6 ? k8.z : k8.w); const float kf = (x & 1) ? bfhi(wk) : bflo(wk); \
              const float sc = (GLA) ? fexp2(B[63 * 65 + d] - B[jq * 65 + d]) : fexp2((float)(63 - jq) * l2g); \
              KL[tsw(d, jq)] = (bf16)f2bf(kf * sc); } } \
        { const v4u vv[2] = {va, vbv}; mixer_vt_write(F, vv); } \
        float dec4[4]; \
        _Pragma("unroll") for (int t = 0; t < 4; ++t) dec4[t] = (GLA) ? fexp2(B[63 * 65 + 16 * t + fr]) : g64; \
        if ((GLA) && F.tid < 64) { F.DEC[(size_t)m.item * 64 + F.tid] = cdG; cdG *= fexp2(B[63 * 65 + F.tid]); }     \
        if ((K) < 15) mixer_kv_load(F, mix_item(vb, (K) + 1), R);            \
        _Pragma("unroll") for (int t = 0; t < 4; ++t) _Pragma("unroll") for (int r = 0; r < 4; ++r) OT[(16 * F.wave + 4 * fq + r) * MS + 16 * t + fr] = (bf16)f2bf(ACC[t][r]);     \
        __syncthreads(); \
        { bf16* st = (bf16*)F.ST + (size_t)m.item * 8192; \
          _Pragma("unroll") for (int i = 0; i < 2; ++i) { const int idx = F.tid + 512 * i, e = idx >> 3, d = (idx & 7) * 8; *(GAS v4u*)(st + e * 64 + d) = *(const LAS v4u*)(OT + e * MS + d); } } \
        _Pragma("unroll") for (int t = 0; t < 4; ++t) ACC[t] = ACC[t] * dec4[t]; \
        _Pragma("unroll") for (int ks = 0; ks < 2; ++ks) { const bf16x8 aV = *(const LAS bf16x8*)(VT + tsw(16 * F.wave + fr, 32 * ks + 8 * fq)); \
            _Pragma("unroll") for (int t = 0; t < 4; ++t) { const bf16x8 bK = *(const LAS bf16x8*)(KL + tsw(16 * t + fr, 32 * ks + 8 * fq)); ACC[t] = __builtin_amdgcn_mfma_f32_16x16x32_bf16(aV, bK, ACC[t], 0, 0, 0); } } \
    } while (0)
__device__ __forceinline__ void mixer_kv_phase(Frame& F) {
    const int fr = F.lane & 15, fq = F.lane >> 4;
    LAS float* B = (LAS float*)(F.lds + MX_B); LAS bf16* KL = (LAS bf16*)(F.lds + MX_KE); LAS bf16* VT = (LAS bf16*)(F.lds + MX_VT); LAS bf16* OT = (LAS bf16*)(F.lds + MX_PT);
    for (int vb = F.vcu; vb < 256; vb += F.G) {
        __syncthreads();
        const int h = (vb >> 4) & 3; const float l2g = log2_gamma(h), g64 = fexp2(64.0f * l2g);
        mixer_stage_gate(F, h);
        MixKvRegs R; mixer_kv_load(F, mix_item(vb, 0), R);
        f32x4 accG[4], accR[4]; float cdG = 1.0f;
#pragma unroll
        for (int t = 0; t < 4; ++t) { accG[t] = (f32x4){0.f, 0.f, 0.f, 0.f}; accR[t] = (f32x4){0.f, 0.f, 0.f, 0.f}; }
        __syncthreads();
        for (int kk = 0; kk < 8; ++kk) { KV_ITEM(2 * kk, true, accG); KV_ITEM(2 * kk + 1, false, accR); }
        { const int b = vb >> 6, cg = vb & 15; const size_t gG = (size_t)((b * 8 + h) * 16 + cg), gR = (size_t)((b * 8 + 4 + h) * 16 + cg);
#pragma unroll
            for (int t = 0; t < 4; ++t)
#pragma unroll
                for (int r = 0; r < 4; ++r) { const int o = (16 * F.wave + 4 * fq + r) * 64 + 16 * t + fr; F.AGG[gG * 8192 + o] = accG[t][r]; F.AGG[gR * 8192 + o] = accR[t][r]; }
            if (F.tid < 64) { F.DAGG[gG * 64 + F.tid] = cdG; F.DAGG[gR * 64 + F.tid] = fexp2(512.0f * l2g); } }
    }
}
#undef KV_ITEM
__device__ __forceinline__ void mixer_scan(Frame& F) {
    for (int idx = F.vcu * 512 + F.tid; idx < NB * 8 * 4096; idx += F.G * 512) {
        const int bh = idx >> 12, ed = (idx & 4095) * 2, d = ed & 63; float s0 = 0.f, s1 = 0.f;
        f32x2_t a[16], dg[16];
#pragma unroll
        for (int g = 0; g < 16; ++g) { a[g] = *(const GAS f32x2_t*)(F.AGG + (size_t)(bh * 16 + g) * 8192 + ed); dg[g] = *(const GAS f32x2_t*)(F.DAGG + (size_t)(bh * 16 + g) * 64 + d); }
#pragma unroll
        for (int g = 0; g < 16; ++g) { *(GAS unsigned*)(F.SIN + (size_t)(bh * 16 + g) * 8192 + ed) = pk2(s0, s1); s0 = s0 * dg[g][0] + a[g][0]; s1 = s1 * dg[g][1] + a[g][1]; }
    }
}
struct MixOutRegs { v4u q8, k8, v8[2], p8[2], gt[2]; f32x4 g[4]; f32x4 cd[2]; };
__device__ __forceinline__ void mixer_out_load(Frame& F, const MixItem& m, MixOutRegs& R) {
    const bf16* Q = m.gla ? F.GQ : F.RQ; const bf16* K = m.gla ? F.GK : F.RK; const bf16* V = m.gla ? F.GV : F.RV; const bf16* GT = m.gla ? F.GG : F.RG;
    const int jq = F.tid >> 3, dq = (F.tid & 7) * 8;
    R.q8 = __builtin_nontemporal_load((const GAS v4u*)(Q + (m.t0 + jq) * 256 + m.h * 64 + dq));
    R.k8 = __builtin_nontemporal_load((const GAS v4u*)(K + (m.t0 + jq) * 256 + m.h * 64 + dq));
#pragma unroll
    for (int i = 0; i < 2; ++i) { const int p = F.tid + 512 * i; R.v8[i] = __builtin_nontemporal_load((const GAS v4u*)(V + (m.t0 + (p >> 4)) * 512 + m.h * 128 + (p & 15) * 8)); }
#pragma unroll
    for (int i = 0; i < 2; ++i) R.p8[i] = __builtin_nontemporal_load((const GAS v4u*)((const bf16*)F.ST + (size_t)m.item * 8192) + F.tid + 512 * i);
#pragma unroll
    for (int i = 0; i < 2; ++i) R.gt[i] = __builtin_nontemporal_load((const GAS v4u*)(GT + (m.t0 + jq) * 512 + m.h * 128 + (F.tid & 7) * 8 + 64 * i));
    if (m.gla) { const GAS f32x4* gr = (const GAS f32x4*)(F.GLR + (m.t0 + F.lane) * 16); R.g[0] = gr[0]; R.g[1] = gr[1]; R.g[2] = gr[2]; R.g[3] = gr[3];
        const GAS f32x4* cp = (const GAS f32x4*)(F.DEC + (size_t)m.item * 64 + (F.tid & 7) * 8); R.cd[0] = cp[0]; R.cd[1] = cp[1]; }
}
__device__ __forceinline__ void mixer_out_phase(Frame& F) {
    const int fr = F.lane & 15, fq = F.lane >> 4, w = F.wave;
    LAS bf16* QE = (LAS bf16*)(F.lds + MX_QE); LAS bf16* QN = (LAS bf16*)(F.lds + MX_QN); LAS bf16* KE = (LAS bf16*)(F.lds + MX_KE); LAS bf16* KN = (LAS bf16*)(F.lds + MX_KN);
    LAS bf16* VT = (LAS bf16*)(F.lds + MX_VT); LAS bf16* PT = (LAS bf16*)(F.lds + MX_PT); LAS bf16* P = (LAS bf16*)(F.lds + MX_P);
    LAS float* B = (LAS float*)(F.lds + MX_B); LAS float* RED = (LAS float*)(F.lds + MX_RED); LAS float* OUT = (LAS float*)(F.lds + MX_OUT);
    const int jq = F.tid >> 3, dq = (F.tid & 7) * 8;
#define MO_SEL(MSK, A, B) __builtin_bit_cast(float, (__builtin_bit_cast(unsigned, (A)) & (MSK)) | (__builtin_bit_cast(unsigned, (B)) & ~(MSK)))
#define MO_STAGE1(GLA, KC) do { const unsigned gm_ = (GLA) ? 0xffffffffu : 0u; const float rc_ = fexp2(64.0f * (float)(KC) * l2gb); \
        float cd_[8]; _Pragma("unroll") for (int x = 0; x < 8; ++x) { const float cg_ = (x < 4) ? R.cd[0][x & 3] : R.cd[1][x & 3]; cd_[x] = MO_SEL(gm_, cg_, rc_); } \
        _Pragma("unroll") for (int i_ = 0; i_ < 2; ++i_) { const int idx_ = F.tid + 512 * i_, e_ = idx_ >> 3, d_ = (idx_ & 7) * 8; const v4u l_ = R.p8[i_]; float v_[8]; \
            v_[0] = bflo(l_.x); v_[1] = bfhi(l_.x); v_[2] = bflo(l_.y); v_[3] = bfhi(l_.y); v_[4] = bflo(l_.z); v_[5] = bfhi(l_.z); v_[6] = bflo(l_.w); v_[7] = bfhi(l_.w); \
            { const v4u sg_ = sinG[i_], sr_ = sinR[i_]; const unsigned w0_ = (sg_.x & gm_) | (sr_.x & ~gm_), w1_ = (sg_.y & gm_) | (sr_.y & ~gm_), w2_ = (sg_.z & gm_) | (sr_.z & ~gm_), w3_ = (sg_.w & gm_) | (sr_.w & ~gm_); \
              v_[0] += cd_[0] * bflo(w0_); v_[1] += cd_[1] * bfhi(w0_); v_[2] += cd_[2] * bflo(w1_); v_[3] += cd_[3] * bfhi(w1_); \
              v_[4] += cd_[4] * bflo(w2_); v_[5] += cd_[5] * bfhi(w2_); v_[6] += cd_[6] * bflo(w3_); v_[7] += cd_[7] * bfhi(w3_); }     \
            *(LAS v4u*)(PT + e_ * MS + d_) = (v4u){pk2(v_[0], v_[1]), pk2(v_[2], v_[3]), pk2(v_[4], v_[5]), pk2(v_[6], v_[7])}; } \
        if (GLA) mixer_bcum(F, R.g); mixer_vt_write(F, R.v8); } while (0)
#define MO_IMAGES(GLA) do { const v4u q8_ = R.q8, k8_ = R.k8; \
        if (GLA) { float qf[8], kf[8], eb[8], en[8]; \
            _Pragma("unroll") for (int x = 0; x < 8; ++x) { const unsigned wq = (x < 2 ? q8_.x : x < 4 ? q8_.y : x < 6 ? q8_.z : q8_.w), wk = (x < 2 ? k8_.x : x < 4 ? k8_.y : x < 6 ? k8_.z : k8_.w); \
                qf[x] = (x & 1) ? bfhi(wq) : bflo(wq); kf[x] = (x & 1) ? bfhi(wk) : bflo(wk); const float bv = B[jq * 65 + dq + x]; eb[x] = fexp2(bv); en[x] = fexp2(-bv); } \
            *(LAS v4u*)(QE + jq * MS + dq) = (v4u){pk2(qf[0] * eb[0], qf[1] * eb[1]), pk2(qf[2] * eb[2], qf[3] * eb[3]), pk2(qf[4] * eb[4], qf[5] * eb[5]), pk2(qf[6] * eb[6], qf[7] * eb[7])}; \
            *(LAS v4u*)(QN + jq * MS + dq) = (v4u){pk2(qf[0] * en[0], qf[1] * en[1]), pk2(qf[2] * en[2], qf[3] * en[3]), pk2(qf[4] * en[4], qf[5] * en[5]), pk2(qf[6] * en[6], qf[7] * en[7])}; \
            *(LAS v4u*)(KE + jq * MS + dq) = (v4u){pk2(kf[0] * eb[0], kf[1] * eb[1]), pk2(kf[2] * eb[2], kf[3] * eb[3]), pk2(kf[4] * eb[4], kf[5] * eb[5]), pk2(kf[6] * eb[6], kf[7] * eb[7])}; \
            *(LAS v4u*)(KN + jq * MS + dq) = (v4u){pk2(kf[0] * en[0], kf[1] * en[1]), pk2(kf[2] * en[2], kf[3] * en[3]), pk2(kf[4] * en[4], kf[5] * en[5]), pk2(kf[6] * en[6], kf[7] * en[7])}; \
        } else { *(LAS v4u*)(QE + jq * MS + dq) = q8_; *(LAS v4u*)(KN + jq * MS + dq) = k8_; } } while (0)
    for (int vb = F.vcu; vb < 256; vb += F.G) {
        __syncthreads();
        mixer_stage_gate(F, (vb >> 4) & 3);
        MixOutRegs R; mixer_out_load(F, mix_item(vb, 0), R);
        const float l2gb = log2_gamma((vb >> 4) & 3);
        v4u sinG[2], sinR[2];
        { const int b_ = vb >> 6, h_ = (vb >> 4) & 3, cg_ = vb & 15; const size_t gG = (size_t)((b_ * 8 + h_) * 16 + cg_), gR = (size_t)((b_ * 8 + 4 + h_) * 16 + cg_);
#pragma unroll
            for (int i = 0; i < 2; ++i) { const int idx = F.tid + 512 * i, e = idx >> 3, d = (idx & 7) * 8;
                sinG[i] = *(const GAS v4u*)(F.SIN + gG * 8192 + e * 64 + d); sinR[i] = *(const GAS v4u*)(F.SIN + gR * 8192 + e * 64 + d); } }
        __syncthreads();
        v4u gc0, gc1, gn0, gn1;
        { const MixItem m0 = mix_item(vb, 0); MO_STAGE1(m0.gla, 0); gc0 = R.gt[0]; gc1 = R.gt[1]; gn0 = gc0; gn1 = gc1;
            __syncthreads();
            MO_IMAGES(m0.gla); mixer_out_load(F, mix_item(vb, 1), R);
            __syncthreads(); }
        for (int k = 0; k < 16; ++k) { const MixItem m = mix_item(vb, k); const bool gla = m.gla; const int h = m.h;
            const float l2g = log2_gamma(h);
            { const int mi = w >> 1;
#pragma unroll
                for (int t = 0; t < 2; ++t) { const int nj = (w & 1) * 2 + t; f32x4 lo = (f32x4){0.f, 0.f, 0.f, 0.f}, up = (f32x4){0.f, 0.f, 0.f, 0.f};
#pragma unroll
                    for (int ks = 0; ks < 2; ++ks) { const int ao = (16 * mi + fr) * MS + 32 * ks + 8 * fq, bo = (16 * nj + fr) * MS + 32 * ks + 8 * fq;
                        lo = __builtin_amdgcn_mfma_f32_16x16x32_bf16(*(const LAS bf16x8*)(QE + ao), *(const LAS bf16x8*)(KN + bo), lo, 0, 0, 0);
                        if (gla) up = __builtin_amdgcn_mfma_f32_16x16x32_bf16(*(const LAS bf16x8*)(QN + ao), *(const LAS bf16x8*)(KE + bo), up, 0, 0, 0); }
#pragma unroll
                    for (int r = 0; r < 4; ++r) { const int i = 16 * mi + 4 * fq + r, j = 16 * nj + fr; float pv;
                        if (gla) pv = (i >= j) ? lo[r] : up[r]; else pv = lo[r] * fexp2((float)(i >= j ? i - j : j - i) * l2g);
                        P[i * MS + j] = (bf16)f2bf(pv); } } }
            __syncthreads();
            const int mi = w & 3, nt0 = (w >> 2) * 4;
            f32x4 oi[4], oe[4];
#pragma unroll
            for (int t = 0; t < 4; ++t) { oi[t] = (f32x4){0.f, 0.f, 0.f, 0.f}; oe[t] = (f32x4){0.f, 0.f, 0.f, 0.f}; }
#pragma unroll
            for (int ks = 0; ks < 2; ++ks) { const int ao = (16 * mi + fr) * MS + 32 * ks + 8 * fq; const bf16x8 aP = *(const LAS bf16x8*)(P + ao), aQ = *(const LAS bf16x8*)(QE + ao);
#pragma unroll
                for (int t = 0; t < 4; ++t) { const int bo = (16 * (nt0 + t) + fr) * MS + 32 * ks + 8 * fq;
                    oi[t] = __builtin_amdgcn_mfma_f32_16x16x32_bf16(aP, *(const LAS bf16x8*)(VT + tsw(16 * (nt0 + t) + fr, 32 * ks + 8 * fq)), oi[t], 0, 0, 0);
                    oe[t] = __builtin_amdgcn_mfma_f32_16x16x32_bf16(aQ, *(const LAS bf16x8*)(PT + bo), oe[t], 0, 0, 0); } }
            float s1[4], s2[4];
#pragma unroll
            for (int r = 0; r < 4; ++r) { const int i = 16 * mi + 4 * fq + r; const float rs = gla ? 1.0f : fexp2((float)(i + 1) * l2g); s1[r] = 0.f; s2[r] = 0.f;
#pragma unroll
                for (int t = 0; t < 4; ++t) { const float o = oi[t][r] + rs * oe[t][r]; oi[t][r] = o; s1[r] += o; s2[r] += o * o; } }
#pragma unroll
            for (int r = 0; r < 4; ++r) {
                s1[r] += dppf<0xB1>(s1[r]); s1[r] += dppf<0x4E>(s1[r]); s1[r] += dppf<0x141>(s1[r]); s1[r] += dppf<0x140>(s1[r]);
                s2[r] += dppf<0xB1>(s2[r]); s2[r] += dppf<0x4E>(s2[r]); s2[r] += dppf<0x141>(s2[r]); s2[r] += dppf<0x140>(s2[r]);
                if (fr == 0) { const int i = 16 * mi + 4 * fq + r; RED[(i * 2 + (w >> 2)) * 2] = s1[r]; RED[(i * 2 + (w >> 2)) * 2 + 1] = s2[r]; } }
            __syncthreads();
#pragma unroll
            for (int r = 0; r < 4; ++r) { const int i = 16 * mi + 4 * fq + r;
                const float a1 = RED[i * 4] + RED[i * 4 + 2], a2 = RED[i * 4 + 1] + RED[i * 4 + 3];
                const float mu = gla ? 0.f : a1 * (1.f / 128.f); const float var = a2 * (1.f / 128.f) - mu * mu; const float rstd = 1.0f / sqrtf(var + LN_EPS);
#pragma unroll
                for (int t = 0; t < 4; ++t) { const int e = 16 * (nt0 + t) + fr;
                    OUT[i * OUTS + e] = gla ? oi[t][r] * rstd * F.gla_g[e] : (oi[t][r] - mu) * rstd * F.ret_g[h * 128 + e] + F.ret_b[h * 128 + e]; } }
            if (k < 15) { const MixItem mn = mix_item(vb, k + 1); MO_STAGE1(mn.gla, (k + 1) >> 1); gn0 = R.gt[0]; gn1 = R.gt[1]; }
            __syncthreads();
            { const int e0 = (F.tid & 7) * 8; const LAS f32x4* op = (const LAS f32x4*)(OUT + jq * OUTS + e0); float val[16];
#pragma unroll
                for (int x4 = 0; x4 < 4; ++x4) { const f32x4 o = op[(x4 & 1) + 16 * (x4 >> 1)]; val[4 * x4] = o.x; val[4 * x4 + 1] = o.y; val[4 * x4 + 2] = o.z; val[4 * x4 + 3] = o.w; }
#pragma unroll
                for (int x = 0; x < 16; ++x) { const v4u gv = x < 8 ? gc0 : gc1; const int xx = x & 7; const unsigned wg = (xx < 2 ? gv.x : xx < 4 ? gv.y : xx < 6 ? gv.z : gv.w); const float g = (xx & 1) ? bfhi(wg) : bflo(wg);
                    val[x] *= g * __builtin_amdgcn_rcpf(1.0f + fexp2(-g * LOG2E)); }
                v4u o0, o1;
                o0.x = pk2(val[0], val[1]); o0.y = pk2(val[2], val[3]); o0.z = pk2(val[4], val[5]); o0.w = pk2(val[6], val[7]);
                o1.x = pk2(val[8], val[9]); o1.y = pk2(val[10], val[11]); o1.z = pk2(val[12], val[13]); o1.w = pk2(val[14], val[15]);
                GAS v4u* dst = (GAS v4u*)(F.MIXED + (m.t0 + jq) * D + m.h8 * 128 + e0); dst[0] = o0; dst[8] = o1; }
            if (k < 15) { const MixItem mn = mix_item(vb, k + 1); MO_IMAGES(mn.gla); if (k < 14) mixer_out_load(F, mix_item(vb, k + 2), R); }
            gc0 = gn0; gc1 = gn1;
            __syncthreads();
        }
    }
#undef MO_STAGE1
#undef MO_SEL
#undef MO_IMAGES
}

__device__ __forceinline__ void p6_ln1_route(Frame& F) {
    LAS bf16* WB = (LAS bf16*)(F.lds + RING_OFF);
    f32x4 rw[16];
#pragma unroll
    for (int u = 0; u < 16; ++u) rw[u] = *((const GAS f32x4*)F.router_w + F.tid + 512 * u);
#pragma unroll
    for (int u = 0; u < 16; ++u) { const int idx = F.tid + 512 * u; const int c = idx >> 3, ch = idx & 7; const f32x4 wv = rw[u];
#pragma unroll
        for (int x = 0; x < 4; ++x) { const int e = 4 * ch + x; const float w = wv[x]; const unsigned hi = f2bf(w); const float rem = w - bf2f(hi);
            const int off = e * 2048 + ((((c >> 3) ^ (e & 15)) << 3) | (c & 7)); WB[off] = (bf16)hi; WB[off + 1024] = (bf16)f2bf(rem); } }
    LAS unsigned* lcnt = (LAS unsigned*)(F.lds + X_LCNT); LAS unsigned* lbase = (LAS unsigned*)(F.lds + X_LBASE); LAS unsigned* nasg = (LAS unsigned*)(F.lds + X_NASG); LAS unsigned* asg = (LAS unsigned*)(F.lds + X_ASG);
    const int gw = F.vcu * NWAVES + F.wave, NGW = F.G * NWAVES, lane = F.lane, r16 = lane & 15, cq = lane >> 4;
    const float rb0 = F.router_b[r16], rb1 = F.router_b[16 + r16];
    for (int base = 0; base < M / 16; base += NGW) {
        if (F.tid < 32) lcnt[F.tid] = 0u; if (F.tid == 32) nasg[0] = 0u;
        __syncthreads();
        const int tile = base + gw;
        if (tile < M / 16) {
            const int row = 16 * tile + r16;
            const bf16* xrow = (const bf16*)F.PRE1 + (size_t)row * D + 8 * cq;
            float sum = 0.f, sq = 0.f;
#pragma unroll 8
            for (int s = 0; s < 32; ++s) { const v4u x = *(const GAS v4u*)(xrow + 32 * s);
                const float f0 = bflo(x.x), f1 = bfhi(x.x), f2 = bflo(x.y), f3 = bfhi(x.y), f4 = bflo(x.z), f5 = bfhi(x.z), f6 = bflo(x.w), f7 = bfhi(x.w);
                sum += ((f0 + f1) + (f2 + f3)) + ((f4 + f5) + (f6 + f7)); sq += ((f0 * f0 + f1 * f1) + (f2 * f2 + f3 * f3)) + ((f4 * f4 + f5 * f5) + (f6 * f6 + f7 * f7)); }
            sum += __shfl_xor(sum, 16); sum += __shfl_xor(sum, 32); sq += __shfl_xor(sq, 16); sq += __shfl_xor(sq, 32);
            const float mean = sum * (1.f / D); const float rstd = 1.0f / sqrtf(fmaxf(sq * (1.f / D) - mean * mean, 0.f) + LN_EPS);
            f32x4 acc[2]; acc[0] = (f32x4){0.f, 0.f, 0.f, 0.f}; acc[1] = (f32x4){0.f, 0.f, 0.f, 0.f};
            int bt[2][4];
#pragma unroll
            for (int nt = 0; nt < 2; ++nt)
#pragma unroll
                for (int j = 0; j < 4; ++j) bt[nt][j] = (16 * nt + r16) * 2048 + (((4 * j + cq) ^ r16) << 3);
            GAS unsigned char* hq = (GAS unsigned char*)F.H1B + (size_t)row * D + 8 * cq;
            for (int s4 = 0; s4 < 8; ++s4) {
#pragma unroll
                for (int j = 0; j < 4; ++j) { const int s = 4 * s4 + j, c0 = 32 * s + 8 * cq; const v4u x = *(const GAS v4u*)(xrow + 32 * s);
                    const f32x4 ga = *(const GAS f32x4*)(F.ln1_g + c0), gb = *(const GAS f32x4*)(F.ln1_g + c0 + 4), ba = *(const GAS f32x4*)(F.ln1_b + c0), bb = *(const GAS f32x4*)(F.ln1_b + c0 + 4);
                    float h[8];
                    h[0] = (bflo(x.x) - mean) * rstd * ga[0] + ba[0]; h[1] = (bfhi(x.x) - mean) * rstd * ga[1] + ba[1]; h[2] = (bflo(x.y) - mean) * rstd * ga[2] + ba[2]; h[3] = (bfhi(x.y) - mean) * rstd * ga[3] + ba[3];
                    h[4] = (bflo(x.z) - mean) * rstd * gb[0] + bb[0]; h[5] = (bfhi(x.z) - mean) * rstd * gb[1] + bb[1]; h[6] = (bflo(x.w) - mean) * rstd * gb[2] + bb[2]; h[7] = (bfhi(x.w) - mean) * rstd * gb[3] + bb[3];
                    typedef unsigned u32x2_t __attribute__((ext_vector_type(2)));
                    *(GAS u32x2_t*)(hq + 32 * s) = (u32x2_t){pk4_fp8(h[0] * QS_H1, h[1] * QS_H1, h[2] * QS_H1, h[3] * QS_H1), pk4_fp8(h[4] * QS_H1, h[5] * QS_H1, h[6] * QS_H1, h[7] * QS_H1)};
                    v4u ahi, alo;
                    ahi.x = pk2(h[0], h[1]); ahi.y = pk2(h[2], h[3]); ahi.z = pk2(h[4], h[5]); ahi.w = pk2(h[6], h[7]);
                    alo.x = pk2(h[0] - bflo(ahi.x), h[1] - bfhi(ahi.x)); alo.y = pk2(h[2] - bflo(ahi.y), h[3] - bfhi(ahi.y)); alo.z = pk2(h[4] - bflo(ahi.z), h[5] - bfhi(ahi.z)); alo.w = pk2(h[6] - bflo(ahi.w), h[7] - bfhi(ahi.w));
                    const bf16x8 Ah = __builtin_bit_cast(bf16x8, ahi), Al = __builtin_bit_cast(bf16x8, alo);
#pragma unroll
                    for (int nt = 0; nt < 2; ++nt) { const LAS bf16* wp = WB + bt[nt][j] + s4 * 128;
                        const bf16x8 Bh = *(const LAS bf16x8*)wp, Bl = *(const LAS bf16x8*)(wp + 1024);
                        acc[nt] = __builtin_amdgcn_mfma_f32_16x16x32_bf16(Ah, Bh, acc[nt], 0, 0, 0);
                        acc[nt] = __builtin_amdgcn_mfma_f32_16x16x32_bf16(Ah, Bl, acc[nt], 0, 0, 0);
                        acc[nt] = __builtin_amdgcn_mfma_f32_16x16x32_bf16(Al, Bh, acc[nt], 0, 0, 0); } } }
#pragma unroll
            for (int reg = 0; reg < 4; ++reg) { const int trow = 16 * tile + 4 * cq + reg;
                float a0 = acc[0][reg] + rb0, a1 = acc[1][reg] + rb1; float tv[4]; int ti[4];
#pragma unroll
                for (int k = 0; k < 4; ++k) { float mx; int idx; if (a1 > a0) { mx = a1; idx = 16 + r16; } else { mx = a0; idx = r16; }
#define P6_STEP(OM, OI) { const float om = (OM); const int oi = (OI); if (om > mx || (om == mx && oi < idx)) { mx = om; idx = oi; } }
                    P6_STEP(dppf<0xB1>(mx), dppi<0xB1>(idx)) P6_STEP(dppf<0x4E>(mx), dppi<0x4E>(idx)) P6_STEP(dppf<0x141>(mx), dppi<0x141>(idx)) P6_STEP(dppf<0x140>(mx), dppi<0x140>(idx))
#undef P6_STEP
                    tv[k] = mx; ti[k] = idx; if (idx == r16) a0 = -3.0e38f; if (idx == 16 + r16) a1 = -3.0e38f; }
                const float e1 = expf(tv[1] - tv[0]), e2 = expf(tv[2] - tv[0]), e3 = expf(tv[3] - tv[0]); const float inv = 1.f / (1.f + e1 + e2 + e3);
                if (r16 < 4) { const float gk = (r16 == 0 ? 1.f : r16 == 1 ? e1 : r16 == 2 ? e2 : e3) * inv; const int ek = (r16 == 0 ? ti[0] : r16 == 1 ? ti[1] : r16 == 2 ? ti[2] : ti[3]);
                    const unsigned tk = (unsigned)(trow * 4 + r16);
                    const unsigned lp = __hip_atomic_fetch_add(lcnt + ek, 1u, __ATOMIC_RELAXED, __HIP_MEMORY_SCOPE_WORKGROUP); const unsigned sl = __hip_atomic_fetch_add(nasg, 1u, __ATOMIC_RELAXED, __HIP_MEMORY_SCOPE_WORKGROUP);
                    asg[sl] = tk | ((unsigned)ek << 17) | (lp << 22); asg[512 + sl] = __builtin_bit_cast(unsigned, gk); } }
        }
        __syncthreads();
        if (F.tid < 32) { const unsigned n = lcnt[F.tid]; lbase[F.tid] = n ? __hip_atomic_fetch_add(F.counts + F.tid, n, __ATOMIC_RELAXED, __HIP_MEMORY_SCOPE_AGENT) : 0u; }
        __syncthreads();
        const unsigned na = nasg[0];
        for (unsigned i = F.tid; i < na; i += 512) { const unsigned a = asg[i]; const unsigned tk = a & 0x1ffffu, e = (a >> 17) & 31u, lp = a >> 22; const size_t o = (size_t)e * M + lbase[e] + lp; F.list[o] = (int)tk; F.slotg[o] = __builtin_bit_cast(float, asg[512 + i]); F.tkslot[tk] = (int)((e << 20) | (lbase[e] + lp)); }
        __syncthreads();
    }
}
__device__ __forceinline__ int moe_tables(Frame& F) {
    LAS int* cnt = (LAS int*)(F.lds + X_CNT); LAS int* ts = (LAS int*)(F.lds + X_TSTART);
    __syncthreads();
    if (F.tid < 32) cnt[F.tid] = (int)__hip_atomic_load(F.counts + F.tid, __ATOMIC_RELAXED, __HIP_MEMORY_SCOPE_AGENT);
    __syncthreads();
    if (F.tid == 0) { int a = 0; for (int e = 0; e < 32; ++e) { ts[e] = a; a += (cnt[e] + 255) >> 8; } ts[32] = a; }
    __syncthreads();
    return __builtin_amdgcn_readfirstlane(ts[32]);
}
__device__ __forceinline__ void p10_final(Frame& F) {
    (void)moe_tables(F); const LAS int* ts = (const LAS int*)(F.lds + X_TSTART);
    const int gw = F.vcu * NWAVES + F.wave, NGW = F.G * NWAVES, lane = F.lane;
    typedef unsigned long long u64; typedef int i32x4v __attribute__((ext_vector_type(4))); typedef float f32x2v __attribute__((ext_vector_type(2)));
    const int cb = ((lane >> 1) & 1) * 128 + (lane >> 4) * 32 + ((lane >> 2) & 3) * 8 + 4 * (lane & 1);
    f32x4 g4[4], b4[4], g1[4], b1[4];
#pragma unroll
    for (int j = 0; j < 4; ++j) { g4[j] = *(const GAS f32x4*)(F.ln2_g + 256 * j + cb); b4[j] = *(const GAS f32x4*)(F.ln2_b + 256 * j + cb);
        g1[j] = *(const GAS f32x4*)(F.ln1_g + 256 * j + cb); b1[j] = *(const GAS f32x4*)(F.ln1_b + 256 * j + cb); }
    u64 nh[4]; unsigned ny[4][4]; i32x4v ns; int row = gw;
#define P10_SLOTS(R) do { ns = *((const GAS i32x4v*)F.tkslot + (R)); } while (0)
#define P10_LOAD(R) do { int sl_[4]; sl_[0] = ts[ns.x >> 20] * 256 + (ns.x & 0xfffff); sl_[1] = ts[ns.y >> 20] * 256 + (ns.y & 0xfffff); sl_[2] = ts[ns.z >> 20] * 256 + (ns.z & 0xfffff); sl_[3] = ts[ns.w >> 20] * 256 + (ns.w & 0xfffff); \
        _Pragma("unroll") for (int j = 0; j < 4; ++j) { nh[j] = __builtin_nontemporal_load((const GAS u64*)((const bf16*)F.PRE1 + (size_t)(R) * D + 256 * j + cb)); \
        _Pragma("unroll") for (int k = 0; k < 4; ++k) ny[j][k] = __builtin_nontemporal_load((const GAS unsigned*)((const GAS unsigned char*)F.Y + (size_t)sl_[k] * D) + lane + 64 * j); } } while (0)
    if (row < M) { P10_SLOTS(row); P10_LOAD(row); if (row + NGW < M) P10_SLOTS(row + NGW); }
    for (; row < M; row += NGW) {
        f32x4 v[4], y[4]; float s = 0.f;
#pragma unroll
        for (int j = 0; j < 4; ++j) { const unsigned lo = (unsigned)nh[j], hi = (unsigned)(nh[j] >> 32);
            v[j] = (f32x4){__builtin_bit_cast(float, lo << 16), __builtin_bit_cast(float, lo & 0xffff0000u), __builtin_bit_cast(float, hi << 16), __builtin_bit_cast(float, hi & 0xffff0000u)};
            s += (v[j].x + v[j].y) + (v[j].z + v[j].w);
            y[j] = (f32x4){0.f, 0.f, 0.f, 0.f};
#pragma unroll
            for (int k = 0; k < 4; ++k) { const f32x2v p0 = __builtin_amdgcn_cvt_pk_f32_fp8((int)ny[j][k], false), p1 = __builtin_amdgcn_cvt_pk_f32_fp8((int)ny[j][k], true);
                y[j].x += p0.x; y[j].y += p0.y; y[j].z += p1.x; y[j].w += p1.y; } }
        if (row + NGW < M) { P10_LOAD(row + NGW); if (row + 2 * NGW < M) P10_SLOTS(row + 2 * NGW); }
        const float mean1 = wave_sum(s) * (1.f / D); float q1 = 0.f;
#pragma unroll
        for (int j = 0; j < 4; ++j) { v[j] = v[j] - mean1; q1 += (v[j].x * v[j].x + v[j].y * v[j].y) + (v[j].z * v[j].z + v[j].w * v[j].w); }
        const float rstd1 = 1.f / sqrtf(wave_sum(q1) * (1.f / D) + LN_EPS);
        float s2 = 0.f;
#pragma unroll
        for (int j = 0; j < 4; ++j) { v[j] = (v[j] * rstd1 * g1[j] + b1[j]) * ALPHA + y[j] * (1.0f / QS_Y); s2 += (v[j].x + v[j].y) + (v[j].z + v[j].w); }
        const float mean = wave_sum(s2) * (1.f / D); float q2 = 0.f;
#pragma unroll
        for (int j = 0; j < 4; ++j) { v[j] = v[j] - mean; q2 += (v[j].x * v[j].x + v[j].y * v[j].y) + (v[j].z * v[j].z + v[j].w * v[j].w); }
        const float rstd = 1.f / sqrtf(wave_sum(q2) * (1.f / D) + LN_EPS);
        float* hr = F.out + (size_t)row * D + cb;
#pragma unroll
        for (int j = 0; j < 4; ++j) __builtin_nontemporal_store(v[j] * rstd * g4[j] + b4[j], (GAS f32x4*)(hr + 256 * j));
    }
#undef P10_LOAD
#undef P10_SLOTS
}

struct Args { const void* in[21]; float* out; unsigned char* ws; int ph_lo, ph_hi; };
__global__ void __launch_bounds__(NWAVES * 64, 2) fwd_kernel(Args args) {
    extern __shared__ __attribute__((aligned(16))) unsigned char lds[];
    Frame F;
    F.lds = (LAS unsigned char*)lds;
    F.MISC = (volatile LAS unsigned*)(F.lds + MISC_OFF);
    F.tid = threadIdx.x; F.lane = F.tid & 63; F.wave = __builtin_amdgcn_readfirstlane(F.tid >> 6);
    F.G = gridDim.x; { const int bx = blockIdx.x; F.vcu = (F.G % 8 == 0) ? (bx % 8) * (F.G / 8) + bx / 8 : bx; }
    unsigned char* ws = args.ws;
    F.ctl = (gu32*)(ws + WS_CTL);
    F.x = (const float*)args.in[0]; F.positions = (const int*)args.in[1]; F.ln_in_g = (const float*)args.in[2]; F.ln_in_b = (const float*)args.in[3];
    F.w_in = (const float*)args.in[4]; F.gate_w = (const float*)args.in[5]; F.gate_b = (const float*)args.in[6]; F.gla_g = (const float*)args.in[7];
    F.ret_g = (const float*)args.in[8]; F.ret_b = (const float*)args.in[9]; F.w_out = (const float*)args.in[10]; F.ln1_g = (const float*)args.in[11]; F.ln1_b = (const float*)args.in[12];
    F.router_w = (const float*)args.in[13]; F.router_b = (const float*)args.in[14]; F.w1 = (const float*)args.in[15]; F.b1 = (const float*)args.in[16];
    F.w2 = (const float*)args.in[17]; F.b2 = (const float*)args.in[18]; F.ln2_g = (const float*)args.in[19]; F.ln2_b = (const float*)args.in[20];
    F.out = args.out;
    F.stats0 = (float*)(ws + WS_STATS0); F.cosT = (float*)(ws + WS_COS); F.sinT = (float*)(ws + WS_SIN); F.ST = (float*)(ws + WS_ST); F.DEC = (float*)(ws + WS_DEC); F.PRE1 = (float*)(ws + WS_PRE1);
    F.AGG = (float*)(ws + WS_AGG); F.SIN = (bf16*)(ws + WS_SINS); F.DAGG = (float*)(ws + WS_DAGG); F.GLR = (float*)(ws + WS_PROJ + PJ_GLR); F.gates = (float*)(ws + WS_GATES);
    F.WinT = (bf16*)(ws + WS_WINT); F.WoT = (bf16*)(ws + WS_WOT); F.W1T = (bf16*)(ws + WS_W1T); F.W2T = (bf16*)(ws + WS_W2T); F.H0B = (bf16*)(ws + WS_H0B); F.MIXED = (bf16*)(ws + WS_MIXED);
    F.GQ = (bf16*)(ws + WS_PROJ + PJ_GQ); F.GK = (bf16*)(ws + WS_PROJ + PJ_GK); F.GV = (bf16*)(ws + WS_PROJ + PJ_GV); F.GG = (bf16*)(ws + WS_PROJ + PJ_GG);
    F.RQ = (bf16*)(ws + WS_PROJ + PJ_RQ); F.RK = (bf16*)(ws + WS_PROJ + PJ_RK); F.RV = (bf16*)(ws + WS_PROJ + PJ_RV); F.RG = (bf16*)(ws + WS_PROJ + PJ_RG);
    F.H1B = (bf16*)(ws + WS_H1B); F.XS = (bf16*)(ws + WS_XS); F.ACT = (bf16*)(ws + WS_ACT); F.Y = (bf16*)(ws + WS_Y);
    F.list = (int*)(ws + WS_LIST); F.slotg = (float*)(ws + WS_SLOTG); F.tkslot = (int*)(ws + WS_GATES); F.counts = (unsigned*)(ws + WS_CTL) + CW_COUNTS;
    for (int u = F.tid; u < (LDS_BYTES - LDSCTL_OFF) / 4; u += NWAVES * 64) ((LAS unsigned*)(F.lds + LDSCTL_OFF))[u] = 0u;
    __syncthreads();
    const int lo = args.ph_lo, hi = args.ph_hi;
    const bool multi = (hi - lo) > 1;
    XcdBarrier bar; bar.bar = (unsigned*)(F.ctl + CW_BAR); bar.x = 0; bar.st = nullptr;
    if (multi) bar = xcd_barrier_post((unsigned*)(F.ctl + CW_BAR), F.MISC + 8);
#define IN(k) (lo <= (k) && (k) < hi)
#define SEAM(k) do { if (IN(k) && (IN((k) + 1) || ((k) == 6 && IN(8)))) xcd_barrier(bar); } while (0)

    if (IN(0)) { p0_prologue(F); SEAM(0); }
    if (IN(1)) { {
        pg8::Gemm g{F.H0B, F.WinT, M, NPROJ_T * 256, D, nullptr}; pg8::StaticOrder S; S.init(M, NPROJ_T * 256, F.G, (int)blockIdx.x);
        pg8::EpiProj E{F.GQ, F.GK, F.GV, F.GG, F.RQ, F.RK, F.RV, F.RG, F.GLR, F.cosT, F.sinT};
        pg8::gemm_phase<pg8::EpiProj, pg8::StaticOrder, true, true>(F.lds + RING_OFF, g, S, E); }
        SEAM(1);
    }
    if (IN(2)) { mixer_kv_phase(F); SEAM(2); }
    if (IN(3)) { mixer_scan(F); SEAM(3); }
    if (IN(4)) { mixer_out_phase(F); SEAM(4); }
    if (IN(5)) { {
        pg8::Gemm g{F.MIXED, F.WoT, M, D, D, nullptr}; pg8::StaticOrder S; S.init(M, D, F.G, (int)blockIdx.x);
        pg8::EpiOutProj E{F.H0B, (bf16*)F.PRE1, ALPHA};
        pg8::gemm_phase<pg8::EpiOutProj, pg8::StaticOrder, true, true>(F.lds + RING_OFF, g, S, E); }
        SEAM(5);
    }
    if (IN(6)) { p6_ln1_route(F); SEAM(6); }
    if (IN(8)) {
        const int ntiles = moe_tables(F);
        pg8::GroupedOrder S; S.init(ntiles, 8, F.G, (int)blockIdx.x, (const LAS int*)(F.lds + X_TSTART));
        { LAS unsigned* gtab = (LAS unsigned*)(F.lds + X_GTAB); const LAS int* cntl = (const LAS int*)(F.lds + X_CNT); pg8::Unit u;
            for (int i = 0; i < GT_MAXU && S.next(i, u); ++i) if (F.tid < 256) { const int lr = u.lt * 256 + F.tid;
                gtab[i * 256 + F.tid] = (lr < cntl[u.e]) ? (unsigned)(F.list[(size_t)u.e * M + lr] >> 2) * (unsigned)D : 0u; }
            __syncthreads(); }
        pg8::Gemm g{F.H1B, F.W1T, M, 2 * DFF, D, (const LAS unsigned*)(F.lds + X_GTAB)};
        pg8::EpiSwiGLU E{(unsigned char*)F.ACT, F.b1, 1.0f / (QS_H1 * QS_W)};
        pg8::gemm_phase<pg8::EpiSwiGLU, pg8::GroupedOrder, true, true, 1, true>(F.lds + RING_OFF, g, S, E);
        SEAM(8);
    }
    if (IN(9)) { {
        const int ntiles = moe_tables(F);
        pg8::Gemm g{F.ACT, F.W2T, ntiles * 256, D, DFF, nullptr}; pg8::GroupedOrder S; S.init(ntiles, 4, F.G, (int)blockIdx.x, (const LAS int*)(F.lds + X_TSTART));
        { LAS float* gt = (LAS float*)(F.lds + X_GTAB); const LAS int* cntl = (const LAS int*)(F.lds + X_CNT); pg8::Unit u;
            for (int i = 0; i < GT_MAXU && S.next(i, u); ++i) if (F.tid < 256) { const int lr = u.lt * 256 + F.tid; gt[i * 256 + F.tid] = (lr < cntl[u.e]) ? F.slotg[(size_t)u.e * M + lr] : 0.f; }
            __syncthreads(); }
        pg8::EpiMoeOut E{(unsigned char*)F.Y, F.b2, (const LAS float*)(F.lds + X_GTAB), 1.0f / (QS_ACT * QS_W)};
        pg8::gemm_phase<pg8::EpiMoeOut, pg8::GroupedOrder, true, true, 1>(F.lds + RING_OFF, g, S, E); }
        SEAM(9);
    }
    if (IN(10)) { p10_final(F); }
#undef IN
#undef SEAM
}

extern "C" void kernel_launch(void* const* d_in, const int* in_sizes, int n_in, void* d_out, int out_size, void* d_ws, size_t ws_size, hipStream_t stream) {
    static int grid = 0;
    if (grid == 0) {
        if (n_in != 21 || out_size != M * D || ws_size < WS_END) { fprintf(stderr, "kernel_launch: unexpected problem (n_in %d, out %d, ws %zu)\n", n_in, out_size, ws_size); grid = -1; return; }
        int dev = 0, cus = 0;
        if (hipGetDevice(&dev) != hipSuccess || hipDeviceGetAttribute(&cus, hipDeviceAttributeMultiprocessorCount, dev) != hipSuccess) { grid = -1; return; }
        if (hipFuncSetAttribute((const void*)fwd_kernel, hipFuncAttributeMaxDynamicSharedMemorySize, LDS_BYTES) != hipSuccess) { fprintf(stderr, "kernel_launch: hipFuncSetAttribute failed\n"); grid = -1; return; }
        (void)hipGetLastError();
        grid = cus;
    }
    if (grid < 0) return;
    if (hipMemsetAsync((char*)d_ws + WS_CTL, 0, CTL_ZERO_BYTES, stream) != hipSuccess) return;
    Args a{};
    for (int i = 0; i < 21; ++i) a.in[i] = d_in[i];
    a.out = (float*)d_out; a.ws = (unsigned char*)d_ws;
    constexpr int NL = MK_N_LAUNCHES;
    for (int li = 0; li < NL; ++li) {
        a.ph_lo = (NL == 1) ? 0 : li; a.ph_hi = (NL == 1) ? NPH : li + 1;
        hipLaunchKernelGGL(fwd_kernel, dim3(grid), dim3(NWAVES * 64), LDS_BYTES, stream, a);
    }
}
```

```cpp
#include <hip/hip_runtime.h>
#include <cstdio>
#include <cstdint>

#ifndef MK_N_LAUNCHES
#define MK_N_LAUNCHES 1
#endif

constexpr int NB = 4, SEQ = 8192, D = 1024, M = NB * SEQ, CH = 64, NCH = SEQ / CH;
constexpr int PW = 3088, NE = 32, DFF = 1024;
constexpr int NPROJ_T = 12;
constexpr float LN_EPS = 1e-5f;
constexpr float ALPHA = 1.189207115002721f;
constexpr int MAXTILES = (M * 4) / 256 + NE;
constexpr int NITEM = NB * 8 * NCH;
constexpr float QS_H1 = 16.0f, QS_W = 256.0f, QS_ACT = 4.0f, QS_Y = 64.0f;
__device__ __forceinline__ float clamp448(float v) { return __builtin_fminf(__builtin_fmaxf(v, -448.0f), 448.0f); }
__device__ __forceinline__ unsigned pk4_fp8(float a, float b, float c, float d) {
    int w = __builtin_amdgcn_cvt_pk_fp8_f32(clamp448(a), clamp448(b), 0, false); w = __builtin_amdgcn_cvt_pk_fp8_f32(clamp448(c), clamp448(d), w, true); return (unsigned)w; }

namespace pg8 {
#define PG8_LAS __attribute__((address_space(3)))
typedef unsigned short bf16_t;
typedef short bf16x8 __attribute__((ext_vector_type(8)));
typedef float f32x4 __attribute__((ext_vector_type(4)));
typedef unsigned u32x4 __attribute__((ext_vector_type(4)));
typedef int i32x4 __attribute__((ext_vector_type(4)));
typedef int i32x8 __attribute__((ext_vector_type(8)));
__device__ __forceinline__ i32x8 cat8(bf16x8 lo, bf16x8 hi) { return __builtin_shufflevector(__builtin_bit_cast(i32x4, lo), __builtin_bit_cast(i32x4, hi), 0, 1, 2, 3, 4, 5, 6, 7); }
constexpr int BM = 256, BK = 64, HALF = 128, HTB = HALF * BK * 2  , STAGE_BYTES = 8 * HTB, NXCD = 8, WGM = 8;

__host__ __device__ __forceinline__ int lds_byte(int r, int c) { const int st = (r >> 4) * 2 + (c >> 5), rr = r & 15, cc = c & 31, ob = rr * 64 + cc * 2; return st * 1024 + (ob ^ (((ob >> 9) & 1) << 5)); }
__host__ __device__ __forceinline__ void stage_rc(int b, int& R, int& C) { const int st = b / 1024, sb = b % 1024, swz = sb ^ (((sb >> 9) & 1) << 5); R = (st >> 1) * 16 + swz / 64; C = (st & 1) * 32 + (swz % 64) / 2; }
__host__ __device__ __forceinline__ int perm32(int rho) { const int n = rho >> 4, i = rho & 15; return 8 * (i >> 2) + 4 * n + (i & 3); }

struct Unit { int pm, pn, e, lt, ui; };
struct Gemm { const bf16_t* A; const bf16_t* Bt; int M, N, K; const PG8_LAS unsigned* gtab; };

struct StaticOrder {
    int nM, nN, nwg, G, c;
    __host__ __device__ void init(int M, int N, int G_, int c_) { nM = M / BM; nN = N / BM; nwg = nM * nN; G = G_; c = c_; }
    __host__ __device__ bool next(int i, Unit& u) const {
        const int L = i * G + c; if (L >= nwg) return false;
        int wgid = L; { const int q = nwg / NXCD, r = nwg % NXCD, xcd = wgid % NXCD, off = wgid / NXCD; wgid = (xcd < r ? xcd * (q + 1) : r * (q + 1) + (xcd - r) * q) + off; }
        const int nig = WGM * nN, gid = wgid / nig, fm = gid * WGM, gsz = (nM - fm) < WGM ? (nM - fm) : WGM;
        u.pm = fm + ((wgid % nig) % gsz); u.pn = (wgid % nig) / gsz; u.e = 0; u.lt = 0; u.ui = i; return true;
    }
    __device__ __forceinline__ void a_ready(const Unit&) const {}
    __device__ __forceinline__ void done(const Unit&) const {}
};


struct GroupedOrder {
    StaticOrder so; const PG8_LAS int* tstart; int nN;
    __device__ __forceinline__ void init(int total_tiles, int nN_, int G_, int c_, const PG8_LAS int* ts) { so.init(total_tiles * BM, nN_ * BM, G_, c_); nN = nN_; tstart = ts; }
    __device__ __forceinline__ bool next(int i, Unit& u) const {
        if (!so.next(i, u)) return false;
        int e = 0;
#pragma unroll
        for (int k = 1; k < 32; ++k) e += (u.pm >= tstart[k]) ? 1 : 0;
        e = __builtin_amdgcn_readfirstlane(e);
        u.e = e; u.lt = u.pm - __builtin_amdgcn_readfirstlane(tstart[e]); u.pn = e * nN + u.pn; return true;
    }
    __device__ __forceinline__ void a_ready(const Unit&) const {}
    __device__ __forceinline__ void done(const Unit&) const {}
};

struct RowMajorOrder {
    const PG8_LAS int* tstart; int nN, ntiles, G, vcu;
    __device__ __forceinline__ void init(int total_tiles, int nN_, int G_, int vcu_, const PG8_LAS int* ts) { ntiles = total_tiles; nN = nN_; G = G_; vcu = vcu_; tstart = ts; }
    __device__ __forceinline__ bool next(int i, Unit& u) const {
        const int full = ntiles / G;
        int pm, j;
        if (i < full * nN) { pm = vcu + G * (i / nN); j = i % nN; }
        else { const int r = (i - full * nN) * G + vcu; pm = full * G + r / nN; j = r % nN; if (pm >= ntiles) return false; }
        int e = 0;
#pragma unroll
        for (int k = 1; k < 32; ++k) e += (pm >= tstart[k]) ? 1 : 0;
        e = __builtin_amdgcn_readfirstlane(e);
        u.pm = pm; u.e = e; u.lt = pm - __builtin_amdgcn_readfirstlane(tstart[e]); u.pn = e * nN + j; u.ui = i; return true;
    }
    __device__ __forceinline__ void a_ready(const Unit&) const {}
    __device__ __forceinline__ void done(const Unit&) const {}
};

__device__ __forceinline__ unsigned cvt_pk_bf16(float lo, float hi) { unsigned r; asm volatile("v_cvt_pk_bf16_f32 %0, %1, %2" : "=v"(r) : "v"(lo), "v"(hi)); return r; }
__device__ __forceinline__ u32x4 pack8(const f32x4 a, const f32x4 b) { u32x4 w; w.x = cvt_pk_bf16(a[0], a[1]); w.y = cvt_pk_bf16(a[2], a[3]); w.z = cvt_pk_bf16(b[0], b[1]); w.w = cvt_pk_bf16(b[2], b[3]); return w; }


typedef float f2 __attribute__((ext_vector_type(2)));
struct NoPre {};
struct NoSeed {};
#define PG8_ZERO_ACC(acc) do { _Pragma("unroll") for (int a_ = 0; a_ < 2; ++a_) _Pragma("unroll") for (int b_ = 0; b_ < 2; ++b_) _Pragma("unroll") for (int m_ = 0; m_ < 4; ++m_) _Pragma("unroll") for (int n_ = 0; n_ < 2; ++n_) acc[a_][b_][m_][n_] = (f32x4){0.f, 0.f, 0.f, 0.f}; } while (0)
struct EpiProj {
    static constexpr bool PERM = true, AFTER_DRAIN = false; static constexpr int NST = -1;     typedef NoPre Pre; typedef NoSeed Seed;
    __device__ __forceinline__ void seed_load(Seed&, const Unit&, int, int, int, int) const {}
    __device__ __forceinline__ void seed_acc(f32x4 (&acc)[2][2][4][2], const Seed&) const { PG8_ZERO_ACC(acc); }
    __device__ __forceinline__ void prefetch(Pre&, const Unit&, int, int, int, int) const {}
    bf16_t *GQ, *GK, *GV, *GG, *RQ, *RK, *RV, *RG; float* GLR; const float* cosT; const float* sinT;
    __device__ __forceinline__ void operator()(const f32x4 (&acc)[2][2][4][2], const Unit& u, int wr, int wc, int fr, int fq, const Pre& pre) const {
        asm volatile("" : "+v"(fr), "+v"(fq));
        const int row0 = u.pm * BM + wr * 64 + fr; const int t = u.pn;
        if (t == 6 || t == 7) {
            bf16_t* O = (t == 6) ? RQ : RK; const float sc = (t == 6) ? 1.0f : 0.125f;
#pragma unroll
            for (int ai = 0; ai < 2; ++ai)
#pragma unroll
                for (int m = 0; m < 4; ++m) { const int row = row0 + ai * HALF + m * 16;
                    const f32x4 c0 = *(const f32x4*)(cosT + (size_t)row * 32 + 8 * fq), c1 = *(const f32x4*)(cosT + (size_t)row * 32 + 8 * fq + 4);
                    const f32x4 s0 = *(const f32x4*)(sinT + (size_t)row * 32 + 8 * fq), s1 = *(const f32x4*)(sinT + (size_t)row * 32 + 8 * fq + 4);
                    const f32x4 a0 = acc[ai][0][m][0], a1 = acc[ai][0][m][1], b0 = acc[ai][1][m][0], b1 = acc[ai][1][m][1];
                    const f32x4 o10 = (a0 * c0 - b0 * s0) * sc, o11 = (a1 * c1 - b1 * s1) * sc, o20 = (a0 * s0 + b0 * c0) * sc, o21 = (a1 * s1 + b1 * c1) * sc;
                    bf16_t* rp = O + (size_t)row * 256 + wc * 64 + 8 * fq;
                    *(u32x4*)rp = pack8(o10, o11); *(u32x4*)(rp + 32) = pack8(o20, o21); }
        } else if (t == 12) {
            if (wc == 0 && fq < 2) {
#pragma unroll
                for (int ai = 0; ai < 2; ++ai)
#pragma unroll
                    for (int m = 0; m < 4; ++m) { const int row = row0 + ai * HALF + m * 16; float* rp = GLR + (size_t)row * 16 + 8 * fq;
                        *(f32x4*)rp = acc[ai][0][m][0]; *(f32x4*)(rp + 4) = acc[ai][0][m][1]; }
            }
        } else {
            bf16_t* O; int ldc, cb; float sc = 1.0f;
            if (t == 0) { O = GQ; ldc = 256; cb = 0; sc = 0.125f; } else if (t == 1) { O = GK; ldc = 256; cb = 0; }
            else if (t < 4) { O = GV; ldc = 512; cb = (t - 2) * 256; } else if (t < 6) { O = GG; ldc = 512; cb = (t - 4) * 256; }
            else if (t < 10) { O = RV; ldc = 512; cb = (t - 8) * 256; } else { O = RG; ldc = 512; cb = (t - 10) * 256; }
            const int col0 = cb + wc * 32 + 8 * fq;
#pragma unroll
            for (int ai = 0; ai < 2; ++ai)
#pragma unroll
                for (int m = 0; m < 4; ++m) { bf16_t* rp = O + (size_t)(row0 + ai * HALF + m * 16) * ldc + col0;
#pragma unroll
                    for (int bj = 0; bj < 2; ++bj) *(u32x4*)(rp + bj * HALF) = pack8(acc[ai][bj][m][0] * sc, acc[ai][bj][m][1] * sc); }
        }
    }
};

struct EpiOutProj {
    static constexpr bool PERM = true, AFTER_DRAIN = false; static constexpr int NST = 16;     typedef NoPre Pre; typedef NoSeed Seed;
    __device__ __forceinline__ void seed_load(Seed&, const Unit&, int, int, int, int) const {}
    __device__ __forceinline__ void seed_acc(f32x4 (&acc)[2][2][4][2], const Seed&) const { PG8_ZERO_ACC(acc); }
    __device__ __forceinline__ void prefetch(Pre&, const Unit&, int, int, int, int) const {}
    const bf16_t* h0b; bf16_t* out; float alpha;
    __device__ __forceinline__ void operator()(const f32x4 (&acc)[2][2][4][2], const Unit& u, int wr, int wc, int fr, int fq, const Pre& pre) const {
        asm volatile("" : "+v"(fr), "+v"(fq));
        const int row0 = u.pm * BM + wr * 64 + fr, col0 = u.pn * BM + wc * 32 + 8 * fq;
#pragma unroll
        for (int ai = 0; ai < 2; ++ai)
#pragma unroll
            for (int m = 0; m < 4; ++m) { const size_t off = (size_t)(row0 + ai * HALF + m * 16) * D + col0;
                u32x4 hv[2];
#pragma unroll
                for (int bj = 0; bj < 2; ++bj) hv[bj] = *(const u32x4*)(h0b + off + bj * HALF);
#pragma unroll
                for (int bj = 0; bj < 2; ++bj) { f32x4 a0, a1;
                    a0[0] = __builtin_bit_cast(float, hv[bj].x << 16); a0[1] = __builtin_bit_cast(float, hv[bj].x & 0xffff0000u); a0[2] = __builtin_bit_cast(float, hv[bj].y << 16); a0[3] = __builtin_bit_cast(float, hv[bj].y & 0xffff0000u);
                    a1[0] = __builtin_bit_cast(float, hv[bj].z << 16); a1[1] = __builtin_bit_cast(float, hv[bj].z & 0xffff0000u); a1[2] = __builtin_bit_cast(float, hv[bj].w << 16); a1[3] = __builtin_bit_cast(float, hv[bj].w & 0xffff0000u);
                    *(u32x4*)(out + off + bj * HALF) = pack8(a0 * alpha + acc[ai][bj][m][0], a1 * alpha + acc[ai][bj][m][1]); }
                asm volatile("" ::: "memory"); }
    }
};

struct EpiSwiGLU {
    static constexpr bool PERM = true, AFTER_DRAIN = false; static constexpr int NST = -1;     typedef NoPre Pre;
    struct Seed { f32x4 g0, g1, l0, l1; };
    __device__ __forceinline__ void seed_load(Seed& sd, const Unit& u, int wr, int wc, int fr, int fq) const {
        asm volatile("" : "+v"(fq));
        const int e = u.e, jt = u.pn - e * 8; const int colc = jt * 128 + wc * 32 + 8 * fq; const float* bp = b1 + (size_t)e * 2048 + colc;
        sd.g0 = *(const f32x4*)bp; sd.g1 = *(const f32x4*)(bp + 4); sd.l0 = *(const f32x4*)(bp + 1024); sd.l1 = *(const f32x4*)(bp + 1028);
    }
    __device__ __forceinline__ void seed_acc(f32x4 (&acc)[2][2][4][2], const Seed& sd) const {
        const float inv = QS_H1 * QS_W; const f32x4 g0 = sd.g0 * inv, g1 = sd.g1 * inv, l0 = sd.l0 * inv, l1 = sd.l1 * inv;
#pragma unroll
        for (int ai = 0; ai < 2; ++ai)
#pragma unroll
            for (int m = 0; m < 4; ++m) { acc[ai][0][m][0] = g0; acc[ai][0][m][1] = g1; acc[ai][1][m][0] = l0; acc[ai][1][m][1] = l1; }
    }
    __device__ __forceinline__ void prefetch(Pre&, const Unit&, int, int, int, int) const {}
    unsigned char* ACT; const float* b1; float asc;
    __device__ __forceinline__ void operator()(const f32x4 (&acc)[2][2][4][2], const Unit& u, int wr, int wc, int fr, int fq, const Pre& pre) const {
        asm volatile("" : "+v"(fr), "+v"(fq));
        const int e = u.e, jt = u.pn - e * 8; const int colc = jt * 128 + wc * 32 + 8 * fq;
        const int row0 = u.pm * BM + wr * 64 + fr;
        const float inv = QS_H1 * QS_W; const f2 kc = {asc * (-1.702f * 1.4426950408889634f), asc * (-1.702f * 1.4426950408889634f)}, one = {1.0f, 1.0f}, q2 = {QS_ACT * asc * asc, QS_ACT * asc * asc}, q1 = {QS_ACT * asc, QS_ACT * asc};
#pragma unroll
        for (int ai = 0; ai < 2; ++ai)
#pragma unroll
            for (int m = 0; m < 4; ++m) { typedef unsigned u32x2_t __attribute__((ext_vector_type(2))); u32x2_t w;
#pragma unroll
                for (int n = 0; n < 2; ++n) { int wv = 0;
#pragma unroll
                    for (int p = 0; p < 2; ++p) {
                        f2 mg, ml, ex, rc; const f32x4 ag = acc[ai][0][m][n], al = acc[ai][1][m][n];
                        mg.x = __builtin_amdgcn_fmed3f(ag[2 * p], -3.0e38f, 7.0f * inv); mg.y = __builtin_amdgcn_fmed3f(ag[2 * p + 1], -3.0e38f, 7.0f * inv);
                        ml.x = __builtin_amdgcn_fmed3f(al[2 * p], -7.0f * inv, 7.0f * inv); ml.y = __builtin_amdgcn_fmed3f(al[2 * p + 1], -7.0f * inv, 7.0f * inv);
                        const f2 t = mg * kc;
                        ex.x = __builtin_amdgcn_exp2f(t.x); ex.y = __builtin_amdgcn_exp2f(t.y);
                        const f2 dn = ex + one;
                        rc.x = __builtin_amdgcn_rcpf(dn.x); rc.y = __builtin_amdgcn_rcpf(dn.y);
                        const f2 o = (mg * rc) * (ml * q2 + q1);
                        wv = p ? __builtin_amdgcn_cvt_pk_fp8_f32(o.x, o.y, wv, true) : __builtin_amdgcn_cvt_pk_fp8_f32(o.x, o.y, 0, false); }
                    w[n] = (unsigned)wv; }
                *(u32x2_t*)(ACT + (size_t)(row0 + ai * HALF + m * 16) * DFF + colc) = w; }
    }
};

struct EpiMoeOut {
    static constexpr bool PERM = true, AFTER_DRAIN = false; static constexpr int NST = 8;     typedef NoPre Pre;
    struct Seed { f32x4 bv[2][2]; };
    __device__ __forceinline__ void seed_load(Seed& sd, const Unit& u, int wr, int wc, int fr, int fq) const {
        asm volatile("" : "+v"(fq));
        const int e = u.e, jt = u.pn - e * 4; const int col0 = jt * 256 + wc * 32 + 8 * fq;
#pragma unroll
        for (int bj = 0; bj < 2; ++bj)
#pragma unroll
            for (int n = 0; n < 2; ++n) sd.bv[bj][n] = *(const f32x4*)(b2 + (size_t)e * D + col0 + bj * HALF + 4 * n);
    }
    __device__ __forceinline__ void seed_acc(f32x4 (&acc)[2][2][4][2], const Seed& sd) const {
        const float inv = QS_ACT * QS_W;
#pragma unroll
        for (int bj = 0; bj < 2; ++bj)
#pragma unroll
            for (int n = 0; n < 2; ++n) { const f32x4 v = sd.bv[bj][n] * inv;
#pragma unroll
                for (int ai = 0; ai < 2; ++ai)
#pragma unroll
                    for (int m = 0; m < 4; ++m) acc[ai][bj][m][n] = v; }
    }
    __device__ __forceinline__ void prefetch(Pre&, const Unit&, int, int, int, int) const {}
    unsigned char* Y; const float* b2; const PG8_LAS float* gtab; float asc;
    __device__ __forceinline__ void operator()(const f32x4 (&acc)[2][2][4][2], const Unit& u, int wr, int wc, int fr, int fq, const Pre& pre) const {
        asm volatile("" : "+v"(fr), "+v"(fq));
        const int e = u.e, jt = u.pn - e * 4; const int colp = jt * 256 + wc * 64 + 16 * fq;
        const int row0 = u.pm * BM + wr * 64 + fr; const PG8_LAS float* gp = gtab + u.ui * 256 + wr * 64 + fr;
#pragma unroll
        for (int ai = 0; ai < 2; ++ai)
#pragma unroll
            for (int m = 0; m < 4; ++m) { const float gt = gp[ai * HALF + m * 16] * (QS_Y * asc); u32x4 w;
#pragma unroll
                for (int bj = 0; bj < 2; ++bj) { const f32x4 v0 = acc[ai][bj][m][0] * gt, v1 = acc[ai][bj][m][1] * gt;
                    const unsigned lo = pk4_fp8(v0[0], v0[1], v0[2], v0[3]), hi = pk4_fp8(v1[0], v1[1], v1[2], v1[3]);
                    if (bj == 0) { w.x = lo; w.y = hi; } else { w.z = lo; w.w = hi; } }
                *(u32x4*)(Y + (size_t)(row0 + ai * HALF + m * 16) * D + colp) = w; }
    }
};

template <class Epi, class Sched, bool ALIGN_EPI = false, bool SP2 = false, int ES = 2, bool GATHER = false>
__device__ __forceinline__ void gemm_phase(PG8_LAS unsigned char* lds, const Gemm g, const Sched& S, const Epi& E) {
    const int tid = threadIdx.x, wid = __builtin_amdgcn_readfirstlane(tid >> 6), lane = tid & 63, wr = wid >> 2, wc = wid & 3, fr = lane & 15, fq = lane >> 4;
    const int K = g.K * ES / 2, nt = K / BK;
    unsigned voffA[2], voffB[2]; int gR[2]; unsigned gC[2];
#pragma unroll
    for (int i = 0; i < 2; ++i) { int R, C; stage_rc(tid * 16 + i * 8192, R, C); const int Rb = Epi::PERM ? ((R & ~31) + perm32(R & 31)) : R;
        voffA[i] = (unsigned)(R * K + C) * 2u; voffB[i] = (unsigned)(Rb * K + C) * 2u; gR[i] = R; gC[i] = (unsigned)C * 2u; }
    unsigned vAc[2][2], vAn[2][2], vAs[2][2];
#define PG8_GLOAD(dst, ui_) do { _Pragma("unroll") for (int h_ = 0; h_ < 2; ++h_) _Pragma("unroll") for (int i_ = 0; i_ < 2; ++i_) dst[h_][i_] = g.gtab[(ui_) * 256 + h_ * HALF + gR[i_]] + gC[i_]; } while (0)
#define PG8_STAGE_A(b, h, soff, V) do { if constexpr (GATHER) { PG8_STAGE_R(PG8_SA(b, h), rA, soff, V[h]); } else { PG8_STAGE_R(PG8_SA(b, h), rA, (soff) + (h) * hstep, voffA); } } while (0)
    const unsigned kstep = (unsigned)(BK * 2);
    const unsigned hstep = (unsigned)HALF * K * 2;
    const unsigned tstep = 2 * hstep;
    const unsigned ldsw = (unsigned)wid * 1024u;
    const int aoff = lds_byte(wr * 64 + fr, fq * 8), boff = lds_byte(wc * 32 + fr, fq * 8);
#define PG8_SA(b, h) (((b) * 2 + (h)) * HTB)
#define PG8_SB(b, h) ((4 + (b) * 2 + (h)) * HTB)
    const __amdgpu_buffer_rsrc_t rA = __builtin_amdgcn_make_buffer_rsrc((void*)g.A, (short)0, 0x7fffffff, 0x00020000);
    const __amdgpu_buffer_rsrc_t rB = __builtin_amdgcn_make_buffer_rsrc((void*)g.Bt, (short)0, 0x7fffffff, 0x00020000);
#define PG8_STAGE_R(bufoff, rsrc, soff, voff) do { _Pragma("unroll") for (int _i = 0; _i < 2; ++_i) \
        __builtin_amdgcn_raw_ptr_buffer_load_lds(rsrc, (PG8_LAS void*)(lds + (bufoff) + ldsw + _i * 8192), 16, (int)(voff)[_i], (int)(soff), 0, 0); } while (0)
#define PG8_LDA(dst, b, h) do { _Pragma("unroll") for (int m = 0; m < 4; ++m) _Pragma("unroll") for (int k = 0; k < 2; ++k) dst[m][k] = *(const PG8_LAS bf16x8*)(lds + PG8_SA(b, h) + aoff + m * 2048 + k * 1024); } while (0)
#define PG8_LDB(dst, b, h) do { _Pragma("unroll") for (int n = 0; n < 2; ++n) _Pragma("unroll") for (int k = 0; k < 2; ++k) dst[n][k] = *(const PG8_LAS bf16x8*)(lds + PG8_SB(b, h) + boff + n * 2048 + k * 1024); } while (0)
#define PG8_PIN12(At, Bt) asm volatile("" : "+v"(At[0][0]), "+v"(At[0][1]), "+v"(At[1][0]), "+v"(At[1][1]), "+v"(At[2][0]), "+v"(At[2][1]), "+v"(At[3][0]), "+v"(At[3][1]), "+v"(Bt[0][0]), "+v"(Bt[0][1]), "+v"(Bt[1][0]), "+v"(Bt[1][1]))
#define PG8_PINACC(ai, bj) asm volatile("" : "+v"(acc[ai][bj][0][0]), "+v"(acc[ai][bj][0][1]), "+v"(acc[ai][bj][1][0]), "+v"(acc[ai][bj][1][1]), "+v"(acc[ai][bj][2][0]), "+v"(acc[ai][bj][2][1]), "+v"(acc[ai][bj][3][0]), "+v"(acc[ai][bj][3][1]))
#define PG8_MMA(ai, bj, At, Bt) do { if constexpr (ES == 1) { PG8_PIN12(At, Bt); __builtin_amdgcn_sched_barrier(0); } __builtin_amdgcn_s_setprio(1); _Pragma("unroll") for (int m = 0; m < 4; ++m) _Pragma("unroll") for (int n = 0; n < 2; ++n) { \
        if constexpr (ES == 2) { _Pragma("unroll") for (int k = 0; k < 2; ++k) acc[ai][bj][m][n] = __builtin_amdgcn_mfma_f32_16x16x32_bf16(Bt[n][k], At[m][k], acc[ai][bj][m][n], 0, 0, 0); } \
        else { acc[ai][bj][m][n] = __builtin_amdgcn_mfma_scale_f32_16x16x128_f8f6f4(cat8(Bt[n][0], Bt[n][1]), cat8(At[m][0], At[m][1]), acc[ai][bj][m][n], 0, 0, 0, 0x7f7f7f7f, 0, 0x7f7f7f7f); } } \
        __builtin_amdgcn_s_setprio(0); if constexpr (ES == 1) { PG8_PINACC(ai, bj); __builtin_amdgcn_sched_barrier(0); } } while (0)
#define PG8_WAIT_V(n) asm volatile("s_waitcnt vmcnt(" #n ")" ::: "memory")
#define PG8_WAIT_L(n) asm volatile("s_waitcnt lgkmcnt(" #n ")" ::: "memory")
#define PG8_BAR __builtin_amdgcn_s_barrier()
#define PG8_SCHED __builtin_amdgcn_sched_barrier(0)
    Unit cur, nxt; int ui = 0;
    if (!S.next(0, cur)) return;
    typename Epi::Pre pre; E.prefetch(pre, cur, wr, wc, fr, fq);
    typename Epi::Seed sd; E.seed_load(sd, cur, wr, wc, fr, fq);
    f32x4 acc[2][2][4][2]; E.seed_acc(acc, sd);
    bf16x8 At[4][2], B0[2][2], B1[2][2];
    unsigned cA = GATHER ? 0u : (unsigned)cur.pm * tstep, cB = (unsigned)cur.pn * tstep;
    if constexpr (GATHER) PG8_GLOAD(vAc, 0);
    S.a_ready(cur);
    if constexpr (SP2) {
        PG8_STAGE_R(PG8_SB(0, 0), rB, cB, voffB); PG8_STAGE_R(PG8_SB(0, 1), rB, cB + hstep, voffB); PG8_STAGE_A(0, 0, cA, vAc); PG8_STAGE_A(0, 1, cA, vAc);
        if (wr == 1) PG8_BAR;
        PG8_WAIT_V(2); PG8_BAR;
        PG8_STAGE_R(PG8_SB(1, 0), rB, cB + kstep, voffB); PG8_STAGE_A(1, 0, cA + kstep, vAc); PG8_STAGE_R(PG8_SB(1, 1), rB, cB + hstep + kstep, voffB);
        if constexpr (Epi::NST >= 0) PG8_WAIT_V(0); else PG8_WAIT_V(6);
        PG8_BAR;
    } else {
        PG8_STAGE_R(PG8_SB(0, 0), rB, cB, voffB); PG8_STAGE_A(0, 0, cA, vAc); PG8_STAGE_R(PG8_SB(0, 1), rB, cB + hstep, voffB); PG8_STAGE_A(0, 1, cA, vAc);
        if (wr == 1) PG8_BAR;
        PG8_WAIT_V(4); PG8_BAR;
        PG8_STAGE_R(PG8_SB(1, 0), rB, cB + kstep, voffB); PG8_STAGE_A(1, 0, cA + kstep, vAc); PG8_STAGE_R(PG8_SB(1, 1), rB, cB + hstep + kstep, voffB);
        PG8_WAIT_V(6); PG8_BAR;
    }
    for (;;) {
        const bool has_next = S.next(ui + 1, nxt);
        const unsigned nA = (has_next && !GATHER) ? (unsigned)nxt.pm * tstep : cA, nB = has_next ? (unsigned)nxt.pn * tstep : cB;
        if constexpr (GATHER) { if (has_next) PG8_GLOAD(vAn, ui + 1); else { _Pragma("unroll") for (int h_ = 0; h_ < 2; ++h_) _Pragma("unroll") for (int i_ = 0; i_ < 2; ++i_) vAn[h_][i_] = vAc[h_][i_]; } }
#define PG8_ITER_HEAD(t, LAST) \
            const bool last = (LAST); \
            if constexpr (GATHER) { _Pragma("unroll") for (int h_ = 0; h_ < 2; ++h_) _Pragma("unroll") for (int i_ = 0; i_ < 2; ++i_) vAs[h_][i_] = last ? vAn[h_][i_] : vAc[h_][i_]; } \
            const unsigned a1 = cA + (unsigned)((t) + 1) * kstep;                                             \
            const unsigned a2 = last ? nA : cA + (unsigned)((t) + 2) * kstep, b2 = last ? nB : cB + (unsigned)((t) + 2) * kstep;     \
            const unsigned a3 = a2 + kstep, b3 = b2 + kstep;                                \
            if (last && has_next) S.a_ready(nxt);
#define PG8_ITER_SP2(W01) \
            PG8_LDB(B0, 0, 0); PG8_LDB(B1, 0, 1); PG8_SCHED; PG8_LDA(At, 0, 0); PG8_STAGE_A(1, 1, a1, vAc); \
            W01; PG8_WAIT_L(0); PG8_BAR; PG8_MMA(0, 0, At, B0); PG8_MMA(0, 1, At, B1); PG8_BAR; PG8_SCHED; \
            PG8_LDA(At, 0, 1); PG8_STAGE_R(PG8_SB(0, 0), rB, b2, voffB); PG8_STAGE_R(PG8_SB(0, 1), rB, b2 + hstep, voffB); PG8_STAGE_A(0, 0, a2, vAs); \
            W01; PG8_WAIT_L(0); PG8_BAR; PG8_MMA(1, 0, At, B0); PG8_MMA(1, 1, At, B1); PG8_BAR; PG8_SCHED; \
            PG8_LDB(B0, 1, 0); PG8_LDB(B1, 1, 1); PG8_SCHED; PG8_LDA(At, 1, 0); PG8_STAGE_A(0, 1, a2, vAs); \
            PG8_WAIT_V(8); PG8_WAIT_L(0); PG8_BAR; PG8_MMA(0, 0, At, B0); PG8_MMA(0, 1, At, B1); PG8_BAR; PG8_SCHED; \
            PG8_LDA(At, 1, 1); PG8_STAGE_R(PG8_SB(1, 0), rB, b3, voffB); PG8_STAGE_R(PG8_SB(1, 1), rB, b3 + hstep, voffB); PG8_STAGE_A(1, 0, a3, vAs); \
            PG8_WAIT_V(8); PG8_WAIT_L(0); PG8_BAR; PG8_MMA(1, 0, At, B0); PG8_MMA(1, 1, At, B1); PG8_BAR; PG8_SCHED;
        if constexpr (SP2 && Epi::NST >= 0) {
            { PG8_ITER_HEAD(0, false) PG8_ITER_SP2(asm volatile("s_waitcnt vmcnt(%0)" :: "n"(8 + Epi::NST) : "memory")) }
            for (int t = 2; t < nt; t += 2) { PG8_ITER_HEAD(t, t == nt - 2) PG8_ITER_SP2(PG8_WAIT_V(8)) }
        } else if constexpr (SP2) {
            for (int t = 0; t < nt; t += 2) { PG8_ITER_HEAD(t, t == nt - 2) PG8_ITER_SP2(PG8_WAIT_V(8)) }
        } else {
            for (int t = 0; t < nt; t += 2) { PG8_ITER_HEAD(t, t == nt - 2)
            PG8_LDB(B0, 0, 0); PG8_SCHED; PG8_LDA(At, 0, 0); PG8_STAGE_A(1, 1, a1, vAc);
            PG8_WAIT_L(8); PG8_BAR; PG8_WAIT_L(0); PG8_MMA(0, 0, At, B0); PG8_BAR; PG8_SCHED;
            PG8_LDB(B1, 0, 1); PG8_STAGE_R(PG8_SB(0, 0), rB, b2, voffB);
            PG8_BAR; PG8_WAIT_L(0); PG8_MMA(0, 1, At, B1); PG8_BAR;
            PG8_LDA(At, 0, 1); PG8_STAGE_A(0, 0, a2, vAs);
            PG8_BAR; PG8_WAIT_L(0); PG8_MMA(1, 0, At, B0); PG8_BAR; PG8_SCHED;
            PG8_STAGE_R(PG8_SB(0, 1), rB, b2 + hstep, voffB);
            PG8_WAIT_V(6); PG8_BAR; PG8_MMA(1, 1, At, B1); PG8_BAR;
            PG8_LDB(B0, 1, 0); PG8_SCHED; PG8_LDA(At, 1, 0); PG8_STAGE_A(0, 1, a2, vAs);
            PG8_WAIT_L(8); PG8_BAR; PG8_WAIT_L(0); PG8_MMA(0, 0, At, B0); PG8_BAR; PG8_SCHED;
            PG8_LDB(B1, 1, 1); PG8_STAGE_R(PG8_SB(1, 0), rB, b3, voffB);
            PG8_BAR; PG8_WAIT_L(0); PG8_MMA(0, 1, At, B1); PG8_BAR;
            PG8_LDA(At, 1, 1); PG8_STAGE_A(1, 0, a3, vAs);
            PG8_BAR; PG8_WAIT_L(0); PG8_MMA(1, 0, At, B0); PG8_BAR; PG8_SCHED;
            PG8_STAGE_R(PG8_SB(1, 1), rB, b3 + hstep, voffB);
            PG8_WAIT_V(6); PG8_BAR; PG8_MMA(1, 1, At, B1); PG8_BAR;
            }
        }
#undef PG8_ITER_HEAD
#undef PG8_ITER_SP2
        if constexpr (ALIGN_EPI) { if (wr == 0) PG8_BAR; }
        if (has_next) E.seed_load(sd, nxt, wr, wc, fr, fq);
        if constexpr (!Epi::AFTER_DRAIN) { E(acc, cur, wr, wc, fr, fq, pre); S.done(cur); }
        if (!has_next) break;
        E.seed_acc(acc, sd);
        cur = nxt; cA = nA; cB = nB; ++ui;
        if constexpr (GATHER) { _Pragma("unroll") for (int h_ = 0; h_ < 2; ++h_) _Pragma("unroll") for (int i_ = 0; i_ < 2; ++i_) vAc[h_][i_] = vAn[h_][i_]; }
        E.prefetch(pre, cur, wr, wc, fr, fq);
        if constexpr (ALIGN_EPI) { if (wr == 1) PG8_BAR; }
    }
    PG8_WAIT_V(0);
    if constexpr (!ALIGN_EPI) { if (wr == 0) PG8_BAR; }
    PG8_BAR;
#undef PG8_SA
#undef PG8_SB
#undef PG8_STAGE_R
#undef PG8_STAGE_A
#undef PG8_GLOAD
#undef PG8_LDA
#undef PG8_LDB
#undef PG8_MMA
#undef PG8_PIN12
#undef PG8_PINACC
#undef PG8_WAIT_V
#undef PG8_WAIT_L
#undef PG8_BAR
#undef PG8_SCHED
}
}


constexpr size_t MiB = 1u << 20;
constexpr size_t WS_CTL = 0, CTL_ZERO_BYTES = 1 * MiB;
constexpr size_t WS_STATS0 = 1 * MiB, WS_COS = 2 * MiB, WS_SIN = 6 * MiB;
constexpr size_t WS_WINT = 10 * MiB, WS_WOT = 17 * MiB, WS_W1T = 20 * MiB, WS_W2T = 148 * MiB;
constexpr size_t WS_H0B = 212 * MiB, WS_MIXED = 534 * MiB;
constexpr size_t WS_PROJ = 276 * MiB;
constexpr size_t WS_ST = 470 * MiB, WS_DEC = 598 * MiB;
constexpr size_t WS_PRE1 = 212 * MiB;
constexpr size_t WS_AGG = 599 * MiB, WS_SINS = 615 * MiB, WS_DAGG = 631 * MiB;
constexpr size_t WS_H1B = 599 * MiB, WS_LIST = 663 * MiB, WS_GATES = 667 * MiB;
constexpr size_t WS_XS = 276 * MiB, WS_SLOTG = 668 * MiB, WS_ACT = 672 * MiB, WS_Y = 276 * MiB, WS_END = 940 * MiB;
constexpr size_t PJ_GQ = 0, PJ_GK = 16 * MiB, PJ_GV = 32 * MiB, PJ_GG = 64 * MiB, PJ_RQ = 96 * MiB, PJ_RK = 112 * MiB, PJ_RV = 128 * MiB, PJ_RG = 160 * MiB, PJ_GLR = 192 * MiB;
constexpr int CW_TMO = 0, CW_CODE = 1, CW_COUNTS = 64, CW_BAR = 4096;
constexpr int RING_OFF = 0, RING_BYTES = 131072;
constexpr int LDSCTL_OFF = RING_BYTES, MISC_OFF = LDSCTL_OFF + 320;
constexpr int X_TSTART = LDSCTL_OFF + 512, X_CNT = LDSCTL_OFF + 768, X_LCNT = LDSCTL_OFF + 1024, X_LBASE = LDSCTL_OFF + 1280, X_NASG = LDSCTL_OFF + 1536, X_ASG = LDSCTL_OFF + 2048;
constexpr int X_GTAB = LDSCTL_OFF + 8192, GT_MAXU = 17;
constexpr int LDS_BYTES = 157696;
constexpr int NWAVES = 8;
constexpr int NPH = 11;
#define GAS __attribute__((address_space(1)))
#define LAS __attribute__((address_space(3)))
typedef unsigned short bf16;
typedef unsigned v4u __attribute__((ext_vector_type(4)));
typedef float f32x4 __attribute__((ext_vector_type(4)));
typedef short bf16x8 __attribute__((ext_vector_type(8)));
typedef GAS unsigned gu32;
typedef GAS unsigned long long gu64;
#define RLX_AGENT __ATOMIC_RELAXED, __HIP_MEMORY_SCOPE_AGENT
#define LDS_WAIT() asm volatile("s_waitcnt lgkmcnt(0)" ::: "memory")
#define VM_WAIT() asm volatile("s_waitcnt vmcnt(0)" ::: "memory")
__device__ __forceinline__ unsigned long long rt() { return __builtin_amdgcn_s_memrealtime(); }
typedef __bf16 hwbf16x2 __attribute__((ext_vector_type(2)));
typedef float f32x2_t __attribute__((ext_vector_type(2)));
__device__ __forceinline__ unsigned pk2(float lo, float hi) { return __builtin_bit_cast(unsigned, __builtin_convertvector((f32x2_t){lo, hi}, hwbf16x2)); }
__device__ __forceinline__ unsigned f2bf(float f) { return pk2(f, 0.f) & 0xffffu; }

#define XB_TMO      128
#define XB_XCNT(j)  (256  + 64 * (j))
#define XB_XSUB(j)  (1280 + 64 * (j))
#define XB_XGEN(j)  (2304 + 64 * (j))
#define XB_TOP      3328
#define XB_TOPGEN   3392
#define XCD_BAR_WORDS 3456
#define XB_SPIN_CAP (1u << 18)

__device__ __forceinline__ unsigned xb_ld(unsigned* p)              { return __hip_atomic_load(p, __ATOMIC_RELAXED, __HIP_MEMORY_SCOPE_AGENT); }
__device__ __forceinline__ unsigned xb_add(unsigned* p, unsigned v) { return __hip_atomic_fetch_add(p, v, __ATOMIC_RELAXED, __HIP_MEMORY_SCOPE_AGENT); }
__device__ __forceinline__ unsigned xb_xcc_id() { return (unsigned)__builtin_amdgcn_s_getreg((3 << 11) | 20) & 0xFu; }
#define XB_SPIN(cond, bar) do { unsigned _sp = 0; while (cond) { __builtin_amdgcn_s_sleep(1); \
    if ((++_sp & 255u) == 0u) { if (xb_ld(&(bar)[XB_TMO])) break; if (_sp > XB_SPIN_CAP) { atomicAdd(&(bar)[XB_TMO], 1u); break; } } } } while (0)

struct XcdBarrier {
    unsigned* bar; unsigned x;
    volatile LAS unsigned* st;
};

__device__ __forceinline__ XcdBarrier xcd_barrier_post(unsigned* bar, volatile LAS unsigned* st) {
    XcdBarrier b; b.bar = bar; b.x = xb_xcc_id(); b.st = st;
    if (threadIdx.x == 0) (void)xb_add(&bar[XB_XCNT(b.x)], 1u);
    return b;
}
__device__ __forceinline__ void xcd_barrier_complete(unsigned* bar, unsigned x, unsigned& nloc, unsigned& nx) {
    const unsigned G = gridDim.x * gridDim.y * gridDim.z;
    unsigned sum, cnt, mine, sp = 0u;
    for (;;) {
        sum = 0u; cnt = 0u; mine = 0u;
#pragma unroll
        for (unsigned j = 0; j < 16; ++j) { const unsigned c = xb_ld(&bar[XB_XCNT(j)]); sum += c; cnt += (c > 0u) ? 1u : 0u; mine = (j == x) ? c : mine; }
        if (sum == G) break;
        __builtin_amdgcn_s_sleep(1);
        if ((++sp & 255u) == 0u) { if (xb_ld(&bar[XB_TMO])) break; if (sp > XB_SPIN_CAP) { atomicAdd(&bar[XB_TMO], 1u); break; } }
    }
    nloc = mine > 0u ? mine : 1u; nx = cnt > 0u ? cnt : 1u;
}

__device__ __forceinline__ void xcd_barrier(const XcdBarrier& b) {
    asm volatile("s_waitcnt vmcnt(0)" ::: "memory");
    __syncthreads();
    if (threadIdx.x == 0) {
        unsigned* bar = b.bar;
        __builtin_amdgcn_s_waitcnt(0);
        unsigned nloc = b.st[0], nx = b.st[1];
        if (nloc == 0u) { xcd_barrier_complete(bar, b.x, nloc, nx); b.st[0] = nloc; b.st[1] = nx; }
        const unsigned old = xb_add(&bar[XB_XSUB(b.x)], 1u);
        const unsigned gen = old / nloc;
        if (old + 1u == (gen + 1u) * nloc) {
            __builtin_amdgcn_fence(__ATOMIC_RELEASE, "agent");
            asm volatile("s_waitcnt vmcnt(0)" ::: "memory");
            const unsigned og = xb_add(&bar[XB_TOP], 1u);
            const unsigned tg = og / nx;
            if (og + 1u == (tg + 1u) * nx) xb_add(&bar[XB_TOPGEN], 1u);
            else XB_SPIN(xb_ld(&bar[XB_TOPGEN]) == tg, bar);
            __builtin_amdgcn_fence(__ATOMIC_ACQUIRE, "agent");
            xb_add(&bar[XB_XGEN(b.x)], 1u);
            asm volatile("s_waitcnt vmcnt(0)" ::: "memory");
        } else {
            XB_SPIN(xb_ld(&bar[XB_XGEN(b.x)]) == gen, bar);
            __builtin_amdgcn_fence(__ATOMIC_ACQUIRE, "agent");
            asm volatile("s_waitcnt vmcnt(0)" ::: "memory");
        }
    }
    __syncthreads();
}

struct Frame {
    LAS unsigned char* lds;
    volatile LAS unsigned* MISC;
    gu32* ctl;
    int tid, lane, wave, vcu, G;
    const float *x; const int* positions; const float *ln_in_g, *ln_in_b, *w_in, *gate_w, *gate_b, *gla_g, *ret_g, *ret_b, *w_out, *ln1_g, *ln1_b, *router_w, *router_b, *w1, *b1, *w2, *b2, *ln2_g, *ln2_b;
    float* out;
    float *stats0, *cosT, *sinT, *ST, *DEC, *PRE1, *GLR, *gates, *AGG, *DAGG; bf16* SIN;
    bf16 *WinT, *WoT, *W1T, *W2T, *H0B, *MIXED, *GQ, *GK, *GV, *GG, *RQ, *RK, *RV, *RG, *H1B, *XS, *ACT, *Y;
    int* list; unsigned* counts; float* slotg; int* tkslot;
};
template <int CTRL> __device__ __forceinline__ float dppf(float v) { return __builtin_bit_cast(float, __builtin_amdgcn_update_dpp(0, __builtin_bit_cast(int, v), CTRL, 0xF, 0xF, true)); }
template <int CTRL> __device__ __forceinline__ int dppi(int v) { return __builtin_amdgcn_update_dpp(0, v, CTRL, 0xF, 0xF, true); }
__device__ __forceinline__ float wave_sum(float v) {
    v += dppf<0xB1>(v); v += dppf<0x4E>(v); v += dppf<0x141>(v); v += dppf<0x140>(v);
    const float s0 = __builtin_bit_cast(float, __builtin_amdgcn_readlane(__builtin_bit_cast(int, v), 0)), s1 = __builtin_bit_cast(float, __builtin_amdgcn_readlane(__builtin_bit_cast(int, v), 16));
    const float s2 = __builtin_bit_cast(float, __builtin_amdgcn_readlane(__builtin_bit_cast(int, v), 32)), s3 = __builtin_bit_cast(float, __builtin_amdgcn_readlane(__builtin_bit_cast(int, v), 48));
    return (s0 + s1) + (s2 + s3);
}
__device__ __forceinline__ float bf2f(unsigned h) { return __builtin_bit_cast(float, h << 16); }

struct WinMap { __device__ __forceinline__ int operator()(int n) const {
    if (n < 1536) return n;
    if (n < 1552) return -1;
    if (n < 2064) { const int q = n < 1808 ? 0 : 1, l = n - (q ? 1808 : 1552); return 1536 + 256 * q + ((l >> 5) & 1) * 128 + (l >> 6) * 32 + (l & 31); }
    if (n < 2576) return 2048 + (n - 2064);
    return 2560 + (n - 2576); } };
struct IdMap { int off; __device__ __forceinline__ int operator()(int n) const { return off + n; } };
struct W1Map { int off; __device__ __forceinline__ int operator()(int n) const { const int l = n & 1023; return off + (l >> 7) * 256 + (n >> 10) * 128 + (l & 127); } };
template <bool FP8, class RowMap>
__device__ __forceinline__ void p0_transpose_item(const float* W, int K, int N, bf16* WT, const RowMap rm, int item, int lane) {
    const int nblk = (N + 31) / 32, kb = item / nblk, nb = item % nblk, k0 = 128 * kb, n0 = 32 * nb;
    const int q = lane & 7, n4 = n0 + 4 * (lane >> 3);
    f32x4 a[16];
    if (n4 < N) {
#pragma unroll
        for (int i = 0; i < 16; ++i) a[i] = __builtin_nontemporal_load((const GAS f32x4*)(W + (size_t)(k0 + 16 * q + i) * N + n4)); }
    else {
#pragma unroll
        for (int i = 0; i < 16; ++i) a[i] = (f32x4){0.f, 0.f, 0.f, 0.f}; }
#pragma unroll
    for (int c = 0; c < 4; ++c) { const int n = n4 + c; const int row = (n < N) ? rm(n) : -1;
        if (row >= 0) {
            if constexpr (FP8) { v4u w;
                w.x = pk4_fp8(a[0][c] * QS_W, a[1][c] * QS_W, a[2][c] * QS_W, a[3][c] * QS_W); w.y = pk4_fp8(a[4][c] * QS_W, a[5][c] * QS_W, a[6][c] * QS_W, a[7][c] * QS_W);
                w.z = pk4_fp8(a[8][c] * QS_W, a[9][c] * QS_W, a[10][c] * QS_W, a[11][c] * QS_W); w.w = pk4_fp8(a[12][c] * QS_W, a[13][c] * QS_W, a[14][c] * QS_W, a[15][c] * QS_W);
                *(GAS v4u*)((GAS unsigned char*)WT + (size_t)row * K + k0 + 16 * q) = w; }
            else { GAS v4u* dst = (GAS v4u*)(WT + (size_t)row * K + k0 + 16 * q);
                dst[0] = (v4u){pk2(a[0][c], a[1][c]), pk2(a[2][c], a[3][c]), pk2(a[4][c], a[5][c]), pk2(a[6][c], a[7][c])};
                dst[1] = (v4u){pk2(a[8][c], a[9][c]), pk2(a[10][c], a[11][c]), pk2(a[12][c], a[13][c]), pk2(a[14][c], a[15][c])}; } } }
}
__device__ __forceinline__ void p0_prologue(Frame& F) {
    const int gw = F.vcu * NWAVES + F.wave, NGW = F.G * NWAVES;
    constexpr int I_IN = (D / 128) * ((PW + 31) / 32), I_OUT = (D / 128) * (D / 32), I_1 = (D / 128) * (2 * DFF / 32), I_2 = (DFF / 128) * (D / 32);
    constexpr int NITEMS = I_IN + I_OUT + NE * (I_1 + I_2);
    for (int it = gw; it < NITEMS; it += NGW) {
        int r = it;
        if (r < I_IN) { p0_transpose_item<false>(F.w_in, D, PW, F.WinT, WinMap{}, r, F.lane); continue; } r -= I_IN;
        if (r < I_OUT) { p0_transpose_item<false>(F.w_out, D, D, F.WoT, IdMap{0}, r, F.lane); continue; } r -= I_OUT;
        if (r < NE * I_1) { const int e = r / I_1; p0_transpose_item<true>(F.w1 + (size_t)e * D * 2 * DFF, D, 2 * DFF, F.W1T, W1Map{e * 2 * DFF}, r % I_1, F.lane); continue; } r -= NE * I_1;
        { const int e = r / I_2; p0_transpose_item<true>(F.w2 + (size_t)e * DFF * D, DFF, D, F.W2T, IdMap{e * D}, r % I_2, F.lane); }
    }
    __syncthreads();
    { LAS float* WG = (LAS float*)(F.lds + RING_OFF);
        for (int idx = F.tid; idx < D * 4; idx += 512) { const int c = idx >> 2, ch = idx & 3; *(LAS f32x4*)(WG + c * 20 + ((ch + ((c >> 4) & 3)) & 3) * 4) = *(const GAS f32x4*)(F.w_in + (size_t)c * PW + 1536 + 4 * ch); } }
    __syncthreads();
    { f32x4 g4[4], b4[4];
#pragma unroll
        for (int j = 0; j < 4; ++j) { g4[j] = *((const GAS f32x4*)F.ln_in_g + F.lane + 64 * j); b4[j] = *((const GAS f32x4*)F.ln_in_b + F.lane + 64 * j); }
        f32x4 nx[4]; int m = gw;
        if (m < M) {
#pragma unroll
            for (int j = 0; j < 4; ++j) nx[j] = __builtin_nontemporal_load((const GAS f32x4*)(F.x + (size_t)m * D) + F.lane + 64 * j); }
        for (; m < M; m += NGW) {
            f32x4 v[4]; float s = 0.f;
#pragma unroll
            for (int j = 0; j < 4; ++j) { v[j] = nx[j]; s += (v[j].x + v[j].y) + (v[j].z + v[j].w); }
            if (m + NGW < M) {
#pragma unroll
                for (int j = 0; j < 4; ++j) nx[j] = __builtin_nontemporal_load((const GAS f32x4*)(F.x + (size_t)(m + NGW) * D) + F.lane + 64 * j); }
            const float mean = wave_sum(s) * (1.f / D); float s2 = 0.f;
#pragma unroll
            for (int j = 0; j < 4; ++j) { v[j] = v[j] - mean; s2 += (v[j].x * v[j].x + v[j].y * v[j].y) + (v[j].z * v[j].z + v[j].w * v[j].w); }
            const float rstd = 1.f / sqrtf(wave_sum(s2) * (1.f / D) + LN_EPS);
            if (F.lane == 0) { F.stats0[2 * m] = mean; F.stats0[2 * m + 1] = rstd; }
            GAS unsigned long long* o8 = (GAS unsigned long long*)(F.H0B + (size_t)m * D) + F.lane;
#pragma unroll
            for (int j = 0; j < 4; ++j) { const f32x4 h = v[j] * rstd * g4[j] + b4[j]; v[j] = h;
                o8[64 * j] = (unsigned long long)pk2(h.x, h.y) | ((unsigned long long)pk2(h.z, h.w) << 32); }
            { const LAS float* WG = (const LAS float*)(F.lds + RING_OFF); float acc[16];
#pragma unroll
                for (int r = 0; r < 16; ++r) acc[r] = 0.f;
#pragma unroll
                for (int ci = 0; ci < 16; ++ci) { const int c = 4 * F.lane + 256 * (ci >> 2) + (ci & 3); const float hv = v[ci >> 2][ci & 3]; f32x4 wc[4];
#pragma unroll
                    for (int ch = 0; ch < 4; ++ch) wc[ch] = *(const LAS f32x4*)(WG + c * 20 + ((ch + ((c >> 4) & 3)) & 3) * 4);
#pragma unroll
                    for (int ch = 0; ch < 4; ++ch)
#pragma unroll
                        for (int x = 0; x < 4; ++x) acc[4 * ch + x] += hv * wc[ch][x];
                    if ((ci & 3) == 3) asm volatile("" ::: "memory"); }
                float red[8];
#pragma unroll
                for (int e = 0; e < 8; ++e) { float pa = acc[e], pb = acc[e + 8]; asm volatile("v_nop\n\tv_nop\n\tv_permlane32_swap_b32 %0, %1" : "+v"(pa), "+v"(pb)); red[e] = pa + pb; }
#define P0_SEL(MSK, A, B) __builtin_bit_cast(float, (__builtin_bit_cast(unsigned, (A)) & (MSK)) | (__builtin_bit_cast(unsigned, (B)) & ~(MSK)))
                { const unsigned hm = (F.lane & 16) ? 0xffffffffu : 0u; float snd[4], rcv[4];
#pragma unroll
                    for (int e = 0; e < 4; ++e) snd[e] = P0_SEL(hm, red[e], red[e + 4]);
#pragma unroll
                    for (int e = 0; e < 4; ++e) rcv[e] = __shfl_xor(snd[e], 16);
#pragma unroll
                    for (int e = 0; e < 4; ++e) red[e] = P0_SEL(hm, red[e + 4], red[e]) + rcv[e]; }
                { const unsigned hm = (F.lane & 8) ? 0xffffffffu : 0u;
#pragma unroll
                    for (int e = 0; e < 2; ++e) { const float keep = P0_SEL(hm, red[e + 2], red[e]), snd = P0_SEL(hm, red[e], red[e + 2]); red[e] = keep + dppf<0x128>(snd); } }
                { const unsigned hm = (F.lane & 4) ? 0xffffffffu : 0u; const float keep = P0_SEL(hm, red[1], red[0]), snd = P0_SEL(hm, red[0], red[1]); red[0] = keep + dppf<0x141>(snd); }
#undef P0_SEL
                red[0] += dppf<0x4E>(red[0]); red[0] += dppf<0xB1>(red[0]);
                if ((F.lane & 3) == 0) F.GLR[(size_t)m * 16 + ((F.lane >> 5) * 8 + ((F.lane >> 4) & 1) * 4 + ((F.lane >> 3) & 1) * 2 + ((F.lane >> 2) & 1))] = red[0]; }
        } }
    const double inv_freq = pow(10000.0, -(double)(F.tid & 31) / 31.0);
    for (int idx = F.vcu * 512 + F.tid; idx < M * 32; idx += F.G * 512) { const int t = idx >> 5;
        const double ang = (double)F.positions[t] * inv_freq;
        F.cosT[idx] = (float)cos(ang); F.sinT[idx] = (float)sin(ang); }
}

constexpr int MS = 72;
constexpr int MX_QE = 0, MX_QN = 9216, MX_KE = 18432, MX_KN = 27648, MX_VT = 36864, MX_PT = 55296, MX_B = 73728, MX_RED = 90368, MX_GW = 91392, MX_P = 95744;
constexpr int MX_NP = MX_P + 64 * 132 * 4;
constexpr int MX_OUT = MX_P, OUTS = 132;
static_assert(MX_GW + 4096 + 256 <= MX_P && MX_OUT + 64 * OUTS * 4 <= MX_NP && MX_NP + 3 * 128 * 4 <= RING_BYTES, "mixer LDS");
constexpr float LOG2E = 1.4426950408889634f, LN2 = 0.6931471805599453f;
__device__ __forceinline__ float log2_gamma(int h) { return log2f(1.0f - exp2f(-5.0f - (float)h)); }
__device__ __forceinline__ float fexp2(float x) { return __builtin_amdgcn_exp2f(x); }
__device__ __forceinline__ float bflo(unsigned w) { return __builtin_bit_cast(float, w << 16); }
__device__ __forceinline__ float bfhi(unsigned w) { return __builtin_bit_cast(float, w & 0xffff0000u); }
__device__ __forceinline__ int tsw(int row, int j) { return row * MS + ((((j >> 3) ^ (row >> 3)) & 7) << 3) + (j & 7); }
struct MixItem { int b, h, h8, c, item; bool gla; size_t t0; };
__device__ __forceinline__ MixItem mix_item(int vb, int k) {
    MixItem m; m.b = vb >> 6; m.h = (vb >> 4) & 3; m.c = (vb & 15) * 8 + (k >> 1); m.gla = (k & 1) == 0; m.h8 = m.gla ? m.h : 4 + m.h;
    m.item = ((m.b * 8 + m.h8) << 7) + m.c; m.t0 = (size_t)m.b * SEQ + (size_t)m.c * CH; return m; }
__device__ __forceinline__ void mixer_stage_gate(Frame& F, int h) {
    LAS float* GW = (LAS float*)(F.lds + MX_GW);
    for (int i = F.tid; i < 1024; i += 512) { const int d = i >> 4, r = i & 15; GW[d * 16 + r] = F.gate_w[r * 256 + h * 64 + d]; }
    if (F.tid < 64) GW[1024 + F.tid] = F.gate_b[h * 64 + F.tid];
}
__device__ __forceinline__ void mixer_bcum(Frame& F, const f32x4 (&g)[4]) {
    LAS float* B = (LAS float*)(F.lds + MX_B); const LAS float* GW = (const LAS float*)(F.lds + MX_GW);
#pragma unroll
    for (int dd = 0; dd < 8; ++dd) { const int d = F.wave * 8 + dd; const LAS f32x4* w = (const LAS f32x4*)(GW + d * 16);
        const f32x4 w0 = w[0], w1 = w[1], w2 = w[2], w3 = w[3];
        float z = GW[1024 + d];
        z += (g[0][0] * w0[0] + g[0][1] * w0[1]) + (g[0][2] * w0[2] + g[0][3] * w0[3]);
        z += (g[1][0] * w1[0] + g[1][1] * w1[1]) + (g[1][2] * w1[2] + g[1][3] * w1[3]);
        z += (g[2][0] * w2[0] + g[2][1] * w2[1]) + (g[2][2] * w2[2] + g[2][3] * w2[3]);
        z += (g[3][0] * w3[0] + g[3][1] * w3[1]) + (g[3][2] * w3[2] + g[3][3] * w3[3]);
        float la = (fminf(z, 0.f) * LOG2E - __builtin_amdgcn_logf(1.0f + fexp2(-fabsf(z) * LOG2E))) * (1.0f / 16.0f);
        la += dppf<0x111>(la); la += dppf<0x112>(la); la += dppf<0x114>(la); la += dppf<0x118>(la);
        la += __builtin_bit_cast(float, __builtin_amdgcn_update_dpp(0, __builtin_bit_cast(int, la), 0x142, 0xA, 0xF, false));
        la += __builtin_bit_cast(float, __builtin_amdgcn_update_dpp(0, __builtin_bit_cast(int, la), 0x143, 0xC, 0xF, false));
        B[F.lane * 65 + d] = la; }
}
struct MixKvRegs { v4u k8, v8[2]; f32x4 g[4]; };
__device__ __forceinline__ void mixer_kv_load(Frame& F, const MixItem& m, MixKvRegs& R) {
    const bf16* K = m.gla ? F.GK : F.RK; const bf16* V = m.gla ? F.GV : F.RV;
    const int jq = F.tid >> 3, dq = (F.tid & 7) * 8;
    R.k8 = *(const GAS v4u*)(K + (m.t0 + jq) * 256 + m.h * 64 + dq);
#pragma unroll
    for (int i = 0; i < 2; ++i) { const int p = F.tid + 512 * i; R.v8[i] = *(const GAS v4u*)(V + (m.t0 + (p >> 4)) * 512 + m.h * 128 + (p & 15) * 8); }
    if (m.gla) { const GAS f32x4* gr = (const GAS f32x4*)(F.GLR + (m.t0 + F.lane) * 16); R.g[0] = gr[0]; R.g[1] = gr[1]; R.g[2] = gr[2]; R.g[3] = gr[3]; }
}
__device__ __forceinline__ void mixer_vt_write(Frame& F, const v4u (&v8)[2]) {
    LAS bf16* VT = (LAS bf16*)(F.lds + MX_VT);
#pragma unroll
    for (int i = 0; i < 2; ++i) { const int p = F.tid + 512 * i, jv = p >> 4, ev = (p & 15) * 8;
#pragma unroll
        for (int x = 0; x < 8; ++x) { const unsigned wv = (x < 2 ? v8[i].x : x < 4 ? v8[i].y : x < 6 ? v8[i].z : v8[i].w); VT[tsw(ev + x, jv)] = (bf16)((x & 1) ? (wv >> 16) : (wv & 0xffffu)); } }
}
#define KV_ITEM(K, GLA, ACC) do { const MixItem m = mix_item(vb, (K)); \
        if (GLA) mixer_bcum(F, R.g); \
        const v4u k8 = R.k8, va = R.v8[0], vbv = R.v8[1]; \
        __syncthreads();                                                      \
        { const int jq = F.tid >> 3, dq = (F.tid & 7) * 8; \
          _Pragma("unroll") for (int x = 0; x < 8; ++x) { const int d = dq + x; const unsigned wk = (x < 2 ? k8.x : x < 4 ? k8.y : x < 6 ? k8.z : k8.w); const float kf = (x & 1) ? bfhi(wk) : bflo(wk); \
              const float sc = (GLA) ? fexp2(B[63 * 65 + d] - B[jq * 65 + d]) : fexp2((float)(63 - jq) * l2g); \
              KL[tsw(d, jq)] = (bf16)f2bf(kf * sc); } } \
        { const v4u vv[2] = {va, vbv}; mixer_vt_write(F, vv); } \
        float dec4[4]; \
        _Pragma("unroll") for (int t = 0; t < 4; ++t) dec4[t] = (GLA) ? fexp2(B[63 * 65 + 16 * t + fr]) : g64; \
        if ((GLA) && F.tid < 64) { F.DEC[(size_t)m.item * 64 + F.tid] = cdG; cdG *= fexp2(B[63 * 65 + F.tid]); }     \
        if ((K) < 15) mixer_kv_load(F, mix_item(vb, (K) + 1), R);            \
        _Pragma("unroll") for (int t = 0; t < 4; ++t) _Pragma("unroll") for (int r = 0; r < 4; ++r) OT[(16 * F.wave + 4 * fq + r) * MS + 16 * t + fr] = (bf16)f2bf(ACC[t][r]);     \
        __syncthreads(); \
        { bf16* st = (bf16*)F.ST + (size_t)m.item * 8192; \
          _Pragma("unroll") for (int i = 0; i < 2; ++i) { const int idx = F.tid + 512 * i, e = idx >> 3, d = (idx & 7) * 8; *(GAS v4u*)(st + e * 64 + d) = *(const LAS v4u*)(OT + e * MS + d); } } \
        _Pragma("unroll") for (int t = 0; t < 4; ++t) ACC[t] = ACC[t] * dec4[t]; \
        _Pragma("unroll") for (int ks = 0; ks < 2; ++ks) { const bf16x8 aV = *(const LAS bf16x8*)(VT + tsw(16 * F.wave + fr, 32 * ks + 8 * fq)); \
            _Pragma("unroll") for (int t = 0; t < 4; ++t) { const bf16x8 bK = *(const LAS bf16x8*)(KL + tsw(16 * t + fr, 32 * ks + 8 * fq)); ACC[t] = __builtin_amdgcn_mfma_f32_16x16x32_bf16(aV, bK, ACC[t], 0, 0, 0); } } \
    } while (0)
__device__ __forceinline__ void mixer_kv_phase(Frame& F) {
    const int fr = F.lane & 15, fq = F.lane >> 4;
    LAS float* B = (LAS float*)(F.lds + MX_B); LAS bf16* KL = (LAS bf16*)(F.lds + MX_KE); LAS bf16* VT = (LAS bf16*)(F.lds + MX_VT); LAS bf16* OT = (LAS bf16*)(F.lds + MX_PT);
    for (int vb = F.vcu; vb < 256; vb += F.G) {
        __syncthreads();
        const int h = (vb >> 4) & 3; const float l2g = log2_gamma(h), g64 = fexp2(64.0f * l2g);
        mixer_stage_gate(F, h);
        MixKvRegs R; mixer_kv_load(F, mix_item(vb, 0), R);
        f32x4 accG[4], accR[4]; float cdG = 1.0f;
#pragma unroll
        for (int t = 0; t < 4; ++t) { accG[t] = (f32x4){0.f, 0.f, 0.f, 0.f}; accR[t] = (f32x4){0.f, 0.f, 0.f, 0.f}; }
        __syncthreads();
        for (int kk = 0; kk < 8; ++kk) { KV_ITEM(2 * kk, true, accG); KV_ITEM(2 * kk + 1, false, accR); }
        { const int b = vb >> 6, cg = vb & 15; const size_t gG = (size_t)((b * 8 + h) * 16 + cg), gR = (size_t)((b * 8 + 4 + h) * 16 + cg);
#pragma unroll
            for (int t = 0; t < 4; ++t)
#pragma unroll
                for (int r = 0; r < 4; ++r) { const int o = (16 * F.wave + 4 * fq + r) * 64 + 16 * t + fr; F.AGG[gG * 8192 + o] = accG[t][r]; F.AGG[gR * 8192 + o] = accR[t][r]; }
            if (F.tid < 64) { F.DAGG[gG * 64 + F.tid] = cdG; F.DAGG[gR * 64 + F.tid] = fexp2(512.0f * l2g); } }
    }
}
#undef KV_ITEM
__device__ __forceinline__ void mixer_scan(Frame& F) {
    for (int idx = F.vcu * 512 + F.tid; idx < NB * 8 * 4096; idx += F.G * 512) {
        const int bh = idx >> 12, ed = (idx & 4095) * 2, d = ed & 63; float s0 = 0.f, s1 = 0.f;
        f32x2_t a[16], dg[16];
#pragma unroll
        for (int g = 0; g < 16; ++g) { a[g] = *(const GAS f32x2_t*)(F.AGG + (size_t)(bh * 16 + g) * 8192 + ed); dg[g] = *(const GAS f32x2_t*)(F.DAGG + (size_t)(bh * 16 + g) * 64 + d); }
#pragma unroll
        for (int g = 0; g < 16; ++g) { *(GAS unsigned*)(F.SIN + (size_t)(bh * 16 + g) * 8192 + ed) = pk2(s0, s1); s0 = s0 * dg[g][0] + a[g][0]; s1 = s1 * dg[g][1] + a[g][1]; }
    }
}
struct MixOutRegs { v4u q8, k8, v8[2], p8[2], gt[2]; f32x4 g[4]; f32x4 cd[2]; };
__device__ __forceinline__ void mixer_out_load(Frame& F, const MixItem& m, MixOutRegs& R) {
    const bf16* Q = m.gla ? F.GQ : F.RQ; const bf16* K = m.gla ? F.GK : F.RK; const bf16* V = m.gla ? F.GV : F.RV; const bf16* GT = m.gla ? F.GG : F.RG;
    const int jq = F.tid >> 3, dq = (F.tid & 7) * 8;
    R.q8 = __builtin_nontemporal_load((const GAS v4u*)(Q + (m.t0 + jq) * 256 + m.h * 64 + dq));
    R.k8 = __builtin_nontemporal_load((const GAS v4u*)(K + (m.t0 + jq) * 256 + m.h * 64 + dq));
#pragma unroll
    for (int i = 0; i < 2; ++i) { const int p = F.tid + 512 * i; R.v8[i] = __builtin_nontemporal_load((const GAS v4u*)(V + (m.t0 + (p >> 4)) * 512 + m.h * 128 + (p & 15) * 8)); }
#pragma unroll
    for (int i = 0; i < 2; ++i) R.p8[i] = __builtin_nontemporal_load((const GAS v4u*)((const bf16*)F.ST + (size_t)m.item * 8192) + F.tid + 512 * i);
#pragma unroll
    for (int i = 0; i < 2; ++i) R.gt[i] = __builtin_nontemporal_load((const GAS v4u*)(GT + (m.t0 + jq) * 512 + m.h * 128 + (F.tid & 7) * 8 + 64 * i));
    if (m.gla) { const GAS f32x4* gr = (const GAS f32x4*)(F.GLR + (m.t0 + F.lane) * 16); R.g[0] = gr[0]; R.g[1] = gr[1]; R.g[2] = gr[2]; R.g[3] = gr[3];
        const GAS f32x4* cp = (const GAS f32x4*)(F.DEC + (size_t)m.item * 64 + (F.tid & 7) * 8); R.cd[0] = cp[0]; R.cd[1] = cp[1]; }
}
__device__ __forceinline__ void mixer_out_phase(Frame& F) {
    const int fr = F.lane & 15, fq = F.lane >> 4, w = F.wave;
    LAS bf16* QE = (LAS bf16*)(F.lds + MX_QE); LAS bf16* QN = (LAS bf16*)(F.lds + MX_QN); LAS bf16* KE = (LAS bf16*)(F.lds + MX_KE); LAS bf16* KN = (LAS bf16*)(F.lds + MX_KN);
    LAS bf16* VT = (LAS bf16*)(F.lds + MX_VT); LAS bf16* PT = (LAS bf16*)(F.lds + MX_PT); LAS bf16* P = (LAS bf16*)(F.lds + MX_P);
    LAS float* B = (LAS float*)(F.lds + MX_B); LAS float* RED = (LAS float*)(F.lds + MX_RED); LAS float* OUT = (LAS float*)(F.lds + MX_OUT); LAS float* NP = (LAS float*)(F.lds + MX_NP);
    const int jq = F.tid >> 3, dq = (F.tid & 7) * 8;
#define MO_SEL(MSK, A, B) __builtin_bit_cast(float, (__builtin_bit_cast(unsigned, (A)) & (MSK)) | (__builtin_bit_cast(unsigned, (B)) & ~(MSK)))
#define MO_STAGE1(GLA, KC) do { const unsigned gm_ = (GLA) ? 0xffffffffu : 0u; const float rc_ = fexp2(64.0f * (float)(KC) * l2gb); \
        float cd_[8]; _Pragma("unroll") for (int x = 0; x < 8; ++x) { const float cg_ = (x < 4) ? R.cd[0][x & 3] : R.cd[1][x & 3]; cd_[x] = MO_SEL(gm_, cg_, rc_); } \
        _Pragma("unroll") for (int i_ = 0; i_ < 2; ++i_) { const int idx_ = F.tid + 512 * i_, e_ = idx_ >> 3, d_ = (idx_ & 7) * 8; const v4u l_ = R.p8[i_]; float v_[8]; \
            v_[0] = bflo(l_.x); v_[1] = bfhi(l_.x); v_[2] = bflo(l_.y); v_[3] = bfhi(l_.y); v_[4] = bflo(l_.z); v_[5] = bfhi(l_.z); v_[6] = bflo(l_.w); v_[7] = bfhi(l_.w); \
            { const v4u sg_ = sinG[i_], sr_ = sinR[i_]; const unsigned w0_ = (sg_.x & gm_) | (sr_.x & ~gm_), w1_ = (sg_.y & gm_) | (sr_.y & ~gm_), w2_ = (sg_.z & gm_) | (sr_.z & ~gm_), w3_ = (sg_.w & gm_) | (sr_.w & ~gm_); \
              v_[0] += cd_[0] * bflo(w0_); v_[1] += cd_[1] * bfhi(w0_); v_[2] += cd_[2] * bflo(w1_); v_[3] += cd_[3] * bfhi(w1_); \
              v_[4] += cd_[4] * bflo(w2_); v_[5] += cd_[5] * bfhi(w2_); v_[6] += cd_[6] * bflo(w3_); v_[7] += cd_[7] * bfhi(w3_); }     \
            *(LAS v4u*)(PT + e_ * MS + d_) = (v4u){pk2(v_[0], v_[1]), pk2(v_[2], v_[3]), pk2(v_[4], v_[5]), pk2(v_[6], v_[7])}; } \
        if (GLA) mixer_bcum(F, R.g); mixer_vt_write(F, R.v8); } while (0)
#define MO_IMAGES(GLA) do { const v4u q8_ = R.q8, k8_ = R.k8; \
        if (GLA) { float qf[8], kf[8], eb[8], en[8]; \
            _Pragma("unroll") for (int x = 0; x < 8; ++x) { const unsigned wq = (x < 2 ? q8_.x : x < 4 ? q8_.y : x < 6 ? q8_.z : q8_.w), wk = (x < 2 ? k8_.x : x < 4 ? k8_.y : x < 6 ? k8_.z : k8_.w); \
                qf[x] = (x & 1) ? bfhi(wq) : bflo(wq); kf[x] = (x & 1) ? bfhi(wk) : bflo(wk); const float bv = B[jq * 65 + dq + x]; eb[x] = fexp2(bv); en[x] = fexp2(-bv); } \
            *(LAS v4u*)(QE + jq * MS + dq) = (v4u){pk2(qf[0] * eb[0], qf[1] * eb[1]), pk2(qf[2] * eb[2], qf[3] * eb[3]), pk2(qf[4] * eb[4], qf[5] * eb[5]), pk2(qf[6] * eb[6], qf[7] * eb[7])}; \
            *(LAS v4u*)(QN + jq * MS + dq) = (v4u){pk2(qf[0] * en[0], qf[1] * en[1]), pk2(qf[2] * en[2], qf[3] * en[3]), pk2(qf[4] * en[4], qf[5] * en[5]), pk2(qf[6] * en[6], qf[7] * en[7])}; \
            *(LAS v4u*)(KE + jq * MS + dq) = (v4u){pk2(kf[0] * eb[0], kf[1] * eb[1]), pk2(kf[2] * eb[2], kf[3] * eb[3]), pk2(kf[4] * eb[4], kf[5] * eb[5]), pk2(kf[6] * eb[6], kf[7] * eb[7])}; \
            *(LAS v4u*)(KN + jq * MS + dq) = (v4u){pk2(kf[0] * en[0], kf[1] * en[1]), pk2(kf[2] * en[2], kf[3] * en[3]), pk2(kf[4] * en[4], kf[5] * en[5]), pk2(kf[6] * en[6], kf[7] * en[7])}; \
        } else { *(LAS v4u*)(QE + jq * MS + dq) = q8_; *(LAS v4u*)(KN + jq * MS + dq) = k8_; } } while (0)
    for (int vb = F.vcu; vb < 256; vb += F.G) {
        __syncthreads();
        mixer_stage_gate(F, (vb >> 4) & 3);
        if (F.tid < 384) { const int hh = (vb >> 4) & 3, e_ = F.tid & 127; NP[F.tid] = F.tid < 128 ? F.gla_g[e_] : F.tid < 256 ? F.ret_g[hh * 128 + e_] : F.ret_b[hh * 128 + e_]; }
        MixOutRegs R; mixer_out_load(F, mix_item(vb, 0), R);
        const float l2gb = log2_gamma((vb >> 4) & 3);
        v4u sinG[2], sinR[2];
        { const int b_ = vb >> 6, h_ = (vb >> 4) & 3, cg_ = vb & 15; const size_t gG = (size_t)((b_ * 8 + h_) * 16 + cg_), gR = (size_t)((b_ * 8 + 4 + h_) * 16 + cg_);
#pragma unroll
            for (int i = 0; i < 2; ++i) { const int idx = F.tid + 512 * i, e = idx >> 3, d = (idx & 7) * 8;
                sinG[i] = *(const GAS v4u*)(F.SIN + gG * 8192 + e * 64 + d); sinR[i] = *(const GAS v4u*)(F.SIN + gR * 8192 + e * 64 + d); } }
        __syncthreads();
        v4u gc0, gc1, gn0, gn1;
        { const MixItem m0 = mix_item(vb, 0); MO_STAGE1(m0.gla, 0); gc0 = R.gt[0]; gc1 = R.gt[1]; gn0 = gc0; gn1 = gc1;
            __syncthreads();
            MO_IMAGES(m0.gla); mixer_out_load(F, mix_item(vb, 1), R);
            __syncthreads(); }
        for (int k = 0; k < 16; ++k) { const MixItem m = mix_item(vb, k); const bool gla = m.gla; const int h = m.h;
            const float l2g = log2_gamma(h);
            { const int mi = w >> 1;
#pragma unroll
                for (int t = 0; t < 2; ++t) { const int nj = (w & 1) * 2 + t; f32x4 lo = (f32x4){0.f, 0.f, 0.f, 0.f}, up = (f32x4){0.f, 0.f, 0.f, 0.f};
#pragma unroll
                    for (int ks = 0; ks < 2; ++ks) { const int ao = (16 * mi + fr) * MS + 32 * ks + 8 * fq, bo = (16 * nj + fr) * MS + 32 * ks + 8 * fq;
                        lo = __builtin_amdgcn_mfma_f32_16x16x32_bf16(*(const LAS bf16x8*)(QE + ao), *(const LAS bf16x8*)(KN + bo), lo, 0, 0, 0);
                        if (gla) up = __builtin_amdgcn_mfma_f32_16x16x32_bf16(*(const LAS bf16x8*)(QN + ao), *(const LAS bf16x8*)(KE + bo), up, 0, 0, 0); }
#pragma unroll
                    for (int r = 0; r < 4; ++r) { const int i = 16 * mi + 4 * fq + r, j = 16 * nj + fr; float pv;
                        if (gla) pv = (i >= j) ? lo[r] : up[r]; else pv = lo[r] * fexp2((float)(i >= j ? i - j : j - i) * l2g);
                        P[i * MS + j] = (bf16)f2bf(pv); } } }
            __syncthreads();
            const int mi = w & 3, nt0 = (w >> 2) * 4;
            f32x4 oi[4], oe[4];
#pragma unroll
            for (int t = 0; t < 4; ++t) { oi[t] = (f32x4){0.f, 0.f, 0.f, 0.f}; oe[t] = (f32x4){0.f, 0.f, 0.f, 0.f}; }
#pragma unroll
            for (int ks = 0; ks < 2; ++ks) { const int ao = (16 * mi + fr) * MS + 32 * ks + 8 * fq; const bf16x8 aP = *(const LAS bf16x8*)(P + ao), aQ = *(const LAS bf16x8*)(QE + ao);
#pragma unroll
                for (int t = 0; t < 4; ++t) { const int bo = (16 * (nt0 + t) + fr) * MS + 32 * ks + 8 * fq;
                    oi[t] = __builtin_amdgcn_mfma_f32_16x16x32_bf16(aP, *(const LAS bf16x8*)(VT + tsw(16 * (nt0 + t) + fr, 32 * ks + 8 * fq)), oi[t], 0, 0, 0);
                    oe[t] = __builtin_amdgcn_mfma_f32_16x16x32_bf16(aQ, *(const LAS bf16x8*)(PT + bo), oe[t], 0, 0, 0); } }
            float s1[4], s2[4];
#pragma unroll
            for (int r = 0; r < 4; ++r) { const int i = 16 * mi + 4 * fq + r; const float rs = gla ? 1.0f : fexp2((float)(i + 1) * l2g); s1[r] = 0.f; s2[r] = 0.f;
#pragma unroll
                for (int t = 0; t < 4; ++t) { const float o = oi[t][r] + rs * oe[t][r]; oi[t][r] = o; s1[r] += o; s2[r] += o * o; } }
#pragma unroll
            for (int r = 0; r < 4; ++r) {
                s1[r] += dppf<0xB1>(s1[r]); s1[r] += dppf<0x4E>(s1[r]); s1[r] += dppf<0x141>(s1[r]); s1[r] += dppf<0x140>(s1[r]);
                s2[r] += dppf<0xB1>(s2[r]); s2[r] += dppf<0x4E>(s2[r]); s2[r] += dppf<0x141>(s2[r]); s2[r] += dppf<0x140>(s2[r]);
                if (fr == 0) { const int i = 16 * mi + 4 * fq + r; RED[(i * 2 + (w >> 2)) * 2] = s1[r]; RED[(i * 2 + (w >> 2)) * 2 + 1] = s2[r]; } }
            __syncthreads();
#pragma unroll
            for (int r = 0; r < 4; ++r) { const int i = 16 * mi + 4 * fq + r;
                const float a1 = RED[i * 4] + RED[i * 4 + 2], a2 = RED[i * 4 + 1] + RED[i * 4 + 3];
                const float mu = gla ? 0.f : a1 * (1.f / 128.f); const float var = a2 * (1.f / 128.f) - mu * mu; const float rstd = 1.0f / sqrtf(var + LN_EPS);
#pragma unroll
                for (int t = 0; t < 4; ++t) { const int e = 16 * (nt0 + t) + fr;
                    OUT[i * OUTS + e] = gla ? oi[t][r] * rstd * NP[e] : (oi[t][r] - mu) * rstd * NP[128 + e] + NP[256 + e]; } }
            if (k < 15) { const MixItem mn = mix_item(vb, k + 1); MO_STAGE1(mn.gla, (k + 1) >> 1); gn0 = R.gt[0]; gn1 = R.gt[1]; }
            __syncthreads();
            { const int e0 = (F.tid & 7) * 8; const LAS f32x4* op = (const LAS f32x4*)(OUT + jq * OUTS + e0); float val[16];
#pragma unroll
                for (int x4 = 0; x4 < 4; ++x4) { const f32x4 o = op[(x4 & 1) + 16 * (x4 >> 1)]; val[4 * x4] = o.x; val[4 * x4 + 1] = o.y; val[4 * x4 + 2] = o.z; val[4 * x4 + 3] = o.w; }
#pragma unroll
                for (int x = 0; x < 16; ++x) { const v4u gv = x < 8 ? gc0 : gc1; const int xx = x & 7; const unsigned wg = (xx < 2 ? gv.x : xx < 4 ? gv.y : xx < 6 ? gv.z : gv.w); const float g = (xx & 1) ? bfhi(wg) : bflo(wg);
                    val[x] *= g * __builtin_amdgcn_rcpf(1.0f + fexp2(-g * LOG2E)); }
                v4u o0, o1;
                o0.x = pk2(val[0], val[1]); o0.y = pk2(val[2], val[3]); o0.z = pk2(val[4], val[5]); o0.w = pk2(val[6], val[7]);
                o1.x = pk2(val[8], val[9]); o1.y = pk2(val[10], val[11]); o1.z = pk2(val[12], val[13]); o1.w = pk2(val[14], val[15]);
                GAS v4u* dst = (GAS v4u*)(F.MIXED + (m.t0 + jq) * D + m.h8 * 128 + e0); dst[0] = o0; dst[8] = o1; }
            if (k < 15) { const MixItem mn = mix_item(vb, k + 1); MO_IMAGES(mn.gla); if (k < 14) mixer_out_load(F, mix_item(vb, k + 2), R); }
            gc0 = gn0; gc1 = gn1;
            __syncthreads();
        }
    }
#undef MO_STAGE1
#undef MO_SEL
#undef MO_IMAGES
}

__device__ __forceinline__ void p6_ln1_route(Frame& F) {
    LAS bf16* WB = (LAS bf16*)(F.lds + RING_OFF);
    f32x4 rw[16];
#pragma unroll
    for (int u = 0; u < 16; ++u) rw[u] = *((const GAS f32x4*)F.router_w + F.tid + 512 * u);
#pragma unroll
    for (int u = 0; u < 16; ++u) { const int idx = F.tid + 512 * u; const int c = idx >> 3, ch = idx & 7; const f32x4 wv = rw[u];
#pragma unroll
        for (int x = 0; x < 4; ++x) { const int e = 4 * ch + x; const float w = wv[x]; const unsigned hi = f2bf(w); const float rem = w - bf2f(hi);
            const int off = e * 2048 + ((((c >> 3) ^ (e & 15)) << 3) | (c & 7)); WB[off] = (bf16)hi; WB[off + 1024] = (bf16)f2bf(rem); } }
    LAS unsigned* lcnt = (LAS unsigned*)(F.lds + X_LCNT); LAS unsigned* lbase = (LAS unsigned*)(F.lds + X_LBASE); LAS unsigned* nasg = (LAS unsigned*)(F.lds + X_NASG); LAS unsigned* asg = (LAS unsigned*)(F.lds + X_ASG);
    const int gw = F.vcu * NWAVES + F.wave, NGW = F.G * NWAVES, lane = F.lane, r16 = lane & 15, cq = lane >> 4;
    const float rb0 = F.router_b[r16], rb1 = F.router_b[16 + r16];
    for (int base = 0; base < M / 16; base += NGW) {
        if (F.tid < 32) lcnt[F.tid] = 0u; if (F.tid == 32) nasg[0] = 0u;
        __syncthreads();
        const int tile = base + gw;
        if (tile < M / 16) {
            const int row = 16 * tile + r16;
            const bf16* xrow = (const bf16*)F.PRE1 + (size_t)row * D + 8 * cq;
            float sum = 0.f, sq = 0.f;
#pragma unroll 8
            for (int s = 0; s < 32; ++s) { const v4u x = *(const GAS v4u*)(xrow + 32 * s);
                const float f0 = bflo(x.x), f1 = bfhi(x.x), f2 = bflo(x.y), f3 = bfhi(x.y), f4 = bflo(x.z), f5 = bfhi(x.z), f6 = bflo(x.w), f7 = bfhi(x.w);
                sum += ((f0 + f1) + (f2 + f3)) + ((f4 + f5) + (f6 + f7)); sq += ((f0 * f0 + f1 * f1) + (f2 * f2 + f3 * f3)) + ((f4 * f4 + f5 * f5) + (f6 * f6 + f7 * f7)); }
            sum += __shfl_xor(sum, 16); sum += __shfl_xor(sum, 32); sq += __shfl_xor(sq, 16); sq += __shfl_xor(sq, 32);
            const float mean = sum * (1.f / D); const float rstd = 1.0f / sqrtf(fmaxf(sq * (1.f / D) - mean * mean, 0.f) + LN_EPS);
            f32x4 acc[2]; acc[0] = (f32x4){0.f, 0.f, 0.f, 0.f}; acc[1] = (f32x4){0.f, 0.f, 0.f, 0.f};
            int bt[2][4];
#pragma unroll
            for (int nt = 0; nt < 2; ++nt)
#pragma unroll
                for (int j = 0; j < 4; ++j) bt[nt][j] = (16 * nt + r16) * 2048 + (((4 * j + cq) ^ r16) << 3);
            GAS unsigned char* hq = (GAS unsigned char*)F.H1B + (size_t)row * D + 8 * cq;
            for (int s4 = 0; s4 < 8; ++s4) {
#pragma unroll
                for (int j = 0; j < 4; ++j) { const int s = 4 * s4 + j, c0 = 32 * s + 8 * cq; const v4u x = *(const GAS v4u*)(xrow + 32 * s);
                    const f32x4 ga = *(const GAS f32x4*)(F.ln1_g + c0), gb = *(const GAS f32x4*)(F.ln1_g + c0 + 4), ba = *(const GAS f32x4*)(F.ln1_b + c0), bb = *(const GAS f32x4*)(F.ln1_b + c0 + 4);
                    float h[8];
                    h[0] = (bflo(x.x) - mean) * rstd * ga[0] + ba[0]; h[1] = (bfhi(x.x) - mean) * rstd * ga[1] + ba[1]; h[2] = (bflo(x.y) - mean) * rstd * ga[2] + ba[2]; h[3] = (bfhi(x.y) - mean) * rstd * ga[3] + ba[3];
                    h[4] = (bflo(x.z) - mean) * rstd * gb[0] + bb[0]; h[5] = (bfhi(x.z) - mean) * rstd * gb[1] + bb[1]; h[6] = (bflo(x.w) - mean) * rstd * gb[2] + bb[2]; h[7] = (bfhi(x.w) - mean) * rstd * gb[3] + bb[3];
                    typedef unsigned u32x2_t __attribute__((ext_vector_type(2)));
                    *(GAS u32x2_t*)(hq + 32 * s) = (u32x2_t){pk4_fp8(h[0] * QS_H1, h[1] * QS_H1, h[2] * QS_H1, h[3] * QS_H1), pk4_fp8(h[4] * QS_H1, h[5] * QS_H1, h[6] * QS_H1, h[7] * QS_H1)};
                    v4u ahi, alo;
                    ahi.x = pk2(h[0], h[1]); ahi.y = pk2(h[2], h[3]); ahi.z = pk2(h[4], h[5]); ahi.w = pk2(h[6], h[7]);
                    alo.x = pk2(h[0] - bflo(ahi.x), h[1] - bfhi(ahi.x)); alo.y = pk2(h[2] - bflo(ahi.y), h[3] - bfhi(ahi.y)); alo.z = pk2(h[4] - bflo(ahi.z), h[5] - bfhi(ahi.z)); alo.w = pk2(h[6] - bflo(ahi.w), h[7] - bfhi(ahi.w));
                    const bf16x8 Ah = __builtin_bit_cast(bf16x8, ahi), Al = __builtin_bit_cast(bf16x8, alo);
#pragma unroll
                    for (int nt = 0; nt < 2; ++nt) { const LAS bf16* wp = WB + bt[nt][j] + s4 * 128;
                        const bf16x8 Bh = *(const LAS bf16x8*)wp, Bl = *(const LAS bf16x8*)(wp + 1024);
                        acc[nt] = __builtin_amdgcn_mfma_f32_16x16x32_bf16(Ah, Bh, acc[nt], 0, 0, 0);
                        acc[nt] = __builtin_amdgcn_mfma_f32_16x16x32_bf16(Ah, Bl, acc[nt], 0, 0, 0);
                        acc[nt] = __builtin_amdgcn_mfma_f32_16x16x32_bf16(Al, Bh, acc[nt], 0, 0, 0); } } }
#pragma unroll
            for (int reg = 0; reg < 4; ++reg) { const int trow = 16 * tile + 4 * cq + reg;
                float a0 = acc[0][reg] + rb0, a1 = acc[1][reg] + rb1; float tv[4]; int ti[4];
#pragma unroll
                for (int k = 0; k < 4; ++k) { float mx; int idx; if (a1 > a0) { mx = a1; idx = 16 + r16; } else { mx = a0; idx = r16; }
#define P6_STEP(OM, OI) { const float om = (OM); const int oi = (OI); if (om > mx || (om == mx && oi < idx)) { mx = om; idx = oi; } }
                    P6_STEP(dppf<0xB1>(mx), dppi<0xB1>(idx)) P6_STEP(dppf<0x4E>(mx), dppi<0x4E>(idx)) P6_STEP(dppf<0x141>(mx), dppi<0x141>(idx)) P6_STEP(dppf<0x140>(mx), dppi<0x140>(idx))
#undef P6_STEP
                    tv[k] = mx; ti[k] = idx; if (idx == r16) a0 = -3.0e38f; if (idx == 16 + r16) a1 = -3.0e38f; }
                const float e1 = expf(tv[1] - tv[0]), e2 = expf(tv[2] - tv[0]), e3 = expf(tv[3] - tv[0]); const float inv = 1.f / (1.f + e1 + e2 + e3);
                if (r16 < 4) { const float gk = (r16 == 0 ? 1.f : r16 == 1 ? e1 : r16 == 2 ? e2 : e3) * inv; const int ek = (r16 == 0 ? ti[0] : r16 == 1 ? ti[1] : r16 == 2 ? ti[2] : ti[3]);
                    const unsigned tk = (unsigned)(trow * 4 + r16);
                    const unsigned lp = __hip_atomic_fetch_add(lcnt + ek, 1u, __ATOMIC_RELAXED, __HIP_MEMORY_SCOPE_WORKGROUP); const unsigned sl = __hip_atomic_fetch_add(nasg, 1u, __ATOMIC_RELAXED, __HIP_MEMORY_SCOPE_WORKGROUP);
                    asg[sl] = tk | ((unsigned)ek << 17) | (lp << 22); asg[512 + sl] = __builtin_bit_cast(unsigned, gk); } }
        }
        __syncthreads();
        if (F.tid < 32) { const unsigned n = lcnt[F.tid]; lbase[F.tid] = n ? __hip_atomic_fetch_add(F.counts + F.tid, n, __ATOMIC_RELAXED, __HIP_MEMORY_SCOPE_AGENT) : 0u; }
        __syncthreads();
        const unsigned na = nasg[0];
        for (unsigned i = F.tid; i < na; i += 512) { const unsigned a = asg[i]; const unsigned tk = a & 0x1ffffu, e = (a >> 17) & 31u, lp = a >> 22; const size_t o = (size_t)e * M + lbase[e] + lp; F.list[o] = (int)tk; F.slotg[o] = __builtin_bit_cast(float, asg[512 + i]); F.tkslot[tk] = (int)((e << 20) | (lbase[e] + lp)); }
        __syncthreads();
    }
}
__device__ __forceinline__ int moe_tables(Frame& F) {
    LAS int* cnt = (LAS int*)(F.lds + X_CNT); LAS int* ts = (LAS int*)(F.lds + X_TSTART);
    __syncthreads();
    if (F.tid < 32) cnt[F.tid] = (int)__hip_atomic_load(F.counts + F.tid, __ATOMIC_RELAXED, __HIP_MEMORY_SCOPE_AGENT);
    __syncthreads();
    if (F.tid == 0) { int a = 0; for (int e = 0; e < 32; ++e) { ts[e] = a; a += (cnt[e] + 255) >> 8; } ts[32] = a; }
    __syncthreads();
    return __builtin_amdgcn_readfirstlane(ts[32]);
}
__device__ __forceinline__ void p10_final(Frame& F) {
    (void)moe_tables(F); const LAS int* ts = (const LAS int*)(F.lds + X_TSTART);
    const int gw = F.vcu * NWAVES + F.wave, NGW = F.G * NWAVES, lane = F.lane;
    typedef unsigned long long u64; typedef int i32x4v __attribute__((ext_vector_type(4))); typedef float f32x2v __attribute__((ext_vector_type(2)));
    const int cb = ((lane >> 1) & 1) * 128 + (lane >> 4) * 32 + ((lane >> 2) & 3) * 8 + 4 * (lane & 1);
    f32x4 g4[4], b4[4], g1[4], b1[4];
#pragma unroll
    for (int j = 0; j < 4; ++j) { g4[j] = *(const GAS f32x4*)(F.ln2_g + 256 * j + cb); b4[j] = *(const GAS f32x4*)(F.ln2_b + 256 * j + cb);
        g1[j] = *(const GAS f32x4*)(F.ln1_g + 256 * j + cb); b1[j] = *(const GAS f32x4*)(F.ln1_b + 256 * j + cb); }
    u64 nh[4]; unsigned ny[4][4]; i32x4v ns; int row = gw;
#define P10_SLOTS(R) do { ns = *((const GAS i32x4v*)F.tkslot + (R)); } while (0)
#define P10_LOAD(R) do { int sl_[4]; sl_[0] = ts[ns.x >> 20] * 256 + (ns.x & 0xfffff); sl_[1] = ts[ns.y >> 20] * 256 + (ns.y & 0xfffff); sl_[2] = ts[ns.z >> 20] * 256 + (ns.z & 0xfffff); sl_[3] = ts[ns.w >> 20] * 256 + (ns.w & 0xfffff); \
        _Pragma("unroll") for (int j = 0; j < 4; ++j) { nh[j] = __builtin_nontemporal_load((const GAS u64*)((const bf16*)F.PRE1 + (size_t)(R) * D + 256 * j + cb)); \
        _Pragma("unroll") for (int k = 0; k < 4; ++k) ny[j][k] = __builtin_nontemporal_load((const GAS unsigned*)((const GAS unsigned char*)F.Y + (size_t)sl_[k] * D) + lane + 64 * j); } } while (0)
    if (row < M) { P10_SLOTS(row); P10_LOAD(row); if (row + NGW < M) P10_SLOTS(row + NGW); }
    for (; row < M; row += NGW) {
        f32x4 v[4], y[4]; float s = 0.f;
#pragma unroll
        for (int j = 0; j < 4; ++j) { const unsigned lo = (unsigned)nh[j], hi = (unsigned)(nh[j] >> 32);
            v[j] = (f32x4){__builtin_bit_cast(float, lo << 16), __builtin_bit_cast(float, lo & 0xffff0000u), __builtin_bit_cast(float, hi << 16), __builtin_bit_cast(float, hi & 0xffff0000u)};
            s += (v[j].x + v[j].y) + (v[j].z + v[j].w);
            y[j] = (f32x4){0.f, 0.f, 0.f, 0.f};
#pragma unroll
            for (int k = 0; k < 4; ++k) { const f32x2v p0 = __builtin_amdgcn_cvt_pk_f32_fp8((int)ny[j][k], false), p1 = __builtin_amdgcn_cvt_pk_f32_fp8((int)ny[j][k], true);
                y[j].x += p0.x; y[j].y += p0.y; y[j].z += p1.x; y[j].w += p1.y; } }
        if (row + NGW < M) { P10_LOAD(row + NGW); if (row + 2 * NGW < M) P10_SLOTS(row + 2 * NGW); }
        const float mean1 = wave_sum(s) * (1.f / D); float q1 = 0.f;
#pragma unroll
        for (int j = 0; j < 4; ++j) { v[j] = v[j] - mean1; q1 += (v[j].x * v[j].x + v[j].y * v[j].y) + (v[j].z * v[j].z + v[j].w * v[j].w); }
        const float rstd1 = 1.f / sqrtf(wave_sum(q1) * (1.f / D) + LN_EPS);
        float s2 = 0.f;
#pragma unroll
        for (int j = 0; j < 4; ++j) { v[j] = (v[j] * rstd1 * g1[j] + b1[j]) * ALPHA + y[j] * (1.0f / QS_Y); s2 += (v[j].x + v[j].y) + (v[j].z + v[j].w); }
        const float mean = wave_sum(s2) * (1.f / D); float q2 = 0.f;
#pragma unroll
        for (int j = 0; j < 4; ++j) { v[j] = v[j] - mean; q2 += (v[j].x * v[j].x + v[j].y * v[j].y) + (v[j].z * v[j].z + v[j].w * v[j].w); }
        const float rstd = 1.f / sqrtf(wave_sum(q2) * (1.f / D) + LN_EPS);
        float* hr = F.out + (size_t)row * D + cb;
#pragma unroll
        for (int j = 0; j < 4; ++j) __builtin_nontemporal_store(v[j] * rstd * g4[j] + b4[j], (GAS f32x4*)(hr + 256 * j));
    }
#undef P10_LOAD
#undef P10_SLOTS
}

struct Args { const void* in[21]; float* out; unsigned char* ws; int ph_lo, ph_hi; };
__global__ void __launch_bounds__(NWAVES * 64, 2) fwd_kernel(Args args) {
    extern __shared__ __attribute__((aligned(16))) unsigned char lds[];
    Frame F;
    F.lds = (LAS unsigned char*)lds;
    F.MISC = (volatile LAS unsigned*)(F.lds + MISC_OFF);
    F.tid = threadIdx.x; F.lane = F.tid & 63; F.wave = __builtin_amdgcn_readfirstlane(F.tid >> 6);
    F.G = gridDim.x; { const int bx = blockIdx.x; F.vcu = (F.G % 8 == 0) ? (bx % 8) * (F.G / 8) + bx / 8 : bx; }
    unsigned char* ws = args.ws;
    F.ctl = (gu32*)(ws + WS_CTL);
    F.x = (const float*)args.in[0]; F.positions = (const int*)args.in[1]; F.ln_in_g = (const float*)args.in[2]; F.ln_in_b = (const float*)args.in[3];
    F.w_in = (const float*)args.in[4]; F.gate_w = (const float*)args.in[5]; F.gate_b = (const float*)args.in[6]; F.gla_g = (const float*)args.in[7];
    F.ret_g = (const float*)args.in[8]; F.ret_b = (const float*)args.in[9]; F.w_out = (const float*)args.in[10]; F.ln1_g = (const float*)args.in[11]; F.ln1_b = (const float*)args.in[12];
    F.router_w = (const float*)args.in[13]; F.router_b = (const float*)args.in[14]; F.w1 = (const float*)args.in[15]; F.b1 = (const float*)args.in[16];
    F.w2 = (const float*)args.in[17]; F.b2 = (const float*)args.in[18]; F.ln2_g = (const float*)args.in[19]; F.ln2_b = (const float*)args.in[20];
    F.out = args.out;
    F.stats0 = (float*)(ws + WS_STATS0); F.cosT = (float*)(ws + WS_COS); F.sinT = (float*)(ws + WS_SIN); F.ST = (float*)(ws + WS_ST); F.DEC = (float*)(ws + WS_DEC); F.PRE1 = (float*)(ws + WS_PRE1);
    F.AGG = (float*)(ws + WS_AGG); F.SIN = (bf16*)(ws + WS_SINS); F.DAGG = (float*)(ws + WS_DAGG); F.GLR = (float*)(ws + WS_PROJ + PJ_GLR); F.gates = (float*)(ws + WS_GATES);
    F.WinT = (bf16*)(ws + WS_WINT); F.WoT = (bf16*)(ws + WS_WOT); F.W1T = (bf16*)(ws + WS_W1T); F.W2T = (bf16*)(ws + WS_W2T); F.H0B = (bf16*)(ws + WS_H0B); F.MIXED = (bf16*)(ws + WS_MIXED);
    F.GQ = (bf16*)(ws + WS_PROJ + PJ_GQ); F.GK = (bf16*)(ws + WS_PROJ + PJ_GK); F.GV = (bf16*)(ws + WS_PROJ + PJ_GV); F.GG = (bf16*)(ws + WS_PROJ + PJ_GG);
    F.RQ = (bf16*)(ws + WS_PROJ + PJ_RQ); F.RK = (bf16*)(ws + WS_PROJ + PJ_RK); F.RV = (bf16*)(ws + WS_PROJ + PJ_RV); F.RG = (bf16*)(ws + WS_PROJ + PJ_RG);
    F.H1B = (bf16*)(ws + WS_H1B); F.XS = (bf16*)(ws + WS_XS); F.ACT = (bf16*)(ws + WS_ACT); F.Y = (bf16*)(ws + WS_Y);
    F.list = (int*)(ws + WS_LIST); F.slotg = (float*)(ws + WS_SLOTG); F.tkslot = (int*)(ws + WS_GATES); F.counts = (unsigned*)(ws + WS_CTL) + CW_COUNTS;
    for (int u = F.tid; u < (LDS_BYTES - LDSCTL_OFF) / 4; u += NWAVES * 64) ((LAS unsigned*)(F.lds + LDSCTL_OFF))[u] = 0u;
    __syncthreads();
    const int lo = args.ph_lo, hi = args.ph_hi;
    const bool multi = (hi - lo) > 1;
    XcdBarrier bar; bar.bar = (unsigned*)(F.ctl + CW_BAR); bar.x = 0; bar.st = nullptr;
    if (multi) bar = xcd_barrier_post((unsigned*)(F.ctl + CW_BAR), F.MISC + 8);
#define IN(k) (lo <= (k) && (k) < hi)
#define SEAM(k) do { if (IN(k) && (IN((k) + 1) || ((k) == 6 && IN(8)))) xcd_barrier(bar); } while (0)

    if (IN(0)) { p0_prologue(F); SEAM(0); }
    if (IN(1)) { {
        pg8::Gemm g{F.H0B, F.WinT, M, NPROJ_T * 256, D, nullptr}; pg8::StaticOrder S; S.init(M, NPROJ_T * 256, F.G, (int)blockIdx.x);
        pg8::EpiProj E{F.GQ, F.GK, F.GV, F.GG, F.RQ, F.RK, F.RV, F.RG, F.GLR, F.cosT, F.sinT};
        pg8::gemm_phase<pg8::EpiProj, pg8::StaticOrder, true, true>(F.lds + RING_OFF, g, S, E); }
        SEAM(1);
    }
    if (IN(2)) { mixer_kv_phase(F); SEAM(2); }
    if (IN(3)) { mixer_scan(F); SEAM(3); }
    if (IN(4)) { mixer_out_phase(F); SEAM(4); }
    if (IN(5)) { {
        pg8::Gemm g{F.MIXED, F.WoT, M, D, D, nullptr}; pg8::StaticOrder S; S.init(M, D, F.G, (int)blockIdx.x);
        pg8::EpiOutProj E{F.H0B, (bf16*)F.PRE1, ALPHA};
        pg8::gemm_phase<pg8::EpiOutProj, pg8::StaticOrder, true, true>(F.lds + RING_OFF, g, S, E); }
        SEAM(5);
    }
    if (IN(6)) { p6_ln1_route(F); SEAM(6); }
    if (IN(8)) {
        const int ntiles = moe_tables(F);
        pg8::GroupedOrder S; S.init(ntiles, 8, F.G, (int)blockIdx.x, (const LAS int*)(F.lds + X_TSTART));
        { LAS unsigned* gtab = (LAS unsigned*)(F.lds + X_GTAB); const LAS int* cntl = (const LAS int*)(F.lds + X_CNT); pg8::Unit u;
            for (int i = 0; i < GT_MAXU && S.next(i, u); ++i) if (F.tid < 256) { const int lr = u.lt * 256 + F.tid;
                gtab[i * 256 + F.tid] = (lr < cntl[u.e]) ? (unsigned)(F.list[(size_t)u.e * M + lr] >> 2) * (unsigned)D : 0u; }
            __syncthreads(); }
        pg8::Gemm g{F.H1B, F.W1T, M, 2 * DFF, D, (const LAS unsigned*)(F.lds + X_GTAB)};
        pg8::EpiSwiGLU E{(unsigned char*)F.ACT, F.b1, 1.0f / (QS_H1 * QS_W)};
        pg8::gemm_phase<pg8::EpiSwiGLU, pg8::GroupedOrder, true, true, 1, true>(F.lds + RING_OFF, g, S, E);
        SEAM(8);
    }
    if (IN(9)) { {
        const int ntiles = moe_tables(F);
        pg8::Gemm g{F.ACT, F.W2T, ntiles * 256, D, DFF, nullptr}; pg8::GroupedOrder S; S.init(ntiles, 4, F.G, (int)blockIdx.x, (const LAS int*)(F.lds + X_TSTART));
        { LAS float* gt = (LAS float*)(F.lds + X_GTAB); const LAS int* cntl = (const LAS int*)(F.lds + X_CNT); pg8::Unit u;
            for (int i = 0; i < GT_MAXU && S.next(i, u); ++i) if (F.tid < 256) { const int lr = u.lt * 256 + F.tid; gt[i * 256 + F.tid] = (lr < cntl[u.e]) ? F.slotg[(size_t)u.e * M + lr] : 0.f; }
            __syncthreads(); }
        pg8::EpiMoeOut E{(unsigned char*)F.Y, F.b2, (const LAS float*)(F.lds + X_GTAB), 1.0f / (QS_ACT * QS_W)};
        pg8::gemm_phase<pg8::EpiMoeOut, pg8::GroupedOrder, true, true, 1>(F.lds + RING_OFF, g, S, E); }
        SEAM(9);
    }
    if (IN(10)) { p10_final(F); }
#undef IN
#undef SEAM
}

extern "C" void kernel_launch(void* const* d_in, const int* in_sizes, int n_in, void* d_out, int out_size, void* d_ws, size_t ws_size, hipStream_t stream) {
    static int grid = 0;
    if (grid == 0) {
        if (n_in != 21 || out_size != M * D || ws_size < WS_END) { fprintf(stderr, "kernel_launch: unexpected problem (n_in %d, out %d, ws %zu)\n", n_in, out_size, ws_size); grid = -1; return; }
        int dev = 0, cus = 0;
        if (hipGetDevice(&dev) != hipSuccess || hipDeviceGetAttribute(&cus, hipDeviceAttributeMultiprocessorCount, dev) != hipSuccess) { grid = -1; return; }
        if (hipFuncSetAttribute((const void*)fwd_kernel, hipFuncAttributeMaxDynamicSharedMemorySize, LDS_BYTES) != hipSuccess) { fprintf(stderr, "kernel_launch: hipFuncSetAttribute failed\n"); grid = -1; return; }
        (void)hipGetLastError();
        grid = cus;
    }
    if (grid < 0) return;
    if (hipMemsetAsync((char*)d_ws + WS_CTL, 0, CTL_ZERO_BYTES, stream) != hipSuccess) return;
    Args a{};
    for (int i = 0; i < 21; ++i) a.in[i] = d_in[i];
    a.out = (float*)d_out; a.ws = (unsigned char*)d_ws;
    constexpr int NL = MK_N_LAUNCHES;
    for (int li = 0; li < NL; ++li) {
        a.ph_lo = (NL == 1) ? 0 : li; a.ph_hi = (NL == 1) ? NPH : li + 1;
        hipLaunchKernelGGL(fwd_kernel, dim3(grid), dim3(NWAVES * 64), LDS_BYTES, stream, a);
    }
}
```

```cpp
#include <hip/hip_runtime.h>
#include <cstdio>
#include <cstdint>

#ifndef MK_N_LAUNCHES
#define MK_N_LAUNCHES 1
#endif

constexpr int NB = 4, SEQ = 8192, D = 1024, M = NB * SEQ, CH = 64, NCH = SEQ / CH;
constexpr int PW = 3088, NE = 32, DFF = 1024;
constexpr int NPROJ_T = 12;
constexpr float LN_EPS = 1e-5f;
constexpr float ALPHA = 1.189207115002721f;
constexpr int MAXTILES = (M * 4) / 256 + NE;
constexpr int NITEM = NB * 8 * NCH;
constexpr float QS_H1 = 16.0f, QS_W = 256.0f, QS_ACT = 4.0f, QS_Y = 64.0f;
__device__ __forceinline__ float clamp448(float v) { return __builtin_fminf(__builtin_fmaxf(v, -448.0f), 448.0f); }
__device__ __forceinline__ unsigned pk4_fp8(float a, float b, float c, float d) {
    int w = __builtin_amdgcn_cvt_pk_fp8_f32(clamp448(a), clamp448(b), 0, false); w = __builtin_amdgcn_cvt_pk_fp8_f32(clamp448(c), clamp448(d), w, true); return (unsigned)w; }

namespace pg8 {
#define PG8_LAS __attribute__((address_space(3)))
typedef unsigned short bf16_t;
typedef short bf16x8 __attribute__((ext_vector_type(8)));
typedef float f32x4 __attribute__((ext_vector_type(4)));
typedef unsigned u32x4 __attribute__((ext_vector_type(4)));
typedef int i32x4 __attribute__((ext_vector_type(4)));
typedef int i32x8 __attribute__((ext_vector_type(8)));
__device__ __forceinline__ i32x8 cat8(bf16x8 lo, bf16x8 hi) { return __builtin_shufflevector(__builtin_bit_cast(i32x4, lo), __builtin_bit_cast(i32x4, hi), 0, 1, 2, 3, 4, 5, 6, 7); }
constexpr int BM = 256, BK = 64, HALF = 128, HTB = HALF * BK * 2  , STAGE_BYTES = 8 * HTB, NXCD = 8, WGM = 8;

__host__ __device__ __forceinline__ int lds_byte(int r, int c) { const int st = (r >> 4) * 2 + (c >> 5), rr = r & 15, cc = c & 31, ob = rr * 64 + cc * 2; return st * 1024 + (ob ^ (((ob >> 9) & 1) << 5)); }
__host__ __device__ __forceinline__ void stage_rc(int b, int& R, int& C) { const int st = b / 1024, sb = b % 1024, swz = sb ^ (((sb >> 9) & 1) << 5); R = (st >> 1) * 16 + swz / 64; C = (st & 1) * 32 + (swz % 64) / 2; }
__host__ __device__ __forceinline__ int perm32(int rho) { const int n = rho >> 4, i = rho & 15; return 8 * (i >> 2) + 4 * n + (i & 3); }

struct Unit { int pm, pn, e, lt, ui; };
struct Gemm { const bf16_t* A; const bf16_t* Bt; int M, N, K; const PG8_LAS unsigned* gtab; };

struct StaticOrder {
    int nM, nN, nwg, G, c;
    __host__ __device__ void init(int M, int N, int G_, int c_) { nM = M / BM; nN = N / BM; nwg = nM * nN; G = G_; c = c_; }
    __host__ __device__ bool next(int i, Unit& u) const {
        const int L = i * G + c; if (L >= nwg) return false;
        int wgid = L; { const int q = nwg / NXCD, r = nwg % NXCD, xcd = wgid % NXCD, off = wgid / NXCD; wgid = (xcd < r ? xcd * (q + 1) : r * (q + 1) + (xcd - r) * q) + off; }
        const int nig = WGM * nN, gid = wgid / nig, fm = gid * WGM, gsz = (nM - fm) < WGM ? (nM - fm) : WGM;
        u.pm = fm + ((wgid % nig) % gsz); u.pn = (wgid % nig) / gsz; u.e = 0; u.lt = 0; u.ui = i; return true;
    }
    __device__ __forceinline__ void a_ready(const Unit&) const {}
    __device__ __forceinline__ void done(const Unit&) const {}
};


struct GroupedOrder {
    StaticOrder so; const PG8_LAS int* tstart; int nN;
    __device__ __forceinline__ void init(int total_tiles, int nN_, int G_, int c_, const PG8_LAS int* ts) { so.init(total_tiles * BM, nN_ * BM, G_, c_); nN = nN_; tstart = ts; }
    __device__ __forceinline__ bool next(int i, Unit& u) const {
        if (!so.next(i, u)) return false;
        int e = 0;
#pragma unroll
        for (int k = 1; k < 32; ++k) e += (u.pm >= tstart[k]) ? 1 : 0;
        e = __builtin_amdgcn_readfirstlane(e);
        u.e = e; u.lt = u.pm - __builtin_amdgcn_readfirstlane(tstart[e]); u.pn = e * nN + u.pn; return true;
    }
    __device__ __forceinline__ void a_ready(const Unit&) const {}
    __device__ __forceinline__ void done(const Unit&) const {}
};

struct RowMajorOrder {
    const PG8_LAS int* tstart; int nN, ntiles, G, vcu;
    __device__ __forceinline__ void init(int total_tiles, int nN_, int G_, int vcu_, const PG8_LAS int* ts) { ntiles = total_tiles; nN = nN_; G = G_; vcu = vcu_; tstart = ts; }
    __device__ __forceinline__ bool next(int i, Unit& u) const {
        const int full = ntiles / G;
        int pm, j;
        if (i < full * nN) { pm = vcu + G * (i / nN); j = i % nN; }
        else { const int r = (i - full * nN) * G + vcu; pm = full * G + r / nN; j = r % nN; if (pm >= ntiles) return false; }
        int e = 0;
#pragma unroll
        for (int k = 1; k < 32; ++k) e += (pm >= tstart[k]) ? 1 : 0;
        e = __builtin_amdgcn_readfirstlane(e);
        u.pm = pm; u.e = e; u.lt = pm - __builtin_amdgcn_readfirstlane(tstart[e]); u.pn = e * nN + j; u.ui = i; return true;
    }
    __device__ __forceinline__ void a_ready(const Unit&) const {}
    __device__ __forceinline__ void done(const Unit&) const {}
};

__device__ __forceinline__ unsigned cvt_pk_bf16(float lo, float hi) { unsigned r; asm volatile("v_cvt_pk_bf16_f32 %0, %1, %2" : "=v"(r) : "v"(lo), "v"(hi)); return r; }
__device__ __forceinline__ u32x4 pack8(const f32x4 a, const f32x4 b) { u32x4 w; w.x = cvt_pk_bf16(a[0], a[1]); w.y = cvt_pk_bf16(a[2], a[3]); w.z = cvt_pk_bf16(b[0], b[1]); w.w = cvt_pk_bf16(b[2], b[3]); return w; }


typedef float f2 __attribute__((ext_vector_type(2)));
struct NoPre {};
struct NoSeed {};
#define PG8_ZERO_ACC(acc) do { _Pragma("unroll") for (int a_ = 0; a_ < 2; ++a_) _Pragma("unroll") for (int b_ = 0; b_ < 2; ++b_) _Pragma("unroll") for (int m_ = 0; m_ < 4; ++m_) _Pragma("unroll") for (int n_ = 0; n_ < 2; ++n_) acc[a_][b_][m_][n_] = (f32x4){0.f, 0.f, 0.f, 0.f}; } while (0)
struct EpiProj {
    static constexpr bool PERM = true, AFTER_DRAIN = false; static constexpr int NST = -1;     typedef NoPre Pre; typedef NoSeed Seed;
    __device__ __forceinline__ void seed_load(Seed&, const Unit&, int, int, int, int) const {}
    __device__ __forceinline__ void seed_acc(f32x4 (&acc)[2][2][4][2], const Seed&) const { PG8_ZERO_ACC(acc); }
    __device__ __forceinline__ void prefetch(Pre&, const Unit&, int, int, int, int) const {}
    bf16_t *GQ, *GK, *GV, *GG, *RQ, *RK, *RV, *RG; float* GLR; const float* cosT; const float* sinT;
    __device__ __forceinline__ void operator()(const f32x4 (&acc)[2][2][4][2], const Unit& u, int wr, int wc, int fr, int fq, const Pre& pre) const {
        asm volatile("" : "+v"(fr), "+v"(fq));
        const int row0 = u.pm * BM + wr * 64 + fr; const int t = u.pn;
        if (t == 6 || t == 7) {
            bf16_t* O = (t == 6) ? RQ : RK; const float sc = (t == 6) ? 1.0f : 0.125f;
#pragma unroll
            for (int ai = 0; ai < 2; ++ai)
#pragma unroll
                for (int m = 0; m < 4; ++m) { const int row = row0 + ai * HALF + m * 16;
                    const f32x4 c0 = *(const f32x4*)(cosT + (size_t)row * 32 + 8 * fq), c1 = *(const f32x4*)(cosT + (size_t)row * 32 + 8 * fq + 4);
                    const f32x4 s0 = *(const f32x4*)(sinT + (size_t)row * 32 + 8 * fq), s1 = *(const f32x4*)(sinT + (size_t)row * 32 + 8 * fq + 4);
                    const f32x4 a0 = acc[ai][0][m][0], a1 = acc[ai][0][m][1], b0 = acc[ai][1][m][0], b1 = acc[ai][1][m][1];
                    const f32x4 o10 = (a0 * c0 - b0 * s0) * sc, o11 = (a1 * c1 - b1 * s1) * sc, o20 = (a0 * s0 + b0 * c0) * sc, o21 = (a1 * s1 + b1 * c1) * sc;
                    bf16_t* rp = O + (size_t)row * 256 + wc * 64 + 8 * fq;
                    *(u32x4*)rp = pack8(o10, o11); *(u32x4*)(rp + 32) = pack8(o20, o21); }
        } else if (t == 12) {
            if (wc == 0 && fq < 2) {
#pragma unroll
                for (int ai = 0; ai < 2; ++ai)
#pragma unroll
                    for (int m = 0; m < 4; ++m) { const int row = row0 + ai * HALF + m * 16; float* rp = GLR + (size_t)row * 16 + 8 * fq;
                        *(f32x4*)rp = acc[ai][0][m][0]; *(f32x4*)(rp + 4) = acc[ai][0][m][1]; }
            }
        } else {
            bf16_t* O; int ldc, cb; float sc = 1.0f;
            if (t == 0) { O = GQ; ldc = 256; cb = 0; sc = 0.125f; } else if (t == 1) { O = GK; ldc = 256; cb = 0; }
            else if (t < 4) { O = GV; ldc = 512; cb = (t - 2) * 256; } else if (t < 6) { O = GG; ldc = 512; cb = (t - 4) * 256; }
            else if (t < 10) { O = RV; ldc = 512; cb = (t - 8) * 256; } else { O = RG; ldc = 512; cb = (t - 10) * 256; }
            const int col0 = cb + wc * 32 + 8 * fq;
#pragma unroll
            for (int ai = 0; ai < 2; ++ai)
#pragma unroll
                for (int m = 0; m < 4; ++m) { bf16_t* rp = O + (size_t)(row0 + ai * HALF + m * 16) * ldc + col0;
#pragma unroll
                    for (int bj = 0; bj < 2; ++bj) *(u32x4*)(rp + bj * HALF) = pack8(acc[ai][bj][m][0] * sc, acc[ai][bj][m][1] * sc); }
        }
    }
};

struct EpiOutProj {
    static constexpr bool PERM = true, AFTER_DRAIN = false; static constexpr int NST = 16;     typedef NoPre Pre; typedef NoSeed Seed;
    __device__ __forceinline__ void seed_load(Seed&, const Unit&, int, int, int, int) const {}
    __device__ __forceinline__ void seed_acc(f32x4 (&acc)[2][2][4][2], const Seed&) const { PG8_ZERO_ACC(acc); }
    __device__ __forceinline__ void prefetch(Pre&, const Unit&, int, int, int, int) const {}
    const bf16_t* h0b; bf16_t* out; float alpha;
    __device__ __forceinline__ void operator()(const f32x4 (&acc)[2][2][4][2], const Unit& u, int wr, int wc, int fr, int fq, const Pre& pre) const {
        asm volatile("" : "+v"(fr), "+v"(fq));
        const int row0 = u.pm * BM + wr * 64 + fr, col0 = u.pn * BM + wc * 32 + 8 * fq;
#pragma unroll
        for (int ai = 0; ai < 2; ++ai)
#pragma unroll
            for (int m = 0; m < 4; ++m) { const size_t off = (size_t)(row0 + ai * HALF + m * 16) * D + col0;
                u32x4 hv[2];
#pragma unroll
                for (int bj = 0; bj < 2; ++bj) hv[bj] = *(const u32x4*)(h0b + off + bj * HALF);
#pragma unroll
                for (int bj = 0; bj < 2; ++bj) { f32x4 a0, a1;
                    a0[0] = __builtin_bit_cast(float, hv[bj].x << 16); a0[1] = __builtin_bit_cast(float, hv[bj].x & 0xffff0000u); a0[2] = __builtin_bit_cast(float, hv[bj].y << 16); a0[3] = __builtin_bit_cast(float, hv[bj].y & 0xffff0000u);
                    a1[0] = __builtin_bit_cast(float, hv[bj].z << 16); a1[1] = __builtin_bit_cast(float, hv[bj].z & 0xffff0000u); a1[2] = __builtin_bit_cast(float, hv[bj].w << 16); a1[3] = __builtin_bit_cast(float, hv[bj].w & 0xffff0000u);
                    *(u32x4*)(out + off + bj * HALF) = pack8(a0 * alpha + acc[ai][bj][m][0], a1 * alpha + acc[ai][bj][m][1]); }
                asm volatile("" ::: "memory"); }
    }
};

struct EpiSwiGLU {
    static constexpr bool PERM = true, AFTER_DRAIN = false; static constexpr int NST = -1;     typedef NoPre Pre;
    struct Seed { f32x4 g0, g1, l0, l1; };
    __device__ __forceinline__ void seed_load(Seed& sd, const Unit& u, int wr, int wc, int fr, int fq) const {
        asm volatile("" : "+v"(fq));
        const int e = u.e, jt = u.pn - e * 8; const int colc = jt * 128 + wc * 32 + 8 * fq; const float* bp = b1 + (size_t)e * 2048 + colc;
        sd.g0 = *(const f32x4*)bp; sd.g1 = *(const f32x4*)(bp + 4); sd.l0 = *(const f32x4*)(bp + 1024); sd.l1 = *(const f32x4*)(bp + 1028);
    }
    __device__ __forceinline__ void seed_acc(f32x4 (&acc)[2][2][4][2], const Seed& sd) const {
        const float inv = QS_H1 * QS_W; const f32x4 g0 = sd.g0 * inv, g1 = sd.g1 * inv, l0 = sd.l0 * inv, l1 = sd.l1 * inv;
#pragma unroll
        for (int ai = 0; ai < 2; ++ai)
#pragma unroll
            for (int m = 0; m < 4; ++m) { acc[ai][0][m][0] = g0; acc[ai][0][m][1] = g1; acc[ai][1][m][0] = l0; acc[ai][1][m][1] = l1; }
    }
    __device__ __forceinline__ void prefetch(Pre&, const Unit&, int, int, int, int) const {}
    unsigned char* ACT; const float* b1; float asc;
    __device__ __forceinline__ void operator()(const f32x4 (&acc)[2][2][4][2], const Unit& u, int wr, int wc, int fr, int fq, const Pre& pre) const {
        asm volatile("" : "+v"(fr), "+v"(fq));
        const int e = u.e, jt = u.pn - e * 8; const int colc = jt * 128 + wc * 32 + 8 * fq;
        const int row0 = u.pm * BM + wr * 64 + fr;
        const float inv = QS_H1 * QS_W; const f2 kc = {asc * (-1.702f * 1.4426950408889634f), asc * (-1.702f * 1.4426950408889634f)}, one = {1.0f, 1.0f}, q2 = {QS_ACT * asc * asc, QS_ACT * asc * asc}, q1 = {QS_ACT * asc, QS_ACT * asc};
#pragma unroll
        for (int ai = 0; ai < 2; ++ai)
#pragma unroll
            for (int m = 0; m < 4; ++m) { typedef unsigned u32x2_t __attribute__((ext_vector_type(2))); u32x2_t w;
#pragma unroll
                for (int n = 0; n < 2; ++n) { int wv = 0;
#pragma unroll
                    for (int p = 0; p < 2; ++p) {
                        f2 mg, ml, ex, rc; const f32x4 ag = acc[ai][0][m][n], al = acc[ai][1][m][n];
                        mg.x = __builtin_amdgcn_fmed3f(ag[2 * p], -3.0e38f, 7.0f * inv); mg.y = __builtin_amdgcn_fmed3f(ag[2 * p + 1], -3.0e38f, 7.0f * inv);
                        ml.x = __builtin_amdgcn_fmed3f(al[2 * p], -7.0f * inv, 7.0f * inv); ml.y = __builtin_amdgcn_fmed3f(al[2 * p + 1], -7.0f * inv, 7.0f * inv);
                        const f2 t = mg * kc;
                        ex.x = __builtin_amdgcn_exp2f(t.x); ex.y = __builtin_amdgcn_exp2f(t.y);
                        const f2 dn = ex + one;
                        rc.x = __builtin_amdgcn_rcpf(dn.x); rc.y = __builtin_amdgcn_rcpf(dn.y);
                        const f2 o = (mg * rc) * (ml * q2 + q1);
                        wv = p ? __builtin_amdgcn_cvt_pk_fp8_f32(o.x, o.y, wv, true) : __builtin_amdgcn_cvt_pk_fp8_f32(o.x, o.y, 0, false); }
                    w[n] = (unsigned)wv; }
                *(u32x2_t*)(ACT + (size_t)(row0 + ai * HALF + m * 16) * DFF + colc) = w; }
    }
};

struct EpiMoeOut {
    static constexpr bool PERM = true, AFTER_DRAIN = false; static constexpr int NST = 8;     typedef NoPre Pre;
    struct Seed { f32x4 bv[2][2]; };
    __device__ __forceinline__ void seed_load(Seed& sd, const Unit& u, int wr, int wc, int fr, int fq) const {
        asm volatile("" : "+v"(fq));
        const int e = u.e, jt = u.pn - e * 4; const int col0 = jt * 256 + wc * 32 + 8 * fq;
#pragma unroll
        for (int bj = 0; bj < 2; ++bj)
#pragma unroll
            for (int n = 0; n < 2; ++n) sd.bv[bj][n] = *(const f32x4*)(b2 + (size_t)e * D + col0 + bj * HALF + 4 * n);
    }
    __device__ __forceinline__ void seed_acc(f32x4 (&acc)[2][2][4][2], const Seed& sd) const {
        const float inv = QS_ACT * QS_W;
#pragma unroll
        for (int bj = 0; bj < 2; ++bj)
#pragma unroll
            for (int n = 0; n < 2; ++n) { const f32x4 v = sd.bv[bj][n] * inv;
#pragma unroll
                for (int ai = 0; ai < 2; ++ai)
#pragma unroll
                    for (int m = 0; m < 4; ++m) acc[ai][bj][m][n] = v; }
    }
    __device__ __forceinline__ void prefetch(Pre&, const Unit&, int, int, int, int) const {}
    unsigned char* Y; const float* b2; const PG8_LAS float* gtab; float asc;
    __device__ __forceinline__ void operator()(const f32x4 (&acc)[2][2][4][2], const Unit& u, int wr, int wc, int fr, int fq, const Pre& pre) const {
        asm volatile("" : "+v"(fr), "+v"(fq));
        const int e = u.e, jt = u.pn - e * 4; const int colp = jt * 256 + wc * 64 + 16 * fq;
        const int row0 = u.pm * BM + wr * 64 + fr; const PG8_LAS float* gp = gtab + u.ui * 256 + wr * 64 + fr;
#pragma unroll
        for (int ai = 0; ai < 2; ++ai)
#pragma unroll
            for (int m = 0; m < 4; ++m) { const float gt = gp[ai * HALF + m * 16] * (QS_Y * asc); u32x4 w;
#pragma unroll
                for (int bj = 0; bj < 2; ++bj) { const f32x4 v0 = acc[ai][bj][m][0] * gt, v1 = acc[ai][bj][m][1] * gt;
                    const unsigned lo = pk4_fp8(v0[0], v0[1], v0[2], v0[3]), hi = pk4_fp8(v1[0], v1[1], v1[2], v1[3]);
                    if (bj == 0) { w.x = lo; w.y = hi; } else { w.z = lo; w.w = hi; } }
                *(u32x4*)(Y + (size_t)(row0 + ai * HALF + m * 16) * D + colp) = w; }
    }
};

template <class Epi, class Sched, bool ALIGN_EPI = false, bool SP2 = false, int ES = 2, bool GATHER = false>
__device__ __forceinline__ void gemm_phase(PG8_LAS unsigned char* lds, const Gemm g, const Sched& S, const Epi& E) {
    const int tid = threadIdx.x, wid = __builtin_amdgcn_readfirstlane(tid >> 6), lane = tid & 63, wr = wid >> 2, wc = wid & 3, fr = lane & 15, fq = lane >> 4;
    const int K = g.K * ES / 2, nt = K / BK;
    unsigned voffA[2], voffB[2]; int gR[2]; unsigned gC[2];
#pragma unroll
    for (int i = 0; i < 2; ++i) { int R, C; stage_rc(tid * 16 + i * 8192, R, C); const int Rb = Epi::PERM ? ((R & ~31) + perm32(R & 31)) : R;
        voffA[i] = (unsigned)(R * K + C) * 2u; voffB[i] = (unsigned)(Rb * K + C) * 2u; gR[i] = R; gC[i] = (unsigned)C * 2u; }
    unsigned vAc[2][2], vAn[2][2], vAs[2][2];
#define PG8_GLOAD(dst, ui_) do { _Pragma("unroll") for (int h_ = 0; h_ < 2; ++h_) _Pragma("unroll") for (int i_ = 0; i_ < 2; ++i_) dst[h_][i_] = g.gtab[(ui_) * 256 + h_ * HALF + gR[i_]] + gC[i_]; } while (0)
#define PG8_STAGE_A(b, h, soff, V) do { if constexpr (GATHER) { PG8_STAGE_R(PG8_SA(b, h), rA, soff, V[h]); } else { PG8_STAGE_R(PG8_SA(b, h), rA, (soff) + (h) * hstep, voffA); } } while (0)
    const unsigned kstep = (unsigned)(BK * 2);
    const unsigned hstep = (unsigned)HALF * K * 2;
    const unsigned tstep = 2 * hstep;
    const unsigned ldsw = (unsigned)wid * 1024u;
    const int aoff = lds_byte(wr * 64 + fr, fq * 8), boff = lds_byte(wc * 32 + fr, fq * 8);
#define PG8_SA(b, h) (((b) * 2 + (h)) * HTB)
#define PG8_SB(b, h) ((4 + (b) * 2 + (h)) * HTB)
    const __amdgpu_buffer_rsrc_t rA = __builtin_amdgcn_make_buffer_rsrc((void*)g.A, (short)0, 0x7fffffff, 0x00020000);
    const __amdgpu_buffer_rsrc_t rB = __builtin_amdgcn_make_buffer_rsrc((void*)g.Bt, (short)0, 0x7fffffff, 0x00020000);
#define PG8_STAGE_R(bufoff, rsrc, soff, voff) do { _Pragma("unroll") for (int _i = 0; _i < 2; ++_i) \
        __builtin_amdgcn_raw_ptr_buffer_load_lds(rsrc, (PG8_LAS void*)(lds + (bufoff) + ldsw + _i * 8192), 16, (int)(voff)[_i], (int)(soff), 0, 0); } while (0)
#define PG8_LDA(dst, b, h) do { _Pragma("unroll") for (int m = 0; m < 4; ++m) _Pragma("unroll") for (int k = 0; k < 2; ++k) dst[m][k] = *(const PG8_LAS bf16x8*)(lds + PG8_SA(b, h) + aoff + m * 2048 + k * 1024); } while (0)
#define PG8_LDB(dst, b, h) do { _Pragma("unroll") for (int n = 0; n < 2; ++n) _Pragma("unroll") for (int k = 0; k < 2; ++k) dst[n][k] = *(const PG8_LAS bf16x8*)(lds + PG8_SB(b, h) + boff + n * 2048 + k * 1024); } while (0)
#define PG8_PIN12(At, Bt) asm volatile("" : "+v"(At[0][0]), "+v"(At[0][1]), "+v"(At[1][0]), "+v"(At[1][1]), "+v"(At[2][0]), "+v"(At[2][1]), "+v"(At[3][0]), "+v"(At[3][1]), "+v"(Bt[0][0]), "+v"(Bt[0][1]), "+v"(Bt[1][0]), "+v"(Bt[1][1]))
#define PG8_PINACC(ai, bj) asm volatile("" : "+v"(acc[ai][bj][0][0]), "+v"(acc[ai][bj][0][1]), "+v"(acc[ai][bj][1][0]), "+v"(acc[ai][bj][1][1]), "+v"(acc[ai][bj][2][0]), "+v"(acc[ai][bj][2][1]), "+v"(acc[ai][bj][3][0]), "+v"(acc[ai][bj][3][1]))
#define PG8_MMA(ai, bj, At, Bt) do { if constexpr (ES == 1) { PG8_PIN12(At, Bt); __builtin_amdgcn_sched_barrier(0); } __builtin_amdgcn_s_setprio(1); _Pragma("unroll") for (int m = 0; m < 4; ++m) _Pragma("unroll") for (int n = 0; n < 2; ++n) { \
        if constexpr (ES == 2) { _Pragma("unroll") for (int k = 0; k < 2; ++k) acc[ai][bj][m][n] = __builtin_amdgcn_mfma_f32_16x16x32_bf16(Bt[n][k], At[m][k], acc[ai][bj][m][n], 0, 0, 0); } \
        else { acc[ai][bj][m][n] = __builtin_amdgcn_mfma_scale_f32_16x16x128_f8f6f4(cat8(Bt[n][0], Bt[n][1]), cat8(At[m][0], At[m][1]), acc[ai][bj][m][n], 0, 0, 0, 0x7f7f7f7f, 0, 0x7f7f7f7f); } } \
        __builtin_amdgcn_s_setprio(0); if constexpr (ES == 1) { PG8_PINACC(ai, bj); __builtin_amdgcn_sched_barrier(0); } } while (0)
#define PG8_WAIT_V(n) asm volatile("s_waitcnt vmcnt(" #n ")" ::: "memory")
#define PG8_WAIT_L(n) asm volatile("s_waitcnt lgkmcnt(" #n ")" ::: "memory")
#define PG8_BAR __builtin_amdgcn_s_barrier()
#define PG8_SCHED __builtin_amdgcn_sched_barrier(0)
    Unit cur, nxt; int ui = 0;
    if (!S.next(0, cur)) return;
    typename Epi::Pre pre; E.prefetch(pre, cur, wr, wc, fr, fq);
    typename Epi::Seed sd; E.seed_load(sd, cur, wr, wc, fr, fq);
    f32x4 acc[2][2][4][2]; E.seed_acc(acc, sd);
    bf16x8 At[4][2], B0[2][2], B1[2][2];
    unsigned cA = GATHER ? 0u : (unsigned)cur.pm * tstep, cB = (unsigned)cur.pn * tstep;
    if constexpr (GATHER) PG8_GLOAD(vAc, 0);
    S.a_ready(cur);
    if constexpr (SP2) {
        PG8_STAGE_R(PG8_SB(0, 0), rB, cB, voffB); PG8_STAGE_R(PG8_SB(0, 1), rB, cB + hstep, voffB); PG8_STAGE_A(0, 0, cA, vAc); PG8_STAGE_A(0, 1, cA, vAc);
        if (wr == 1) PG8_BAR;
        PG8_WAIT_V(2); PG8_BAR;
        PG8_STAGE_R(PG8_SB(1, 0), rB, cB + kstep, voffB); PG8_STAGE_A(1, 0, cA + kstep, vAc); PG8_STAGE_R(PG8_SB(1, 1), rB, cB + hstep + kstep, voffB);
        if constexpr (Epi::NST >= 0) PG8_WAIT_V(0); else PG8_WAIT_V(6);
        PG8_BAR;
    } else {
        PG8_STAGE_R(PG8_SB(0, 0), rB, cB, voffB); PG8_STAGE_A(0, 0, cA, vAc); PG8_STAGE_R(PG8_SB(0, 1), rB, cB + hstep, voffB); PG8_STAGE_A(0, 1, cA, vAc);
        if (wr == 1) PG8_BAR;
        PG8_WAIT_V(4); PG8_BAR;
        PG8_STAGE_R(PG8_SB(1, 0), rB, cB + kstep, voffB); PG8_STAGE_A(1, 0, cA + kstep, vAc); PG8_STAGE_R(PG8_SB(1, 1), rB, cB + hstep + kstep, voffB);
        PG8_WAIT_V(6); PG8_BAR;
    }
    for (;;) {
        const bool has_next = S.next(ui + 1, nxt);
        const unsigned nA = (has_next && !GATHER) ? (unsigned)nxt.pm * tstep : cA, nB = has_next ? (unsigned)nxt.pn * tstep : cB;
        if constexpr (GATHER) { if (has_next) PG8_GLOAD(vAn, ui + 1); else { _Pragma("unroll") for (int h_ = 0; h_ < 2; ++h_) _Pragma("unroll") for (int i_ = 0; i_ < 2; ++i_) vAn[h_][i_] = vAc[h_][i_]; } }
#define PG8_ITER_HEAD(t, LAST) \
            const bool last = (LAST); \
            if constexpr (GATHER) { _Pragma("unroll") for (int h_ = 0; h_ < 2; ++h_) _Pragma("unroll") for (int i_ = 0; i_ < 2; ++i_) vAs[h_][i_] = last ? vAn[h_][i_] : vAc[h_][i_]; } \
            const unsigned a1 = cA + (unsigned)((t) + 1) * kstep;                                             \
            const unsigned a2 = last ? nA : cA + (unsigned)((t) + 2) * kstep, b2 = last ? nB : cB + (unsigned)((t) + 2) * kstep;     \
            const unsigned a3 = a2 + kstep, b3 = b2 + kstep;                                \
            if (last && has_next) S.a_ready(nxt);
#define PG8_ITER_SP2(W01) \
            PG8_LDB(B0, 0, 0); PG8_LDB(B1, 0, 1); PG8_SCHED; PG8_LDA(At, 0, 0); PG8_STAGE_A(1, 1, a1, vAc); \
            W01; PG8_WAIT_L(0); PG8_BAR; PG8_MMA(0, 0, At, B0); PG8_MMA(0, 1, At, B1); PG8_BAR; PG8_SCHED; \
            PG8_LDA(At, 0, 1); PG8_STAGE_R(PG8_SB(0, 0), rB, b2, voffB); PG8_STAGE_R(PG8_SB(0, 1), rB, b2 + hstep, voffB); PG8_STAGE_A(0, 0, a2, vAs); \
            W01; PG8_WAIT_L(0); PG8_BAR; PG8_MMA(1, 0, At, B0); PG8_MMA(1, 1, At, B1); PG8_BAR; PG8_SCHED; \
            PG8_LDB(B0, 1, 0); PG8_LDB(B1, 1, 1); PG8_SCHED; PG8_LDA(At, 1, 0); PG8_STAGE_A(0, 1, a2, vAs); \
            PG8_WAIT_V(8); PG8_WAIT_L(0); PG8_BAR; PG8_MMA(0, 0, At, B0); PG8_MMA(0, 1, At, B1); PG8_BAR; PG8_SCHED; \
            PG8_LDA(At, 1, 1); PG8_STAGE_R(PG8_SB(1, 0), rB, b3, voffB); PG8_STAGE_R(PG8_SB(1, 1), rB, b3 + hstep, voffB); PG8_STAGE_A(1, 0, a3, vAs); \
            PG8_WAIT_V(8); PG8_WAIT_L(0); PG8_BAR; PG8_MMA(1, 0, At, B0); PG8_MMA(1, 1, At, B1); PG8_BAR; PG8_SCHED;
        if constexpr (SP2 && Epi::NST >= 0) {
            { PG8_ITER_HEAD(0, false) PG8_ITER_SP2(asm volatile("s_waitcnt vmcnt(%0)" :: "n"(8 + Epi::NST) : "memory")) }
            for (int t = 2; t < nt; t += 2) { PG8_ITER_HEAD(t, t == nt - 2) PG8_ITER_SP2(PG8_WAIT_V(8)) }
        } else if constexpr (SP2) {
            for (int t = 0; t < nt; t += 2) { PG8_ITER_HEAD(t, t == nt - 2) PG8_ITER_SP2(PG8_WAIT_V(8)) }
        } else {
            for (int t = 0; t < nt; t += 2) { PG8_ITER_HEAD(t, t == nt - 2)
            PG8_LDB(B0, 0, 0); PG8_SCHED; PG8_LDA(At, 0, 0); PG8_STAGE_A(1, 1, a1, vAc);
            PG8_WAIT_L(8); PG8_BAR; PG8_WAIT_L(0); PG8_MMA(0, 0, At, B0); PG8_BAR; PG8_SCHED;
            PG8_LDB(B1, 0, 1); PG8_STAGE_R(PG8_SB(0, 0), rB, b2, voffB);
            PG8_BAR; PG8_WAIT_L(0); PG8_MMA(0, 1, At, B1); PG8_BAR;
            PG8_LDA(At, 0, 1); PG8_STAGE_A(0, 0, a2, vAs);
            PG8_BAR; PG8_WAIT_L(0); PG8_MMA(1, 0, At, B0); PG8_BAR; PG8_SCHED;
            PG8_STAGE_R(PG8_SB(0, 1), rB, b2 + hstep, voffB);
            PG8_WAIT_V(6); PG8_BAR; PG8_MMA(1, 1, At, B1); PG8_BAR;
            PG8_LDB(B0, 1, 0); PG8_SCHED; PG8_LDA(At, 1, 0); PG8_STAGE_A(0, 1, a2, vAs);
            PG8_WAIT_L(8); PG8_BAR; PG8_WAIT_L(0); PG8_MMA(0, 0, At, B0); PG8_BAR; PG8_SCHED;
            PG8_LDB(B1, 1, 1); PG8_STAGE_R(PG8_SB(1, 0), rB, b3, voffB);
            PG8_BAR; PG8_WAIT_L(0); PG8_MMA(0, 1, At, B1); PG8_BAR;
            PG8_LDA(At, 1, 1); PG8_STAGE_A(1, 0, a3, vAs);
            PG8_BAR; PG8_WAIT_L(0); PG8_MMA(1, 0, At, B0); PG8_BAR; PG8_SCHED;
            PG8_STAGE_R(PG8_SB(1, 1), rB, b3 + hstep, voffB);
            PG8_WAIT_V(6); PG8_BAR; PG8_MMA(1, 1, At, B1); PG8_BAR;
            }
        }
#undef PG8_ITER_HEAD
#undef PG8_ITER_SP2
        if constexpr (ALIGN_EPI) { if (wr == 0) PG8_BAR; }
        if (has_next) E.seed_load(sd, nxt, wr, wc, fr, fq);
        if constexpr (!Epi::AFTER_DRAIN) { E(acc, cur, wr, wc, fr, fq, pre); S.done(cur); }
        if (!has_next) break;
        E.seed_acc(acc, sd);
        cur = nxt; cA = nA; cB = nB; ++ui;
        if constexpr (GATHER) { _Pragma("unroll") for (int h_ = 0; h_ < 2; ++h_) _Pragma("unroll") for (int i_ = 0; i_ < 2; ++i_) vAc[h_][i_] = vAn[h_][i_]; }
        E.prefetch(pre, cur, wr, wc, fr, fq);
        if constexpr (ALIGN_EPI) { if (wr == 1) PG8_BAR; }
    }
    PG8_WAIT_V(0);
    if constexpr (!ALIGN_EPI) { if (wr == 0) PG8_BAR; }
    PG8_BAR;
#undef PG8_SA
#undef PG8_SB
#undef PG8_STAGE_R
#undef PG8_STAGE_A
#undef PG8_GLOAD
#undef PG8_LDA
#undef PG8_LDB
#undef PG8_MMA
#undef PG8_PIN12
#undef PG8_PINACC
#undef PG8_WAIT_V
#undef PG8_WAIT_L
#undef PG8_BAR
#undef PG8_SCHED
}
}


constexpr size_t MiB = 1u << 20;
constexpr size_t WS_CTL = 0, CTL_ZERO_BYTES = 1 * MiB;
constexpr size_t WS_STATS0 = 1 * MiB, WS_COS = 2 * MiB, WS_SIN = 6 * MiB;
constexpr size_t WS_WINT = 10 * MiB, WS_WOT = 17 * MiB, WS_W1T = 20 * MiB, WS_W2T = 148 * MiB;
constexpr size_t WS_H0B = 212 * MiB, WS_MIXED = 534 * MiB;
constexpr size_t WS_PROJ = 276 * MiB;
constexpr size_t WS_ST = 470 * MiB, WS_DEC = 598 * MiB;
constexpr size_t WS_PRE1 = 212 * MiB;
constexpr size_t WS_AGG = 599 * MiB, WS_SINS = 615 * MiB, WS_DAGG = 631 * MiB;
constexpr size_t WS_H1B = 599 * MiB, WS_LIST = 663 * MiB, WS_GATES = 667 * MiB;
constexpr size_t WS_XS = 276 * MiB, WS_SLOTG = 668 * MiB, WS_ACT = 672 * MiB, WS_Y = 276 * MiB, WS_END = 940 * MiB;
constexpr size_t PJ_GQ = 0, PJ_GK = 16 * MiB, PJ_GV = 32 * MiB, PJ_GG = 64 * MiB, PJ_RQ = 96 * MiB, PJ_RK = 112 * MiB, PJ_RV = 128 * MiB, PJ_RG = 160 * MiB, PJ_GLR = 192 * MiB;
constexpr int CW_TMO = 0, CW_CODE = 1, CW_COUNTS = 64, CW_BAR = 4096;
constexpr int RING_OFF = 0, RING_BYTES = 131072;
constexpr int LDSCTL_OFF = RING_BYTES, MISC_OFF = LDSCTL_OFF + 320;
constexpr int X_TSTART = LDSCTL_OFF + 512, X_CNT = LDSCTL_OFF + 768, X_LCNT = LDSCTL_OFF + 1024, X_LBASE = LDSCTL_OFF + 1280, X_NASG = LDSCTL_OFF + 1536, X_ASG = LDSCTL_OFF + 2048;
constexpr int X_GTAB = LDSCTL_OFF + 8192, GT_MAXU = 17;
constexpr int LDS_BYTES = 157696;
constexpr int NWAVES = 8;
constexpr int NPH = 11;
#define GAS __attribute__((address_space(1)))
#define LAS __attribute__((address_space(3)))
typedef unsigned short bf16;
typedef unsigned v4u __attribute__((ext_vector_type(4)));
typedef float f32x4 __attribute__((ext_vector_type(4)));
typedef short bf16x8 __attribute__((ext_vector_type(8)));
typedef GAS unsigned gu32;
typedef GAS unsigned long long gu64;
#define RLX_AGENT __ATOMIC_RELAXED, __HIP_MEMORY_SCOPE_AGENT
#define LDS_WAIT() asm volatile("s_waitcnt lgkmcnt(0)" ::: "memory")
#define VM_WAIT() asm volatile("s_waitcnt vmcnt(0)" ::: "memory")
__device__ __forceinline__ unsigned long long rt() { return __builtin_amdgcn_s_memrealtime(); }
typedef __bf16 hwbf16x2 __attribute__((ext_vector_type(2)));
typedef float f32x2_t __attribute__((ext_vector_type(2)));
__device__ __forceinline__ unsigned pk2(float lo, float hi) { return __builtin_bit_cast(unsigned, __builtin_convertvector((f32x2_t){lo, hi}, hwbf16x2)); }
__device__ __forceinline__ unsigned f2bf(float f) { return pk2(f, 0.f) & 0xffffu; }

#define XB_TMO      128
#define XB_XCNT(j)  (256  + 64 * (j))
#define XB_XSUB(j)  (1280 + 64 * (j))
#define XB_XGEN(j)  (2304 + 64 * (j))
#define XB_TOP      3328
#define XB_TOPGEN   3392
#define XCD_BAR_WORDS 3456
#define XB_SPIN_CAP (1u << 18)

__device__ __forceinline__ unsigned xb_ld(unsigned* p)              { return __hip_atomic_load(p, __ATOMIC_RELAXED, __HIP_MEMORY_SCOPE_AGENT); }
__device__ __forceinline__ unsigned xb_add(unsigned* p, unsigned v) { return __hip_atomic_fetch_add(p, v, __ATOMIC_RELAXED, __HIP_MEMORY_SCOPE_AGENT); }
__device__ __forceinline__ unsigned xb_xcc_id() { return (unsigned)__builtin_amdgcn_s_getreg((3 << 11) | 20) & 0xFu; }
#define XB_SPIN(cond, bar) do { unsigned _sp = 0; while (cond) { __builtin_amdgcn_s_sleep(1); \
    if ((++_sp & 255u) == 0u) { if (xb_ld(&(bar)[XB_TMO])) break; if (_sp > XB_SPIN_CAP) { atomicAdd(&(bar)[XB_TMO], 1u); break; } } } } while (0)

struct XcdBarrier {
    unsigned* bar; unsigned x;
    volatile LAS unsigned* st;
};

__device__ __forceinline__ XcdBarrier xcd_barrier_post(unsigned* bar, volatile LAS unsigned* st) {
    XcdBarrier b; b.bar = bar; b.x = xb_xcc_id(); b.st = st;
    if (threadIdx.x == 0) (void)xb_add(&bar[XB_XCNT(b.x)], 1u);
    return b;
}
__device__ __forceinline__ void xcd_barrier_complete(unsigned* bar, unsigned x, unsigned& nloc, unsigned& nx) {
    const unsigned G = gridDim.x * gridDim.y * gridDim.z;
    unsigned sum, cnt, mine, sp = 0u;
    for (;;) {
        sum = 0u; cnt = 0u; mine = 0u;
#pragma unroll
        for (unsigned j = 0; j < 16; ++j) { const unsigned c = xb_ld(&bar[XB_XCNT(j)]); sum += c; cnt += (c > 0u) ? 1u : 0u; mine = (j == x) ? c : mine; }
        if (sum == G) break;
        __builtin_amdgcn_s_sleep(1);
        if ((++sp & 255u) == 0u) { if (xb_ld(&bar[XB_TMO])) break; if (sp > XB_SPIN_CAP) { atomicAdd(&bar[XB_TMO], 1u); break; } }
    }
    nloc = mine > 0u ? mine : 1u; nx = cnt > 0u ? cnt : 1u;
}

__device__ __forceinline__ void xcd_barrier(const XcdBarrier& b) {
    asm volatile("s_waitcnt vmcnt(0)" ::: "memory");
    __syncthreads();
    if (threadIdx.x == 0) {
        unsigned* bar = b.bar;
        __builtin_amdgcn_s_waitcnt(0);
        unsigned nloc = b.st[0], nx = b.st[1];
        if (nloc == 0u) { xcd_barrier_complete(bar, b.x, nloc, nx); b.st[0] = nloc; b.st[1] = nx; }
        const unsigned old = xb_add(&bar[XB_XSUB(b.x)], 1u);
        const unsigned gen = old / nloc;
        if (old + 1u == (gen + 1u) * nloc) {
            __builtin_amdgcn_fence(__ATOMIC_RELEASE, "agent");
            asm volatile("s_waitcnt vmcnt(0)" ::: "memory");
            const unsigned og = xb_add(&bar[XB_TOP], 1u);
            const unsigned tg = og / nx;
            if (og + 1u == (tg + 1u) * nx) xb_add(&bar[XB_TOPGEN], 1u);
            else XB_SPIN(xb_ld(&bar[XB_TOPGEN]) == tg, bar);
            __builtin_amdgcn_fence(__ATOMIC_ACQUIRE, "agent");
            xb_add(&bar[XB_XGEN(b.x)], 1u);
            asm volatile("s_waitcnt vmcnt(0)" ::: "memory");
        } else {
            XB_SPIN(xb_ld(&bar[XB_XGEN(b.x)]) == gen, bar);
            __builtin_amdgcn_fence(__ATOMIC_ACQUIRE, "agent");
            asm volatile("s_waitcnt vmcnt(0)" ::: "memory");
        }
    }
    __syncthreads();
}

struct Frame {
    LAS unsigned char* lds;
    volatile LAS unsigned* MISC;
    gu32* ctl;
    int tid, lane, wave, vcu, G;
    const float *x; const int* positions; const float *ln_in_g, *ln_in_b, *w_in, *gate_w, *gate_b, *gla_g, *ret_g, *ret_b, *w_out, *ln1_g, *ln1_b, *router_w, *router_b, *w1, *b1, *w2, *b2, *ln2_g, *ln2_b;
    float* out;
    float *stats0, *cosT, *sinT, *ST, *DEC, *PRE1, *GLR, *gates, *AGG, *DAGG; bf16* SIN;
    bf16 *WinT, *WoT, *W1T, *W2T, *H0B, *MIXED, *GQ, *GK, *GV, *GG, *RQ, *RK, *RV, *RG, *H1B, *XS, *ACT, *Y;
    int* list; unsigned* counts; float* slotg; int* tkslot;
};
template <int CTRL> __device__ __forceinline__ float dppf(float v) { return __builtin_bit_cast(float, __builtin_amdgcn_update_dpp(0, __builtin_bit_cast(int, v), CTRL, 0xF, 0xF, true)); }
template <int CTRL> __device__ __forceinline__ int dppi(int v) { return __builtin_amdgcn_update_dpp(0, v, CTRL, 0xF, 0xF, true); }
__device__ __forceinline__ float wave_sum(float v) {
    v += dppf<0xB1>(v); v += dppf<0x4E>(v); v += dppf<0x141>(v); v += dppf<0x140>(v);
    const float s0 = __builtin_bit_cast(float, __builtin_amdgcn_readlane(__builtin_bit_cast(int, v), 0)), s1 = __builtin_bit_cast(float, __builtin_amdgcn_readlane(__builtin_bit_cast(int, v), 16));
    const float s2 = __builtin_bit_cast(float, __builtin_amdgcn_readlane(__builtin_bit_cast(int, v), 32)), s3 = __builtin_bit_cast(float, __builtin_amdgcn_readlane(__builtin_bit_cast(int, v), 48));
    return (s0 + s1) + (s2 + s3);
}
__device__ __forceinline__ float bf2f(unsigned h) { return __builtin_bit_cast(float, h << 16); }

struct WinMap { __device__ __forceinline__ int operator()(int n) const {
    if (n < 1536) return n;
    if (n < 1552) return -1;
    if (n < 2064) { const int q = n < 1808 ? 0 : 1, l = n - (q ? 1808 : 1552); return 1536 + 256 * q + ((l >> 5) & 1) * 128 + (l >> 6) * 32 + (l & 31); }
    if (n < 2576) return 2048 + (n - 2064);
    return 2560 + (n - 2576); } };
struct IdMap { int off; __device__ __forceinline__ int operator()(int n) const { return off + n; } };
struct W1Map { int off; __device__ __forceinline__ int operator()(int n) const { const int l = n & 1023; return off + (l >> 7) * 256 + (n >> 10) * 128 + (l & 127); } };
template <bool FP8, class RowMap>
__device__ __forceinline__ void p0_transpose_item(const float* W, int K, int N, bf16* WT, const RowMap rm, int item, int lane) {
    const int nblk = (N + 31) / 32, kb = item / nblk, nb = item % nblk, k0 = 128 * kb, n0 = 32 * nb;
    const int q = lane & 7, n4 = n0 + 4 * (lane >> 3);
    f32x4 a[16];
    if (n4 < N) {
#pragma unroll
        for (int i = 0; i < 16; ++i) a[i] = __builtin_nontemporal_load((const GAS f32x4*)(W + (size_t)(k0 + 16 * q + i) * N + n4)); }
    else {
#pragma unroll
        for (int i = 0; i < 16; ++i) a[i] = (f32x4){0.f, 0.f, 0.f, 0.f}; }
#pragma unroll
    for (int c = 0; c < 4; ++c) { const int n = n4 + c; const int row = (n < N) ? rm(n) : -1;
        if (row >= 0) {
            if constexpr (FP8) { v4u w;
                w.x = pk4_fp8(a[0][c] * QS_W, a[1][c] * QS_W, a[2][c] * QS_W, a[3][c] * QS_W); w.y = pk4_fp8(a[4][c] * QS_W, a[5][c] * QS_W, a[6][c] * QS_W, a[7][c] * QS_W);
                w.z = pk4_fp8(a[8][c] * QS_W, a[9][c] * QS_W, a[10][c] * QS_W, a[11][c] * QS_W); w.w = pk4_fp8(a[12][c] * QS_W, a[13][c] * QS_W, a[14][c] * QS_W, a[15][c] * QS_W);
                *(GAS v4u*)((GAS unsigned char*)WT + (size_t)row * K + k0 + 16 * q) = w; }
            else { GAS v4u* dst = (GAS v4u*)(WT + (size_t)row * K + k0 + 16 * q);
                dst[0] = (v4u){pk2(a[0][c], a[1][c]), pk2(a[2][c], a[3][c]), pk2(a[4][c], a[5][c]), pk2(a[6][c], a[7][c])};
                dst[1] = (v4u){pk2(a[8][c], a[9][c]), pk2(a[10][c], a[11][c]), pk2(a[12][c], a[13][c]), pk2(a[14][c], a[15][c])}; } } }
}
__device__ __forceinline__ void p0_prologue(Frame& F) {
    const int gw = F.vcu * NWAVES + F.wave, NGW = F.G * NWAVES;
    constexpr int I_IN = (D / 128) * ((PW + 31) / 32), I_OUT = (D / 128) * (D / 32), I_1 = (D / 128) * (2 * DFF / 32), I_2 = (DFF / 128) * (D / 32);
    constexpr int NITEMS = I_IN + I_OUT + NE * (I_1 + I_2);
    for (int it = gw; it < NITEMS; it += NGW) {
        int r = it;
        if (r < I_IN) { p0_transpose_item<false>(F.w_in, D, PW, F.WinT, WinMap{}, r, F.lane); continue; } r -= I_IN;
        if (r < I_OUT) { p0_transpose_item<false>(F.w_out, D, D, F.WoT, IdMap{0}, r, F.lane); continue; } r -= I_OUT;
        if (r < NE * I_1) { const int e = r / I_1; p0_transpose_item<true>(F.w1 + (size_t)e * D * 2 * DFF, D, 2 * DFF, F.W1T, W1Map{e * 2 * DFF}, r % I_1, F.lane); continue; } r -= NE * I_1;
        { const int e = r / I_2; p0_transpose_item<true>(F.w2 + (size_t)e * DFF * D, DFF, D, F.W2T, IdMap{e * D}, r % I_2, F.lane); }
    }
    __syncthreads();
    { LAS float* WG = (LAS float*)(F.lds + RING_OFF);
        for (int idx = F.tid; idx < D * 4; idx += 512) { const int c = idx >> 2, ch = idx & 3; *(LAS f32x4*)(WG + c * 20 + ((ch + ((c >> 4) & 3)) & 3) * 4) = *(const GAS f32x4*)(F.w_in + (size_t)c * PW + 1536 + 4 * ch); } }
    __syncthreads();
    { f32x4 g4[4], b4[4];
#pragma unroll
        for (int j = 0; j < 4; ++j) { g4[j] = *((const GAS f32x4*)F.ln_in_g + F.lane + 64 * j); b4[j] = *((const GAS f32x4*)F.ln_in_b + F.lane + 64 * j); }
        f32x4 nx[4]; int m = gw;
        if (m < M) {
#pragma unroll
            for (int j = 0; j < 4; ++j) nx[j] = __builtin_nontemporal_load((const GAS f32x4*)(F.x + (size_t)m * D) + F.lane + 64 * j); }
        for (; m < M; m += NGW) {
            f32x4 v[4]; float s = 0.f;
#pragma unroll
            for (int j = 0; j < 4; ++j) { v[j] = nx[j]; s += (v[j].x + v[j].y) + (v[j].z + v[j].w); }
            if (m + NGW < M) {
#pragma unroll
                for (int j = 0; j < 4; ++j) nx[j] = __builtin_nontemporal_load((const GAS f32x4*)(F.x + (size_t)(m + NGW) * D) + F.lane + 64 * j); }
            const float mean = wave_sum(s) * (1.f / D); float s2 = 0.f;
#pragma unroll
            for (int j = 0; j < 4; ++j) { v[j] = v[j] - mean; s2 += (v[j].x * v[j].x + v[j].y * v[j].y) + (v[j].z * v[j].z + v[j].w * v[j].w); }
            const float rstd = 1.f / sqrtf(wave_sum(s2) * (1.f / D) + LN_EPS);
            if (F.lane == 0) { F.stats0[2 * m] = mean; F.stats0[2 * m + 1] = rstd; }
            GAS unsigned long long* o8 = (GAS unsigned long long*)(F.H0B + (size_t)m * D) + F.lane;
#pragma unroll
            for (int j = 0; j < 4; ++j) { const f32x4 h = v[j] * rstd * g4[j] + b4[j]; v[j] = h;
                o8[64 * j] = (unsigned long long)pk2(h.x, h.y) | ((unsigned long long)pk2(h.z, h.w) << 32); }
            { const LAS float* WG = (const LAS float*)(F.lds + RING_OFF); float acc[16];
#pragma unroll
                for (int r = 0; r < 16; ++r) acc[r] = 0.f;
#pragma unroll
                for (int ci = 0; ci < 16; ++ci) { const int c = 4 * F.lane + 256 * (ci >> 2) + (ci & 3); const float hv = v[ci >> 2][ci & 3]; f32x4 wc[4];
#pragma unroll
                    for (int ch = 0; ch < 4; ++ch) wc[ch] = *(const LAS f32x4*)(WG + c * 20 + ((ch + ((c >> 4) & 3)) & 3) * 4);
#pragma unroll
                    for (int ch = 0; ch < 4; ++ch)
#pragma unroll
                        for (int x = 0; x < 4; ++x) acc[4 * ch + x] += hv * wc[ch][x];
                    if ((ci & 3) == 3) asm volatile("" ::: "memory"); }
                float red[8];
#pragma unroll
                for (int e = 0; e < 8; ++e) { float pa = acc[e], pb = acc[e + 8]; asm volatile("v_nop\n\tv_nop\n\tv_permlane32_swap_b32 %0, %1" : "+v"(pa), "+v"(pb)); red[e] = pa + pb; }
#define P0_SEL(MSK, A, B) __builtin_bit_cast(float, (__builtin_bit_cast(unsigned, (A)) & (MSK)) | (__builtin_bit_cast(unsigned, (B)) & ~(MSK)))
                { const unsigned hm = (F.lane & 16) ? 0xffffffffu : 0u; float snd[4], rcv[4];
#pragma unroll
                    for (int e = 0; e < 4; ++e) snd[e] = P0_SEL(hm, red[e], red[e + 4]);
#pragma unroll
                    for (int e = 0; e < 4; ++e) rcv[e] = __shfl_xor(snd[e], 16);
#pragma unroll
                    for (int e = 0; e < 4; ++e) red[e] = P0_SEL(hm, red[e + 4], red[e]) + rcv[e]; }
                { const unsigned hm = (F.lane & 8) ? 0xffffffffu : 0u;
#pragma unroll
                    for (int e = 0; e < 2; ++e) { const float keep = P0_SEL(hm, red[e + 2], red[e]), snd = P0_SEL(hm, red[e], red[e + 2]); red[e] = keep + dppf<0x128>(snd); } }
                { const unsigned hm = (F.lane & 4) ? 0xffffffffu : 0u; const float keep = P0_SEL(hm, red[1], red[0]), snd = P0_SEL(hm, red[0], red[1]); red[0] = keep + dppf<0x141>(snd); }
#undef P0_SEL
                red[0] += dppf<0x4E>(red[0]); red[0] += dppf<0xB1>(red[0]);
                if ((F.lane & 3) == 0) F.GLR[(size_t)m * 16 + ((F.lane >> 5) * 8 + ((F.lane >> 4) & 1) * 4 + ((F.lane >> 3) & 1) * 2 + ((F.lane >> 2) & 1))] = red[0]; }
        } }
    const double inv_freq = pow(10000.0, -(double)(F.tid & 31) / 31.0);
    for (int idx = F.vcu * 512 + F.tid; idx < M * 32; idx += F.G * 512) { const int t = idx >> 5;
        const double ang = (double)F.positions[t] * inv_freq;
        F.cosT[idx] = (float)cos(ang); F.sinT[idx] = (float)sin(ang); }
}

constexpr int MS = 72;
constexpr int MX_QE = 0, MX_QN = 9216, MX_KE = 18432, MX_KN = 27648, MX_VT = 36864, MX_PT = 55296, MX_B = 73728, MX_RED = 90368, MX_GW = 91392, MX_P = 95744;
constexpr int MX_NP = MX_P + 64 * 132 * 4;
constexpr int MX_OUT = MX_P, OUTS = 132;
static_assert(MX_GW + 4096 + 256 <= MX_P && MX_OUT + 64 * OUTS * 4 <= MX_NP && MX_NP + 3 * 128 * 4 <= RING_BYTES, "mixer LDS");
constexpr float LOG2E = 1.4426950408889634f, LN2 = 0.6931471805599453f;
__device__ __forceinline__ float log2_gamma(int h) { return log2f(1.0f - exp2f(-5.0f - (float)h)); }
__device__ __forceinline__ float fexp2(float x) { return __builtin_amdgcn_exp2f(x); }
__device__ __forceinline__ float bflo(unsigned w) { return __builtin_bit_cast(float, w << 16); }
__device__ __forceinline__ float bfhi(unsigned w) { return __builtin_bit_cast(float, w & 0xffff0000u); }
__device__ __forceinline__ int tsw(int row, int j) { return row * MS + ((((j >> 3) ^ (row >> 3)) & 7) << 3) + (j & 7); }
struct MixItem { int b, h, h8, c, item; bool gla; size_t t0; };
__device__ __forceinline__ MixItem mix_item(int vb, int k) {
    MixItem m; m.b = vb >> 6; m.h = (vb >> 4) & 3; m.c = (vb & 15) * 8 + (k >> 1); m.gla = (k & 1) == 0; m.h8 = m.gla ? m.h : 4 + m.h;
    m.item = ((m.b * 8 + m.h8) << 7) + m.c; m.t0 = (size_t)m.b * SEQ + (size_t)m.c * CH; return m; }
__device__ __forceinline__ void mixer_stage_gate(Frame& F, int h) {
    LAS float* GW = (LAS float*)(F.lds + MX_GW);
    for (int i = F.tid; i < 1024; i += 512) { const int d = i >> 4, r = i & 15; GW[d * 16 + r] = F.gate_w[r * 256 + h * 64 + d]; }
    if (F.tid < 64) GW[1024 + F.tid] = F.gate_b[h * 64 + F.tid];
}
__device__ __forceinline__ void mixer_bcum(Frame& F, const f32x4 (&g)[4]) {
    LAS float* B = (LAS float*)(F.lds + MX_B); const LAS float* GW = (const LAS float*)(F.lds + MX_GW);
#pragma unroll
    for (int dd = 0; dd < 8; ++dd) { const int d = F.wave * 8 + dd; const LAS f32x4* w = (const LAS f32x4*)(GW + d * 16);
        const f32x4 w0 = w[0], w1 = w[1], w2 = w[2], w3 = w[3];
        float z = GW[1024 + d];
        z += (g[0][0] * w0[0] + g[0][1] * w0[1]) + (g[0][2] * w0[2] + g[0][3] * w0[3]);
        z += (g[1][0] * w1[0] + g[1][1] * w1[1]) + (g[1][2] * w1[2] + g[1][3] * w1[3]);
        z += (g[2][0] * w2[0] + g[2][1] * w2[1]) + (g[2][2] * w2[2] + g[2][3] * w2[3]);
        z += (g[3][0] * w3[0] + g[3][1] * w3[1]) + (g[3][2] * w3[2] + g[3][3] * w3[3]);
        float la = (fminf(z, 0.f) * LOG2E - __builtin_amdgcn_logf(1.0f + fexp2(-fabsf(z) * LOG2E))) * (1.0f / 16.0f);
        la += dppf<0x111>(la); la += dppf<0x112>(la); la += dppf<0x114>(la); la += dppf<0x118>(la);
        la += __builtin_bit_cast(float, __builtin_amdgcn_update_dpp(0, __builtin_bit_cast(int, la), 0x142, 0xA, 0xF, false));
        la += __builtin_bit_cast(float, __builtin_amdgcn_update_dpp(0, __builtin_bit_cast(int, la), 0x143, 0xC, 0xF, false));
        B[F.lane * 65 + d] = la; }
}
struct MixKvRegs { v4u k8, v8[2]; f32x4 g[4]; };
__device__ __forceinline__ void mixer_kv_load(Frame& F, const MixItem& m, MixKvRegs& R) {
    const bf16* K = m.gla ? F.GK : F.RK; const bf16* V = m.gla ? F.GV : F.RV;
    const int jq = F.tid >> 3, dq = (F.tid & 7) * 8;
    R.k8 = *(const GAS v4u*)(K + (m.t0 + jq) * 256 + m.h * 64 + dq);
#pragma unroll
    for (int i = 0; i < 2; ++i) { const int p = F.tid + 512 * i; R.v8[i] = *(const GAS v4u*)(V + (m.t0 + (p >> 4)) * 512 + m.h * 128 + (p & 15) * 8); }
    if (m.gla) { const GAS f32x4* gr = (const GAS f32x4*)(F.GLR + (m.t0 + F.lane) * 16); R.g[0] = gr[0]; R.g[1] = gr[1]; R.g[2] = gr[2]; R.g[3] = gr[3]; }
}
__device__ __forceinline__ void mixer_vt_write(Frame& F, const v4u (&v8)[2]) {
    LAS bf16* VT = (LAS bf16*)(F.lds + MX_VT);
#pragma unroll
    for (int i = 0; i < 2; ++i) { const int p = F.tid + 512 * i, jv = p >> 4, ev = (p & 15) * 8;
#pragma unroll
        for (int x = 0; x < 8; ++x) { const unsigned wv = (x < 2 ? v8[i].x : x < 4 ? v8[i].y : x < 6 ? v8[i].z : v8[i].w); VT[tsw(ev + x, jv)] = (bf16)((x & 1) ? (wv >> 16) : (wv & 0xffffu)); } }
}
#define KV_ITEM(K, GLA, ACC) do { const MixItem m = mix_item(vb, (K)); \
        if (GLA) mixer_bcum(F, R.g); \
        const v4u k8 = R.k8, va = R.v8[0], vbv = R.v8[1]; \
        __syncthreads();                                                      \
        { const int jq = F.tid >> 3, dq = (F.tid & 7) * 8; \
          _Pragma("unroll") for (int x = 0; x < 8; ++x) { const int d = dq + x; const unsigned wk = (x < 2 ? k8.x : x < 4 ? k8.y : x < 6 ? k8.z : k8.w); const float kf = (x & 1) ? bfhi(wk) : bflo(wk); \
              const float sc = (GLA) ? fexp2(B[63 * 65 + d] - B[jq * 65 + d]) : fexp2((float)(63 - jq) * l2g); \
              KL[tsw(d, jq)] = (bf16)f2bf(kf * sc); } } \
        { const v4u vv[2] = {va, vbv}; mixer_vt_write(F, vv); } \
        float dec4[4]; \
        _Pragma("unroll") for (int t = 0; t < 4; ++t) dec4[t] = (GLA) ? fexp2(B[63 * 65 + 16 * t + fr]) : g64; \
        if ((GLA) && F.tid < 64) { F.DEC[(size_t)m.item * 64 + F.tid] = cdG; cdG *= fexp2(B[63 * 65 + F.tid]); }     \
        if ((K) < 15) mixer_kv_load(F, mix_item(vb, (K) + 1), R);            \
        _Pragma("unroll") for (int t = 0; t < 4; ++t) _Pragma("unroll") for (int r = 0; r < 4; ++r) OT[(16 * F.wave + 4 * fq + r) * MS + 16 * t + fr] = (bf16)f2bf(ACC[t][r]);     \
        __syncthreads(); \
        { bf16* st = (bf16*)F.ST + (size_t)m.item * 8192; \
          _Pragma("unroll") for (int i = 0; i < 2; ++i) { const int idx = F.tid + 512 * i, e = idx >> 3, d = (idx & 7) * 8; *(GAS v4u*)(st + e * 64 + d) = *(const LAS v4u*)(OT + e * MS + d); } } \
        _Pragma("unroll") for (int t = 0; t < 4; ++t) ACC[t] = ACC[t] * dec4[t]; \
        _Pragma("unroll") for (int ks = 0; ks < 2; ++ks) { const bf16x8 aV = *(const LAS bf16x8*)(VT + tsw(16 * F.wave + fr, 32 * ks + 8 * fq)); \
            _Pragma("unroll") for (int t = 0; t < 4; ++t) { const bf16x8 bK = *(const LAS bf16x8*)(KL + tsw(16 * t + fr, 32 * ks + 8 * fq)); ACC[t] = __builtin_amdgcn_mfma_f32_16x16x32_bf16(aV, bK, ACC[t], 0, 0, 0); } } \
    } while (0)
__device__ __forceinline__ void mixer_kv_phase(Frame& F) {
    const int fr = F.lane & 15, fq = F.lane >> 4;
    LAS float* B = (LAS float*)(F.lds + MX_B); LAS bf16* KL = (LAS bf16*)(F.lds + MX_KE); LAS bf16* VT = (LAS bf16*)(F.lds + MX_VT); LAS bf16* OT = (LAS bf16*)(F.lds + MX_PT);
    for (int vb = F.vcu; vb < 256; vb += F.G) {
        __syncthreads();
        const int h = (vb >> 4) & 3; const float l2g = log2_gamma(h), g64 = fexp2(64.0f * l2g);
        mixer_stage_gate(F, h);
        MixKvRegs R; mixer_kv_load(F, mix_item(vb, 0), R);
        f32x4 accG[4], accR[4]; float cdG = 1.0f;
#pragma unroll
        for (int t = 0; t < 4; ++t) { accG[t] = (f32x4){0.f, 0.f, 0.f, 0.f}; accR[t] = (f32x4){0.f, 0.f, 0.f, 0.f}; }
        __syncthreads();
        for (int kk = 0; kk < 8; ++kk) { KV_ITEM(2 * kk, true, accG); KV_ITEM(2 * kk + 1, false, accR); }
        { const int b = vb >> 6, cg = vb & 15; const size_t gG = (size_t)((b * 8 + h) * 16 + cg), gR = (size_t)((b * 8 + 4 + h) * 16 + cg);
#pragma unroll
            for (int t = 0; t < 4; ++t)
#pragma unroll
                for (int r = 0; r < 4; ++r) { const int o = (16 * F.wave + 4 * fq + r) * 64 + 16 * t + fr; F.AGG[gG * 8192 + o] = accG[t][r]; F.AGG[gR * 8192 + o] = accR[t][r]; }
            if (F.tid < 64) { F.DAGG[gG * 64 + F.tid] = cdG; F.DAGG[gR * 64 + F.tid] = fexp2(512.0f * l2g); } }
    }
}
#undef KV_ITEM
__device__ __forceinline__ void mixer_scan(Frame& F) {
    for (int idx = F.vcu * 512 + F.tid; idx < NB * 8 * 4096; idx += F.G * 512) {
        const int bh = idx >> 12, ed = (idx & 4095) * 2, d = ed & 63; float s0 = 0.f, s1 = 0.f;
        f32x2_t a[16], dg[16];
#pragma unroll
        for (int g = 0; g < 16; ++g) { a[g] = *(const GAS f32x2_t*)(F.AGG + (size_t)(bh * 16 + g) * 8192 + ed); dg[g] = *(const GAS f32x2_t*)(F.DAGG + (size_t)(bh * 16 + g) * 64 + d); }
#pragma unroll
        for (int g = 0; g < 16; ++g) { *(GAS unsigned*)(F.SIN + (size_t)(bh * 16 + g) * 8192 + ed) = pk2(s0, s1); s0 = s0 * dg[g][0] + a[g][0]; s1 = s1 * dg[g][1] + a[g][1]; }
    }
}
struct MixOutRegs { v4u q8, k8, v8[2], p8[2], gt[2]; f32x4 g[4]; f32x4 cd[2]; };
__device__ __forceinline__ void mixer_out_load(Frame& F, const MixItem& m, MixOutRegs& R) {
    const bf16* Q = m.gla ? F.GQ : F.RQ; const bf16* K = m.gla ? F.GK : F.RK; const bf16* V = m.gla ? F.GV : F.RV; const bf16* GT = m.gla ? F.GG : F.RG;
    const int jq = F.tid >> 3, dq = (F.tid & 7) * 8;
    R.q8 = __builtin_nontemporal_load((const GAS v4u*)(Q + (m.t0 + jq) * 256 + m.h * 64 + dq));
    R.k8 = __builtin_nontemporal_load((const GAS v4u*)(K + (m.t0 + jq) * 256 + m.h * 64 + dq));
#pragma unroll
    for (int i = 0; i < 2; ++i) { const int p = F.tid + 512 * i; R.v8[i] = __builtin_nontemporal_load((const GAS v4u*)(V + (m.t0 + (p >> 4)) * 512 + m.h * 128 + (p & 15) * 8)); }
#pragma unroll
    for (int i = 0; i < 2; ++i) R.p8[i] = __builtin_nontemporal_load((const GAS v4u*)((const bf16*)F.ST + (size_t)m.item * 8192) + F.tid + 512 * i);
#pragma unroll
    for (int i = 0; i < 2; ++i) R.gt[i] = __builtin_nontemporal_load((const GAS v4u*)(GT + (m.t0 + jq) * 512 + m.h * 128 + (F.tid & 7) * 8 + 64 * i));
    if (m.gla) { const GAS f32x4* gr = (const GAS f32x4*)(F.GLR + (m.t0 + F.lane) * 16); R.g[0] = gr[0]; R.g[1] = gr[1]; R.g[2] = gr[2]; R.g[3] = gr[3];
        const GAS f32x4* cp = (const GAS f32x4*)(F.DEC + (size_t)m.item * 64 + (F.tid & 7) * 8); R.cd[0] = cp[0]; R.cd[1] = cp[1]; }
}
__device__ __forceinline__ void mixer_out_phase(Frame& F) {
    const int fr = F.lane & 15, fq = F.lane >> 4, w = F.wave;
    LAS bf16* QE = (LAS bf16*)(F.lds + MX_QE); LAS bf16* QN = (LAS bf16*)(F.lds + MX_QN); LAS bf16* KE = (LAS bf16*)(F.lds + MX_KE); LAS bf16* KN = (LAS bf16*)(F.lds + MX_KN);
    LAS bf16* VT = (LAS bf16*)(F.lds + MX_VT); LAS bf16* PT = (LAS bf16*)(F.lds + MX_PT); LAS bf16* P = (LAS bf16*)(F.lds + MX_P);
    LAS float* B = (LAS float*)(F.lds + MX_B); LAS float* RED = (LAS float*)(F.lds + MX_RED); LAS float* OUT = (LAS float*)(F.lds + MX_OUT); LAS float* NP = (LAS float*)(F.lds + MX_NP);
    const int jq = F.tid >> 3, dq = (F.tid & 7) * 8;
#define MO_SEL(MSK, A, B) __builtin_bit_cast(float, (__builtin_bit_cast(unsigned, (A)) & (MSK)) | (__builtin_bit_cast(unsigned, (B)) & ~(MSK)))
#define MO_STAGE1(GLA, KC) do { const unsigned gm_ = (GLA) ? 0xffffffffu : 0u; const float rc_ = fexp2(64.0f * (float)(KC) * l2gb); \
        float cd_[8]; _Pragma("unroll") for (int x = 0; x < 8; ++x) { const float cg_ = (x < 4) ? R.cd[0][x & 3] : R.cd[1][x & 3]; cd_[x] = MO_SEL(gm_, cg_, rc_); } \
        _Pragma("unroll") for (int i_ = 0; i_ < 2; ++i_) { const int idx_ = F.tid + 512 * i_, e_ = idx_ >> 3, d_ = (idx_ & 7) * 8; const v4u l_ = R.p8[i_]; float v_[8]; \
            v_[0] = bflo(l_.x); v_[1] = bfhi(l_.x); v_[2] = bflo(l_.y); v_[3] = bfhi(l_.y); v_[4] = bflo(l_.z); v_[5] = bfhi(l_.z); v_[6] = bflo(l_.w); v_[7] = bfhi(l_.w); \
            { const v4u sg_ = sinG[i_], sr_ = sinR[i_]; const unsigned w0_ = (sg_.x & gm_) | (sr_.x & ~gm_), w1_ = (sg_.y & gm_) | (sr_.y & ~gm_), w2_ = (sg_.z & gm_) | (sr_.z & ~gm_), w3_ = (sg_.w & gm_) | (sr_.w & ~gm_); \
              v_[0] += cd_[0] * bflo(w0_); v_[1] += cd_[1] * bfhi(w0_); v_[2] += cd_[2] * bflo(w1_); v_[3] += cd_[3] * bfhi(w1_); \
              v_[4] += cd_[4] * bflo(w2_); v_[5] += cd_[5] * bfhi(w2_); v_[6] += cd_[6] * bflo(w3_); v_[7] += cd_[7] * bfhi(w3_); }     \
            *(LAS v4u*)(PT + e_ * MS + d_) = (v4u){pk2(v_[0], v_[1]), pk2(v_[2], v_[3]), pk2(v_[4], v_[5]), pk2(v_[6], v_[7])}; } \
        if (GLA) mixer_bcum(F, R.g); mixer_vt_write(F, R.v8); } while (0)
#define MO_IMAGES(GLA) do { const v4u q8_ = R.q8, k8_ = R.k8; \
        if (GLA) { float qf[8], kf[8], eb[8], en[8]; \
            _Pragma("unroll") for (int x = 0; x < 8; ++x) { const unsigned wq = (x < 2 ? q8_.x : x < 4 ? q8_.y : x < 6 ? q8_.z : q8_.w), wk = (x < 2 ? k8_.x : x < 4 ? k8_.y : x < 6 ? k8_.z : k8_.w); \
                qf[x] = (x & 1) ? bfhi(wq) : bflo(wq); kf[x] = (x & 1) ? bfhi(wk) : bflo(wk); const float bv = B[jq * 65 + dq + x]; eb[x] = fexp2(bv); en[x] = fexp2(-bv); } \
            *(LAS v4u*)(QE + jq * MS + dq) = (v4u){pk2(qf[0] * eb[0], qf[1] * eb[1]), pk2(qf[2] * eb[2], qf[3] * eb[3]), pk2(qf[4] * eb[4], qf[5] * eb[5]), pk2(qf[6] * eb[6], qf[7] * eb[7])}; \
            *(LAS v4u*)(QN + jq * MS + dq) = (v4u){pk2(qf[0] * en[0], qf[1] * en[1]), pk2(qf[2] * en[2], qf[3] * en[3]), pk2(qf[4] * en[4], qf[5] * en[5]), pk2(qf[6] * en[6], qf[7] * en[7])}; \
            *(LAS v4u*)(KE + jq * MS + dq) = (v4u){pk2(kf[0] * eb[0], kf[1] * eb[1]), pk2(kf[2] * eb[2], kf[3] * eb[3]), pk2(kf[4] * eb[4], kf[5] * eb[5]), pk2(kf[6] * eb[6], kf[7] * eb[7])}; \
            *(LAS v4u*)(KN + jq * MS + dq) = (v4u){pk2(kf[0] * en[0], kf[1] * en[1]), pk2(kf[2] * en[2], kf[3] * en[3]), pk2(kf[4] * en[4], kf[5] * en[5]), pk2(kf[6] * en[6], kf[7] * en[7])}; \
        } else { *(LAS v4u*)(QE + jq * MS + dq) = q8_; *(LAS v4u*)(KN + jq * MS + dq) = k8_; } } while (0)
    for (int vb = F.vcu; vb < 256; vb += F.G) {
        __syncthreads();
        mixer_stage_gate(F, (vb >> 4) & 3);
        if (F.tid < 384) { const int hh = (vb >> 4) & 3, e_ = F.tid & 127; NP[F.tid] = F.tid < 128 ? F.gla_g[e_] : F.tid < 256 ? F.ret_g[hh * 128 + e_] : F.ret_b[hh * 128 + e_]; }
        MixOutRegs R; mixer_out_load(F, mix_item(vb, 0), R);
        const float l2gb = log2_gamma((vb >> 4) & 3);
        v4u sinG[2], sinR[2];
        { const int b_ = vb >> 6, h_ = (vb >> 4) & 3, cg_ = vb & 15; const size_t gG = (size_t)((b_ * 8 + h_) * 16 + cg_), gR = (size_t)((b_ * 8 + 4 + h_) * 16 + cg_);
#pragma unroll
            for (int i = 0; i < 2; ++i) { const int idx = F.tid + 512 * i, e = idx >> 3, d = (idx & 7) * 8;
                sinG[i] = *(const GAS v4u*)(F.SIN + gG * 8192 + e * 64 + d); sinR[i] = *(const GAS v4u*)(F.SIN + gR * 8192 + e * 64 + d); } }
        __syncthreads();
        v4u gc0, gc1, gn0, gn1;
        { const MixItem m0 = mix_item(vb, 0); MO_STAGE1(m0.gla, 0); gc0 = R.gt[0]; gc1 = R.gt[1]; gn0 = gc0; gn1 = gc1;
            __syncthreads();
            MO_IMAGES(m0.gla); mixer_out_load(F, mix_item(vb, 1), R);
            __syncthreads(); }
        for (int k = 0; k < 16; ++k) { const MixItem m = mix_item(vb, k); const bool gla = m.gla; const int h = m.h;
            const float l2g = log2_gamma(h);
            { const int mi = w >> 1;
#pragma unroll
                for (int t = 0; t < 2; ++t) { const int nj = (w & 1) * 2 + t; f32x4 lo = (f32x4){0.f, 0.f, 0.f, 0.f}, up = (f32x4){0.f, 0.f, 0.f, 0.f};
#pragma unroll
                    for (int ks = 0; ks < 2; ++ks) { const int ao = (16 * mi + fr) * MS + 32 * ks + 8 * fq, bo = (16 * nj + fr) * MS + 32 * ks + 8 * fq;
                        lo = __builtin_amdgcn_mfma_f32_16x16x32_bf16(*(const LAS bf16x8*)(QE + ao), *(const LAS bf16x8*)(KN + bo), lo, 0, 0, 0);
                        if (gla) up = __builtin_amdgcn_mfma_f32_16x16x32_bf16(*(const LAS bf16x8*)(QN + ao), *(const LAS bf16x8*)(KE + bo), up, 0, 0, 0); }
#pragma unroll
                    for (int r = 0; r < 4; ++r) { const int i = 16 * mi + 4 * fq + r, j = 16 * nj + fr; float pv;
                        if (gla) pv = (i >= j) ? lo[r] : up[r]; else pv = lo[r] * fexp2((float)(i >= j ? i - j : j - i) * l2g);
                        P[i * MS + j] = (bf16)f2bf(pv); } } }
            __syncthreads();
            const int mi = w & 3, nt0 = (w >> 2) * 4;
            f32x4 oi[4], oe[4];
#pragma unroll
            for (int t = 0; t < 4; ++t) { oi[t] = (f32x4){0.f, 0.f, 0.f, 0.f}; oe[t] = (f32x4){0.f, 0.f, 0.f, 0.f}; }
#pragma unroll
            for (int ks = 0; ks < 2; ++ks) { const int ao = (16 * mi + fr) * MS + 32 * ks + 8 * fq; const bf16x8 aP = *(const LAS bf16x8*)(P + ao), aQ = *(const LAS bf16x8*)(QE + ao);
#pragma unroll
                for (int t = 0; t < 4; ++t) { const int bo = (16 * (nt0 + t) + fr) * MS + 32 * ks + 8 * fq;
                    oi[t] = __builtin_amdgcn_mfma_f32_16x16x32_bf16(aP, *(const LAS bf16x8*)(VT + tsw(16 * (nt0 + t) + fr, 32 * ks + 8 * fq)), oi[t], 0, 0, 0);
                    oe[t] = __builtin_amdgcn_mfma_f32_16x16x32_bf16(aQ, *(const LAS bf16x8*)(PT + bo), oe[t], 0, 0, 0); } }
            float s1[4], s2[4];
#pragma unroll
            for (int r = 0; r < 4; ++r) { const int i = 16 * mi + 4 * fq + r; const float rs = gla ? 1.0f : fexp2((float)(i + 1) * l2g); s1[r] = 0.f; s2[r] = 0.f;
#pragma unroll
                for (int t = 0; t < 4; ++t) { const float o = oi[t][r] + rs * oe[t][r]; oi[t][r] = o; s1[r] += o; s2[r] += o * o; } }
#pragma unroll
            for (int r = 0; r < 4; ++r) {
                s1[r] += dppf<0xB1>(s1[r]); s1[r] += dppf<0x4E>(s1[r]); s1[r] += dppf<0x141>(s1[r]); s1[r] += dppf<0x140>(s1[r]);
                s2[r] += dppf<0xB1>(s2[r]); s2[r] += dppf<0x4E>(s2[r]); s2[r] += dppf<0x141>(s2[r]); s2[r] += dppf<0x140>(s2[r]);
                if (fr == 0) { const int i = 16 * mi + 4 * fq + r; RED[(i * 2 + (w >> 2)) * 2] = s1[r]; RED[(i * 2 + (w >> 2)) * 2 + 1] = s2[r]; } }
            __syncthreads();
#pragma unroll
            for (int r = 0; r < 4; ++r) { const int i = 16 * mi + 4 * fq + r;
                const float a1 = RED[i * 4] + RED[i * 4 + 2], a2 = RED[i * 4 + 1] + RED[i * 4 + 3];
                const float mu = gla ? 0.f : a1 * (1.f / 128.f); const float var = a2 * (1.f / 128.f) - mu * mu; const float rstd = 1.0f / sqrtf(var + LN_EPS);
#pragma unroll
                for (int t = 0; t < 4; ++t) { const int e = 16 * (nt0 + t) + fr;
                    OUT[i * OUTS + e] = gla ? oi[t][r] * rstd * NP[e] : (oi[t][r] - mu) * rstd * NP[128 + e] + NP[256 + e]; } }
            if (k < 15) { const MixItem mn = mix_item(vb, k + 1); MO_STAGE1(mn.gla, (k + 1) >> 1); gn0 = R.gt[0]; gn1 = R.gt[1]; }
            __syncthreads();
            { const int e0 = (F.tid & 7) * 8; const LAS f32x4* op = (const LAS f32x4*)(OUT + jq * OUTS + e0); float val[16];
#pragma unroll
                for (int x4 = 0; x4 < 4; ++x4) { const f32x4 o = op[(x4 & 1) + 16 * (x4 >> 1)]; val[4 * x4] = o.x; val[4 * x4 + 1] = o.y; val[4 * x4 + 2] = o.z; val[4 * x4 + 3] = o.w; }
#pragma unroll
                for (int x = 0; x < 16; ++x) { const v4u gv = x < 8 ? gc0 : gc1; const int xx = x & 7; const unsigned wg = (xx < 2 ? gv.x : xx < 4 ? gv.y : xx < 6 ? gv.z : gv.w); const float g = (xx & 1) ? bfhi(wg) : bflo(wg);
                    val[x] *= g * __builtin_amdgcn_rcpf(1.0f + fexp2(-g * LOG2E)); }
                v4u o0, o1;
                o0.x = pk2(val[0], val[1]); o0.y = pk2(val[2], val[3]); o0.z = pk2(val[4], val[5]); o0.w = pk2(val[6], val[7]);
                o1.x = pk2(val[8], val[9]); o1.y = pk2(val[10], val[11]); o1.z = pk2(val[12], val[13]); o1.w = pk2(val[14], val[15]);
                GAS v4u* dst = (GAS v4u*)(F.MIXED + (m.t0 + jq) * D + m.h8 * 128 + e0); dst[0] = o0; dst[8] = o1; }
            if (k < 15) { const MixItem mn = mix_item(vb, k + 1); MO_IMAGES(mn.gla); if (k < 14) mixer_out_load(F, mix_item(vb, k + 2), R); }
            gc0 = gn0; gc1 = gn1;
            __syncthreads();
        }
    }
#undef MO_STAGE1
#undef MO_SEL
#undef MO_IMAGES
}

__device__ __forceinline__ void p6_ln1_route(Frame& F) {
    LAS bf16* WB = (LAS bf16*)(F.lds + RING_OFF);
    f32x4 rw[16];
#pragma unroll
    for (int u = 0; u < 16; ++u) rw[u] = *((const GAS f32x4*)F.router_w + F.tid + 512 * u);
#pragma unroll
    for (int u = 0; u < 16; ++u) { const int idx = F.tid + 512 * u; const int c = idx >> 3, ch = idx & 7; const f32x4 wv = rw[u];
#pragma unroll
        for (int x = 0; x < 4; ++x) { const int e = 4 * ch + x; const float w = wv[x]; const unsigned hi = f2bf(w); const float rem = w - bf2f(hi);
            const int off = e * 2048 + ((((c >> 3) ^ (e & 15)) << 3) | (c & 7)); WB[off] = (bf16)hi; WB[off + 1024] = (bf16)f2bf(rem); } }
    LAS float* LNP = (LAS float*)(F.lds + X_GTAB);
    for (int i = F.tid; i < 2 * D; i += 512) LNP[i] = i < D ? F.ln1_g[i] : F.ln1_b[i - D];
    LAS unsigned* lcnt = (LAS unsigned*)(F.lds + X_LCNT); LAS unsigned* lbase = (LAS unsigned*)(F.lds + X_LBASE); LAS unsigned* nasg = (LAS unsigned*)(F.lds + X_NASG); LAS unsigned* asg = (LAS unsigned*)(F.lds + X_ASG);
    const int gw = F.vcu * NWAVES + F.wave, NGW = F.G * NWAVES, lane = F.lane, r16 = lane & 15, cq = lane >> 4;
    const float rb0 = F.router_b[r16], rb1 = F.router_b[16 + r16];
    for (int base = 0; base < M / 16; base += NGW) {
        if (F.tid < 32) lcnt[F.tid] = 0u; if (F.tid == 32) nasg[0] = 0u;
        __syncthreads();
        const int tile = base + gw;
        if (tile < M / 16) {
            const int row = 16 * tile + r16;
            const bf16* xrow = (const bf16*)F.PRE1 + (size_t)row * D + 8 * cq;
            float sum = 0.f, sq = 0.f;
#pragma unroll 8
            for (int s = 0; s < 32; ++s) { const v4u x = *(const GAS v4u*)(xrow + 32 * s);
                const float f0 = bflo(x.x), f1 = bfhi(x.x), f2 = bflo(x.y), f3 = bfhi(x.y), f4 = bflo(x.z), f5 = bfhi(x.z), f6 = bflo(x.w), f7 = bfhi(x.w);
                sum += ((f0 + f1) + (f2 + f3)) + ((f4 + f5) + (f6 + f7)); sq += ((f0 * f0 + f1 * f1) + (f2 * f2 + f3 * f3)) + ((f4 * f4 + f5 * f5) + (f6 * f6 + f7 * f7)); }
            sum += __shfl_xor(sum, 16); sum += __shfl_xor(sum, 32); sq += __shfl_xor(sq, 16); sq += __shfl_xor(sq, 32);
            const float mean = sum * (1.f / D); const float rstd = 1.0f / sqrtf(fmaxf(sq * (1.f / D) - mean * mean, 0.f) + LN_EPS);
            f32x4 acc[2]; acc[0] = (f32x4){0.f, 0.f, 0.f, 0.f}; acc[1] = (f32x4){0.f, 0.f, 0.f, 0.f};
            int bt[2][4];
#pragma unroll
            for (int nt = 0; nt < 2; ++nt)
#pragma unroll
                for (int j = 0; j < 4; ++j) bt[nt][j] = (16 * nt + r16) * 2048 + (((4 * j + cq) ^ r16) << 3);
            GAS unsigned char* hq = (GAS unsigned char*)F.H1B + (size_t)row * D + 8 * cq;
            for (int s4 = 0; s4 < 8; ++s4) {
#pragma unroll
                for (int j = 0; j < 4; ++j) { const int s = 4 * s4 + j, c0 = 32 * s + 8 * cq; const v4u x = *(const GAS v4u*)(xrow + 32 * s);
                    const f32x4 ga = *(const LAS f32x4*)(LNP + c0), gb = *(const LAS f32x4*)(LNP + c0 + 4), ba = *(const LAS f32x4*)(LNP + D + c0), bb = *(const LAS f32x4*)(LNP + D + c0 + 4);
                    float h[8];
                    h[0] = (bflo(x.x) - mean) * rstd * ga[0] + ba[0]; h[1] = (bfhi(x.x) - mean) * rstd * ga[1] + ba[1]; h[2] = (bflo(x.y) - mean) * rstd * ga[2] + ba[2]; h[3] = (bfhi(x.y) - mean) * rstd * ga[3] + ba[3];
                    h[4] = (bflo(x.z) - mean) * rstd * gb[0] + bb[0]; h[5] = (bfhi(x.z) - mean) * rstd * gb[1] + bb[1]; h[6] = (bflo(x.w) - mean) * rstd * gb[2] + bb[2]; h[7] = (bfhi(x.w) - mean) * rstd * gb[3] + bb[3];
                    typedef unsigned u32x2_t __attribute__((ext_vector_type(2)));
                    *(GAS u32x2_t*)(hq + 32 * s) = (u32x2_t){pk4_fp8(h[0] * QS_H1, h[1] * QS_H1, h[2] * QS_H1, h[3] * QS_H1), pk4_fp8(h[4] * QS_H1, h[5] * QS_H1, h[6] * QS_H1, h[7] * QS_H1)};
                    v4u ahi, alo;
                    ahi.x = pk2(h[0], h[1]); ahi.y = pk2(h[2], h[3]); ahi.z = pk2(h[4], h[5]); ahi.w = pk2(h[6], h[7]);
                    alo.x = pk2(h[0] - bflo(ahi.x), h[1] - bfhi(ahi.x)); alo.y = pk2(h[2] - bflo(ahi.y), h[3] - bfhi(ahi.y)); alo.z = pk2(h[4] - bflo(ahi.z), h[5] - bfhi(ahi.z)); alo.w = pk2(h[6] - bflo(ahi.w), h[7] - bfhi(ahi.w));
                    const bf16x8 Ah = __builtin_bit_cast(bf16x8, ahi), Al = __builtin_bit_cast(bf16x8, alo);
#pragma unroll
                    for (int nt = 0; nt < 2; ++nt) { const LAS bf16* wp = WB + bt[nt][j] + s4 * 128;
                        const bf16x8 Bh = *(const LAS bf16x8*)wp, Bl = *(const LAS bf16x8*)(wp + 1024);
                        acc[nt] = __builtin_amdgcn_mfma_f32_16x16x32_bf16(Ah, Bh, acc[nt], 0, 0, 0);
                        acc[nt] = __builtin_amdgcn_mfma_f32_16x16x32_bf16(Ah, Bl, acc[nt], 0, 0, 0);
                        acc[nt] = __builtin_amdgcn_mfma_f32_16x16x32_bf16(Al, Bh, acc[nt], 0, 0, 0); } } }
#pragma unroll
            for (int reg = 0; reg < 4; ++reg) { const int trow = 16 * tile + 4 * cq + reg;
                float a0 = acc[0][reg] + rb0, a1 = acc[1][reg] + rb1; float tv[4]; int ti[4];
#pragma unroll
                for (int k = 0; k < 4; ++k) { float mx; int idx; if (a1 > a0) { mx = a1; idx = 16 + r16; } else { mx = a0; idx = r16; }
#define P6_STEP(OM, OI) { const float om = (OM); const int oi = (OI); if (om > mx || (om == mx && oi < idx)) { mx = om; idx = oi; } }
                    P6_STEP(dppf<0xB1>(mx), dppi<0xB1>(idx)) P6_STEP(dppf<0x4E>(mx), dppi<0x4E>(idx)) P6_STEP(dppf<0x141>(mx), dppi<0x141>(idx)) P6_STEP(dppf<0x140>(mx), dppi<0x140>(idx))
#undef P6_STEP
                    tv[k] = mx; ti[k] = idx; if (idx == r16) a0 = -3.0e38f; if (idx == 16 + r16) a1 = -3.0e38f; }
                const float e1 = expf(tv[1] - tv[0]), e2 = expf(tv[2] - tv[0]), e3 = expf(tv[3] - tv[0]); const float inv = 1.f / (1.f + e1 + e2 + e3);
                if (r16 < 4) { const float gk = (r16 == 0 ? 1.f : r16 == 1 ? e1 : r16 == 2 ? e2 : e3) * inv; const int ek = (r16 == 0 ? ti[0] : r16 == 1 ? ti[1] : r16 == 2 ? ti[2] : ti[3]);
                    const unsigned tk = (unsigned)(trow * 4 + r16);
                    const unsigned lp = __hip_atomic_fetch_add(lcnt + ek, 1u, __ATOMIC_RELAXED, __HIP_MEMORY_SCOPE_WORKGROUP); const unsigned sl = __hip_atomic_fetch_add(nasg, 1u, __ATOMIC_RELAXED, __HIP_MEMORY_SCOPE_WORKGROUP);
                    asg[sl] = tk | ((unsigned)ek << 17) | (lp << 22); asg[512 + sl] = __builtin_bit_cast(unsigned, gk); } }
        }
        __syncthreads();
        if (F.tid < 32) { const unsigned n = lcnt[F.tid]; lbase[F.tid] = n ? __hip_atomic_fetch_add(F.counts + F.tid, n, __ATOMIC_RELAXED, __HIP_MEMORY_SCOPE_AGENT) : 0u; }
        __syncthreads();
        const unsigned na = nasg[0];
        for (unsigned i = F.tid; i < na; i += 512) { const unsigned a = asg[i]; const unsigned tk = a & 0x1ffffu, e = (a >> 17) & 31u, lp = a >> 22; const size_t o = (size_t)e * M + lbase[e] + lp; F.list[o] = (int)tk; F.slotg[o] = __builtin_bit_cast(float, asg[512 + i]); F.tkslot[tk] = (int)((e << 20) | (lbase[e] + lp)); }
        __syncthreads();
    }
}
__device__ __forceinline__ int moe_tables(Frame& F) {
    LAS int* cnt = (LAS int*)(F.lds + X_CNT); LAS int* ts = (LAS int*)(F.lds + X_TSTART);
    __syncthreads();
    if (F.tid < 32) cnt[F.tid] = (int)__hip_atomic_load(F.counts + F.tid, __ATOMIC_RELAXED, __HIP_MEMORY_SCOPE_AGENT);
    __syncthreads();
    if (F.tid == 0) { int a = 0; for (int e = 0; e < 32; ++e) { ts[e] = a; a += (cnt[e] + 255) >> 8; } ts[32] = a; }
    __syncthreads();
    return __builtin_amdgcn_readfirstlane(ts[32]);
}
__device__ __forceinline__ void p10_final(Frame& F) {
    (void)moe_tables(F); const LAS int* ts = (const LAS int*)(F.lds + X_TSTART);
    const int gw = F.vcu * NWAVES + F.wave, NGW = F.G * NWAVES, lane = F.lane;
    typedef unsigned long long u64; typedef int i32x4v __attribute__((ext_vector_type(4))); typedef float f32x2v __attribute__((ext_vector_type(2)));
    const int cb = ((lane >> 1) & 1) * 128 + (lane >> 4) * 32 + ((lane >> 2) & 3) * 8 + 4 * (lane & 1);
    f32x4 g4[4], b4[4], g1[4], b1[4];
#pragma unroll
    for (int j = 0; j < 4; ++j) { g4[j] = *(const GAS f32x4*)(F.ln2_g + 256 * j + cb); b4[j] = *(const GAS f32x4*)(F.ln2_b + 256 * j + cb);
        g1[j] = *(const GAS f32x4*)(F.ln1_g + 256 * j + cb); b1[j] = *(const GAS f32x4*)(F.ln1_b + 256 * j + cb); }
    u64 nh[4]; unsigned ny[4][4]; i32x4v ns; int row = gw;
#define P10_SLOTS(R) do { ns = *((const GAS i32x4v*)F.tkslot + (R)); } while (0)
#define P10_LOAD(R) do { int sl_[4]; sl_[0] = ts[ns.x >> 20] * 256 + (ns.x & 0xfffff); sl_[1] = ts[ns.y >> 20] * 256 + (ns.y & 0xfffff); sl_[2] = ts[ns.z >> 20] * 256 + (ns.z & 0xfffff); sl_[3] = ts[ns.w >> 20] * 256 + (ns.w & 0xfffff); \
        _Pragma("unroll") for (int j = 0; j < 4; ++j) { nh[j] = __builtin_nontemporal_load((const GAS u64*)((const bf16*)F.PRE1 + (size_t)(R) * D + 256 * j + cb)); \
        _Pragma("unroll") for (int k = 0; k < 4; ++k) ny[j][k] = __builtin_nontemporal_load((const GAS unsigned*)((const GAS unsigned char*)F.Y + (size_t)sl_[k] * D) + lane + 64 * j); } } while (0)
    if (row < M) { P10_SLOTS(row); P10_LOAD(row); if (row + NGW < M) P10_SLOTS(row + NGW); }
    for (; row < M; row += NGW) {
        f32x4 v[4], y[4]; float s = 0.f;
#pragma unroll
        for (int j = 0; j < 4; ++j) { const unsigned lo = (unsigned)nh[j], hi = (unsigned)(nh[j] >> 32);
            v[j] = (f32x4){__builtin_bit_cast(float, lo << 16), __builtin_bit_cast(float, lo & 0xffff0000u), __builtin_bit_cast(float, hi << 16), __builtin_bit_cast(float, hi & 0xffff0000u)};
            s += (v[j].x + v[j].y) + (v[j].z + v[j].w);
            y[j] = (f32x4){0.f, 0.f, 0.f, 0.f};
#pragma unroll
            for (int k = 0; k < 4; ++k) { const f32x2v p0 = __builtin_amdgcn_cvt_pk_f32_fp8((int)ny[j][k], false), p1 = __builtin_amdgcn_cvt_pk_f32_fp8((int)ny[j][k], true);
                y[j].x += p0.x; y[j].y += p0.y; y[j].z += p1.x; y[j].w += p1.y; } }
        if (row + NGW < M) { P10_LOAD(row + NGW); if (row + 2 * NGW < M) P10_SLOTS(row + 2 * NGW); }
        const float mean1 = wave_sum(s) * (1.f / D); float q1 = 0.f;
#pragma unroll
        for (int j = 0; j < 4; ++j) { v[j] = v[j] - mean1; q1 += (v[j].x * v[j].x + v[j].y * v[j].y) + (v[j].z * v[j].z + v[j].w * v[j].w); }
        const float rstd1 = 1.f / sqrtf(wave_sum(q1) * (1.f / D) + LN_EPS);
        float s2 = 0.f;
#pragma unroll
        for (int j = 0; j < 4; ++j) { v[j] = (v[j] * rstd1 * g1[j] + b1[j]) * ALPHA + y[j] * (1.0f / QS_Y); s2 += (v[j].x + v[j].y) + (v[j].z + v[j].w); }
        const float mean = wave_sum(s2) * (1.f / D); float q2 = 0.f;
#pragma unroll
        for (int j = 0; j < 4; ++j) { v[j] = v[j] - mean; q2 += (v[j].x * v[j].x + v[j].y * v[j].y) + (v[j].z * v[j].z + v[j].w * v[j].w); }
        const float rstd = 1.f / sqrtf(wave_sum(q2) * (1.f / D) + LN_EPS);
        float* hr = F.out + (size_t)row * D + cb;
#pragma unroll
        for (int j = 0; j < 4; ++j) __builtin_nontemporal_store(v[j] * rstd * g4[j] + b4[j], (GAS f32x4*)(hr + 256 * j));
    }
#undef P10_LOAD
#undef P10_SLOTS
}

struct Args { const void* in[21]; float* out; unsigned char* ws; int ph_lo, ph_hi; };
__global__ void __launch_bounds__(NWAVES * 64, 2) fwd_kernel(Args args) {
    extern __shared__ __attribute__((aligned(16))) unsigned char lds[];
    Frame F;
    F.lds = (LAS unsigned char*)lds;
    F.MISC = (volatile LAS unsigned*)(F.lds + MISC_OFF);
    F.tid = threadIdx.x; F.lane = F.tid & 63; F.wave = __builtin_amdgcn_readfirstlane(F.tid >> 6);
    F.G = gridDim.x; { const int bx = blockIdx.x; F.vcu = (F.G % 8 == 0) ? (bx % 8) * (F.G / 8) + bx / 8 : bx; }
    unsigned char* ws = args.ws;
    F.ctl = (gu32*)(ws + WS_CTL);
    F.x = (const float*)args.in[0]; F.positions = (const int*)args.in[1]; F.ln_in_g = (const float*)args.in[2]; F.ln_in_b = (const float*)args.in[3];
    F.w_in = (const float*)args.in[4]; F.gate_w = (const float*)args.in[5]; F.gate_b = (const float*)args.in[6]; F.gla_g = (const float*)args.in[7];
    F.ret_g = (const float*)args.in[8]; F.ret_b = (const float*)args.in[9]; F.w_out = (const float*)args.in[10]; F.ln1_g = (const float*)args.in[11]; F.ln1_b = (const float*)args.in[12];
    F.router_w = (const float*)args.in[13]; F.router_b = (const float*)args.in[14]; F.w1 = (const float*)args.in[15]; F.b1 = (const float*)args.in[16];
    F.w2 = (const float*)args.in[17]; F.b2 = (const float*)args.in[18]; F.ln2_g = (const float*)args.in[19]; F.ln2_b = (const float*)args.in[20];
    F.out = args.out;
    F.stats0 = (float*)(ws + WS_STATS0); F.cosT = (float*)(ws + WS_COS); F.sinT = (float*)(ws + WS_SIN); F.ST = (float*)(ws + WS_ST); F.DEC = (float*)(ws + WS_DEC); F.PRE1 = (float*)(ws + WS_PRE1);
    F.AGG = (float*)(ws + WS_AGG); F.SIN = (bf16*)(ws + WS_SINS); F.DAGG = (float*)(ws + WS_DAGG); F.GLR = (float*)(ws + WS_PROJ + PJ_GLR); F.gates = (float*)(ws + WS_GATES);
    F.WinT = (bf16*)(ws + WS_WINT); F.WoT = (bf16*)(ws + WS_WOT); F.W1T = (bf16*)(ws + WS_W1T); F.W2T = (bf16*)(ws + WS_W2T); F.H0B = (bf16*)(ws + WS_H0B); F.MIXED = (bf16*)(ws + WS_MIXED);
    F.GQ = (bf16*)(ws + WS_PROJ + PJ_GQ); F.GK = (bf16*)(ws + WS_PROJ + PJ_GK); F.GV = (bf16*)(ws + WS_PROJ + PJ_GV); F.GG = (bf16*)(ws + WS_PROJ + PJ_GG);
    F.RQ = (bf16*)(ws + WS_PROJ + PJ_RQ); F.RK = (bf16*)(ws + WS_PROJ + PJ_RK); F.RV = (bf16*)(ws + WS_PROJ + PJ_RV); F.RG = (bf16*)(ws + WS_PROJ + PJ_RG);
    F.H1B = (bf16*)(ws + WS_H1B); F.XS = (bf16*)(ws + WS_XS); F.ACT = (bf16*)(ws + WS_ACT); F.Y = (bf16*)(ws + WS_Y);
    F.list = (int*)(ws + WS_LIST); F.slotg = (float*)(ws + WS_SLOTG); F.tkslot = (int*)(ws + WS_GATES); F.counts = (unsigned*)(ws + WS_CTL) + CW_COUNTS;
    for (int u = F.tid; u < (LDS_BYTES - LDSCTL_OFF) / 4; u += NWAVES * 64) ((LAS unsigned*)(F.lds + LDSCTL_OFF))[u] = 0u;
    __syncthreads();
    const int lo = args.ph_lo, hi = args.ph_hi;
    const bool multi = (hi - lo) > 1;
    XcdBarrier bar; bar.bar = (unsigned*)(F.ctl + CW_BAR); bar.x = 0; bar.st = nullptr;
    if (multi) bar = xcd_barrier_post((unsigned*)(F.ctl + CW_BAR), F.MISC + 8);
#define IN(k) (lo <= (k) && (k) < hi)
#define SEAM(k) do { if (IN(k) && (IN((k) + 1) || ((k) == 6 && IN(8)))) xcd_barrier(bar); } while (0)

    if (IN(0)) { p0_prologue(F); SEAM(0); }
    if (IN(1)) { {
        pg8::Gemm g{F.H0B, F.WinT, M, NPROJ_T * 256, D, nullptr}; pg8::StaticOrder S; S.init(M, NPROJ_T * 256, F.G, (int)blockIdx.x);
        pg8::EpiProj E{F.GQ, F.GK, F.GV, F.GG, F.RQ, F.RK, F.RV, F.RG, F.GLR, F.cosT, F.sinT};
        pg8::gemm_phase<pg8::EpiProj, pg8::StaticOrder, true, true>(F.lds + RING_OFF, g, S, E); }
        SEAM(1);
    }
    if (IN(2)) { mixer_kv_phase(F); SEAM(2); }
    if (IN(3)) { mixer_scan(F); SEAM(3); }
    if (IN(4)) { mixer_out_phase(F); SEAM(4); }
    if (IN(5)) { {
        pg8::Gemm g{F.MIXED, F.WoT, M, D, D, nullptr}; pg8::StaticOrder S; S.init(M, D, F.G, (int)blockIdx.x);
        pg8::EpiOutProj E{F.H0B, (bf16*)F.PRE1, ALPHA};
        pg8::gemm_phase<pg8::EpiOutProj, pg8::StaticOrder, true, true>(F.lds + RING_OFF, g, S, E); }
        SEAM(5);
    }
    if (IN(6)) { p6_ln1_route(F); SEAM(6); }
    if (IN(8)) {
        const int ntiles = moe_tables(F);
        pg8::GroupedOrder S; S.init(ntiles, 8, F.G, (int)blockIdx.x, (const LAS int*)(F.lds + X_TSTART));
        { LAS unsigned* gtab = (LAS unsigned*)(F.lds + X_GTAB); const LAS int* cntl = (const LAS int*)(F.lds + X_CNT); pg8::Unit u;
            for (int i = 0; i < GT_MAXU && S.next(i, u); ++i) if (F.tid < 256) { const int lr = u.lt * 256 + F.tid;
                gtab[i * 256 + F.tid] = (lr < cntl[u.e]) ? (unsigned)(F.list[(size_t)u.e * M + lr] >> 2) * (unsigned)D : 0u; }
            __syncthreads(); }
        pg8::Gemm g{F.H1B, F.W1T, M, 2 * DFF, D, (const LAS unsigned*)(F.lds + X_GTAB)};
        pg8::EpiSwiGLU E{(unsigned char*)F.ACT, F.b1, 1.0f / (QS_H1 * QS_W)};
        pg8::gemm_phase<pg8::EpiSwiGLU, pg8::GroupedOrder, true, true, 1, true>(F.lds + RING_OFF, g, S, E);
        SEAM(8);
    }
    if (IN(9)) { {
        const int ntiles = moe_tables(F);
        pg8::Gemm g{F.ACT, F.W2T, ntiles * 256, D, DFF, nullptr}; pg8::GroupedOrder S; S.init(ntiles, 4, F.G, (int)blockIdx.x, (const LAS int*)(F.lds + X_TSTART));
        { LAS float* gt = (LAS float*)(F.lds + X_GTAB); const LAS int* cntl = (const LAS int*)(F.lds + X_CNT); pg8::Unit u;
            for (int i = 0; i < GT_MAXU && S.next(i, u); ++i) if (F.tid < 256) { const int lr = u.lt * 256 + F.tid; gt[i * 256 + F.tid] = (lr < cntl[u.e]) ? F.slotg[(size_t)u.e * M + lr] : 0.f; }
            __syncthreads(); }
        pg8::EpiMoeOut E{(unsigned char*)F.Y, F.b2, (const LAS float*)(F.lds + X_GTAB), 1.0f / (QS_ACT * QS_W)};
        pg8::gemm_phase<pg8::EpiMoeOut, pg8::GroupedOrder, true, true, 1>(F.lds + RING_OFF, g, S, E); }
        SEAM(9);
    }
    if (IN(10)) { p10_final(F); }
#undef IN
#undef SEAM
}

extern "C" void kernel_launch(void* const* d_in, const int* in_sizes, int n_in, void* d_out, int out_size, void* d_ws, size_t ws_size, hipStream_t stream) {
    static int grid = 0;
    if (grid == 0) {
        if (n_in != 21 || out_size != M * D || ws_size < WS_END) { fprintf(stderr, "kernel_launch: unexpected problem (n_in %d, out %d, ws %zu)\n", n_in, out_size, ws_size); grid = -1; return; }
        int dev = 0, cus = 0;
        if (hipGetDevice(&dev) != hipSuccess || hipDeviceGetAttribute(&cus, hipDeviceAttributeMultiprocessorCount, dev) != hipSuccess) { grid = -1; return; }
        if (hipFuncSetAttribute((const void*)fwd_kernel, hipFuncAttributeMaxDynamicSharedMemorySize, LDS_BYTES) != hipSuccess) { fprintf(stderr, "kernel_launch: hipFuncSetAttribute failed\n"); grid = -1; return; }
        (void)hipGetLastError();
        grid = cus;
    }
    if (grid < 0) return;
    if (hipMemsetAsync((char*)d_ws + WS_CTL, 0, CTL_ZERO_BYTES, stream) != hipSuccess) return;
    Args a{};
    for (int i = 0; i < 21; ++i) a.in[i] = d_in[i];
    a.out = (float*)d_out; a.ws = (unsigned char*)d_ws;
    constexpr int NL = MK_N_LAUNCHES;
    for (int li = 0; li < NL; ++li) {
        a.ph_lo = (NL == 1) ? 0 : li; a.ph_hi = (NL == 1) ? NPH : li + 1;
        hipLaunchKernelGGL(fwd_kernel, dim3(grid), dim3(NWAVES * 64), LDS_BYTES, stream, a);
    }
}
```

```cpp
#include <hip/hip_runtime.h>
#include <cstdio>
#include <cstdint>

#ifndef MK_N_LAUNCHES
#define MK_N_LAUNCHES 1
#endif

constexpr int NB = 4, SEQ = 8192, D = 1024, M = NB * SEQ, CH = 64, NCH = SEQ / CH;
constexpr int PW = 3088, NE = 32, DFF = 1024;
constexpr int NPROJ_T = 12;
constexpr float LN_EPS = 1e-5f;
constexpr float ALPHA = 1.189207115002721f;
constexpr int MAXTILES = (M * 4) / 256 + NE;
constexpr int NITEM = NB * 8 * NCH;
constexpr float QS_H1 = 16.0f, QS_W = 256.0f, QS_ACT = 4.0f, QS_Y = 64.0f, QS_M = 16.0f;
__device__ __forceinline__ float clamp448(float v) { return __builtin_fminf(__builtin_fmaxf(v, -448.0f), 448.0f); }
__device__ __forceinline__ unsigned pk4_fp8(float a, float b, float c, float d) {
    int w = __builtin_amdgcn_cvt_pk_fp8_f32(clamp448(a), clamp448(b), 0, false); w = __builtin_amdgcn_cvt_pk_fp8_f32(clamp448(c), clamp448(d), w, true); return (unsigned)w; }

namespace pg8 {
#define PG8_LAS __attribute__((address_space(3)))
typedef unsigned short bf16_t;
typedef short bf16x8 __attribute__((ext_vector_type(8)));
typedef float f32x4 __attribute__((ext_vector_type(4)));
typedef unsigned u32x4 __attribute__((ext_vector_type(4)));
typedef int i32x4 __attribute__((ext_vector_type(4)));
typedef int i32x8 __attribute__((ext_vector_type(8)));
__device__ __forceinline__ i32x8 cat8(bf16x8 lo, bf16x8 hi) { return __builtin_shufflevector(__builtin_bit_cast(i32x4, lo), __builtin_bit_cast(i32x4, hi), 0, 1, 2, 3, 4, 5, 6, 7); }
constexpr int BM = 256, BK = 64, HALF = 128, HTB = HALF * BK * 2  , STAGE_BYTES = 8 * HTB, NXCD = 8, WGM = 8;

__host__ __device__ __forceinline__ int lds_byte(int r, int c) { const int st = (r >> 4) * 2 + (c >> 5), rr = r & 15, cc = c & 31, ob = rr * 64 + cc * 2; return st * 1024 + (ob ^ (((ob >> 9) & 1) << 5)); }
__host__ __device__ __forceinline__ void stage_rc(int b, int& R, int& C) { const int st = b / 1024, sb = b % 1024, swz = sb ^ (((sb >> 9) & 1) << 5); R = (st >> 1) * 16 + swz / 64; C = (st & 1) * 32 + (swz % 64) / 2; }
__host__ __device__ __forceinline__ int perm32(int rho) { const int n = rho >> 4, i = rho & 15; return 8 * (i >> 2) + 4 * n + (i & 3); }

struct Unit { int pm, pn, e, lt, ui; };
struct Gemm { const bf16_t* A; const bf16_t* Bt; int M, N, K; const PG8_LAS unsigned* gtab; };

struct StaticOrder {
    int nM, nN, nwg, G, c;
    __host__ __device__ void init(int M, int N, int G_, int c_) { nM = M / BM; nN = N / BM; nwg = nM * nN; G = G_; c = c_; }
    __host__ __device__ bool next(int i, Unit& u) const {
        const int L = i * G + c; if (L >= nwg) return false;
        int wgid = L; { const int q = nwg / NXCD, r = nwg % NXCD, xcd = wgid % NXCD, off = wgid / NXCD; wgid = (xcd < r ? xcd * (q + 1) : r * (q + 1) + (xcd - r) * q) + off; }
        const int nig = WGM * nN, gid = wgid / nig, fm = gid * WGM, gsz = (nM - fm) < WGM ? (nM - fm) : WGM;
        u.pm = fm + ((wgid % nig) % gsz); u.pn = (wgid % nig) / gsz; u.e = 0; u.lt = 0; u.ui = i; return true;
    }
    __device__ __forceinline__ void a_ready(const Unit&) const {}
    __device__ __forceinline__ void done(const Unit&) const {}
};


constexpr int ETAB_OFF = 384;
struct GroupedOrder {
    StaticOrder so; const PG8_LAS int* tstart; int nN;
    __device__ __forceinline__ void init(int total_tiles, int nN_, int G_, int c_, const PG8_LAS int* ts) { so.init(total_tiles * BM, nN_ * BM, G_, c_); nN = nN_; tstart = ts; }
    __device__ __forceinline__ bool next(int i, Unit& u) const {
        if (!so.next(i, u)) return false;
        const int e = __builtin_amdgcn_readfirstlane(tstart[ETAB_OFF + u.pm]);
        u.e = e; u.lt = u.pm - __builtin_amdgcn_readfirstlane(tstart[e]); u.pn = e * nN + u.pn; return true;
    }
    __device__ __forceinline__ void a_ready(const Unit&) const {}
    __device__ __forceinline__ void done(const Unit&) const {}
};

struct RowMajorOrder {
    const PG8_LAS int* tstart; int nN, ntiles, G, vcu;
    __device__ __forceinline__ void init(int total_tiles, int nN_, int G_, int vcu_, const PG8_LAS int* ts) { ntiles = total_tiles; nN = nN_; G = G_; vcu = vcu_; tstart = ts; }
    __device__ __forceinline__ bool next(int i, Unit& u) const {
        const int full = ntiles / G;
        int pm, j;
        if (i < full * nN) { pm = vcu + G * (i / nN); j = i % nN; }
        else { const int r = (i - full * nN) * G + vcu; pm = full * G + r / nN; j = r % nN; if (pm >= ntiles) return false; }
        int e = 0;
#pragma unroll
        for (int k = 1; k < 32; ++k) e += (pm >= tstart[k]) ? 1 : 0;
        e = __builtin_amdgcn_readfirstlane(e);
        u.pm = pm; u.e = e; u.lt = pm - __builtin_amdgcn_readfirstlane(tstart[e]); u.pn = e * nN + j; u.ui = i; return true;
    }
    __device__ __forceinline__ void a_ready(const Unit&) const {}
    __device__ __forceinline__ void done(const Unit&) const {}
};

__device__ __forceinline__ unsigned cvt_pk_bf16(float lo, float hi) { unsigned r; asm volatile("v_cvt_pk_bf16_f32 %0, %1, %2" : "=v"(r) : "v"(lo), "v"(hi)); return r; }
__device__ __forceinline__ u32x4 pack8(const f32x4 a, const f32x4 b) { u32x4 w; w.x = cvt_pk_bf16(a[0], a[1]); w.y = cvt_pk_bf16(a[2], a[3]); w.z = cvt_pk_bf16(b[0], b[1]); w.w = cvt_pk_bf16(b[2], b[3]); return w; }


typedef float f2 __attribute__((ext_vector_type(2)));
struct NoPre {};
struct NoSeed {};
#define PG8_ZERO_ACC(acc) do { _Pragma("unroll") for (int a_ = 0; a_ < 2; ++a_) _Pragma("unroll") for (int b_ = 0; b_ < 2; ++b_) _Pragma("unroll") for (int m_ = 0; m_ < 4; ++m_) _Pragma("unroll") for (int n_ = 0; n_ < 2; ++n_) acc[a_][b_][m_][n_] = (f32x4){0.f, 0.f, 0.f, 0.f}; } while (0)
struct EpiProj {
    static constexpr bool PERM = true, AFTER_DRAIN = false; static constexpr int NST = -1;     typedef NoPre Pre; typedef NoSeed Seed;
    __device__ __forceinline__ void seed_load(Seed&, const Unit&, int, int, int, int) const {}
    __device__ __forceinline__ void seed_acc(f32x4 (&acc)[2][2][4][2], const Seed&) const { PG8_ZERO_ACC(acc); }
    __device__ __forceinline__ void prefetch(Pre&, const Unit&, int, int, int, int) const {}
    bf16_t *GQ, *GK, *GV, *GG, *RQ, *RK, *RV, *RG; float* GLR; const float* cosT; const float* sinT;
    __device__ __forceinline__ void operator()(const f32x4 (&acc)[2][2][4][2], const Unit& u, int wr, int wc, int fr, int fq, const Pre& pre) const {
        asm volatile("" : "+v"(fr), "+v"(fq));
        const int row0 = u.pm * BM + wr * 64 + fr; const int t = u.pn;
        if (t == 6 || t == 7) {
            bf16_t* O = (t == 6) ? RQ : RK; const float sc = (t == 6) ? 1.0f : 0.125f;
#pragma unroll
            for (int ai = 0; ai < 2; ++ai)
#pragma unroll
                for (int m = 0; m < 4; ++m) { const int row = row0 + ai * HALF + m * 16;
                    const f32x4 c0 = *(const f32x4*)(cosT + (size_t)row * 32 + 8 * fq), c1 = *(const f32x4*)(cosT + (size_t)row * 32 + 8 * fq + 4);
                    const f32x4 s0 = *(const f32x4*)(sinT + (size_t)row * 32 + 8 * fq), s1 = *(const f32x4*)(sinT + (size_t)row * 32 + 8 * fq + 4);
                    const f32x4 a0 = acc[ai][0][m][0], a1 = acc[ai][0][m][1], b0 = acc[ai][1][m][0], b1 = acc[ai][1][m][1];
                    const f32x4 o10 = (a0 * c0 - b0 * s0) * sc, o11 = (a1 * c1 - b1 * s1) * sc, o20 = (a0 * s0 + b0 * c0) * sc, o21 = (a1 * s1 + b1 * c1) * sc;
                    bf16_t* rp = O + (size_t)row * 256 + wc * 64 + 8 * fq;
                    *(u32x4*)rp = pack8(o10, o11); *(u32x4*)(rp + 32) = pack8(o20, o21); }
        } else if (t == 12) {
            if (wc == 0 && fq < 2) {
#pragma unroll
                for (int ai = 0; ai < 2; ++ai)
#pragma unroll
                    for (int m = 0; m < 4; ++m) { const int row = row0 + ai * HALF + m * 16; float* rp = GLR + (size_t)row * 16 + 8 * fq;
                        *(f32x4*)rp = acc[ai][0][m][0]; *(f32x4*)(rp + 4) = acc[ai][0][m][1]; }
            }
        } else {
            bf16_t* O; int ldc, cb; float sc = 1.0f;
            if (t == 0) { O = GQ; ldc = 256; cb = 0; sc = 0.125f; } else if (t == 1) { O = GK; ldc = 256; cb = 0; }
            else if (t < 4) { O = GV; ldc = 512; cb = (t - 2) * 256; } else if (t < 6) { O = GG; ldc = 512; cb = (t - 4) * 256; }
            else if (t < 10) { O = RV; ldc = 512; cb = (t - 8) * 256; } else { O = RG; ldc = 512; cb = (t - 10) * 256; }
            const int col0 = cb + wc * 32 + 8 * fq;
#pragma unroll
            for (int ai = 0; ai < 2; ++ai)
#pragma unroll
                for (int m = 0; m < 4; ++m) { bf16_t* rp = O + (size_t)(row0 + ai * HALF + m * 16) * ldc + col0;
#pragma unroll
                    for (int bj = 0; bj < 2; ++bj) *(u32x4*)(rp + bj * HALF) = pack8(acc[ai][bj][m][0] * sc, acc[ai][bj][m][1] * sc); }
        }
    }
};

struct EpiOutProj {
    static constexpr bool PERM = true, AFTER_DRAIN = false; static constexpr int NST = 16;     typedef NoPre Pre; typedef NoSeed Seed;
    __device__ __forceinline__ void seed_load(Seed&, const Unit&, int, int, int, int) const {}
    __device__ __forceinline__ void seed_acc(f32x4 (&acc)[2][2][4][2], const Seed&) const { PG8_ZERO_ACC(acc); }
    __device__ __forceinline__ void prefetch(Pre&, const Unit&, int, int, int, int) const {}
    const bf16_t* h0b; bf16_t* out; float alpha, asc;
    __device__ __forceinline__ void operator()(const f32x4 (&acc)[2][2][4][2], const Unit& u, int wr, int wc, int fr, int fq, const Pre& pre) const {
        asm volatile("" : "+v"(fr), "+v"(fq));
        const int row0 = u.pm * BM + wr * 64 + fr, col0 = u.pn * BM + wc * 32 + 8 * fq;
#pragma unroll
        for (int ai = 0; ai < 2; ++ai)
#pragma unroll
            for (int m = 0; m < 4; ++m) { const size_t off = (size_t)(row0 + ai * HALF + m * 16) * D + col0;
                u32x4 hv[2];
#pragma unroll
                for (int bj = 0; bj < 2; ++bj) hv[bj] = *(const u32x4*)(h0b + off + bj * HALF);
#pragma unroll
                for (int bj = 0; bj < 2; ++bj) { f32x4 a0, a1;
                    a0[0] = __builtin_bit_cast(float, hv[bj].x << 16); a0[1] = __builtin_bit_cast(float, hv[bj].x & 0xffff0000u); a0[2] = __builtin_bit_cast(float, hv[bj].y << 16); a0[3] = __builtin_bit_cast(float, hv[bj].y & 0xffff0000u);
                    a1[0] = __builtin_bit_cast(float, hv[bj].z << 16); a1[1] = __builtin_bit_cast(float, hv[bj].z & 0xffff0000u); a1[2] = __builtin_bit_cast(float, hv[bj].w << 16); a1[3] = __builtin_bit_cast(float, hv[bj].w & 0xffff0000u);
                    *(u32x4*)(out + off + bj * HALF) = pack8(a0 * alpha + acc[ai][bj][m][0] * asc, a1 * alpha + acc[ai][bj][m][1] * asc); }
                asm volatile("" ::: "memory"); }
    }
};

struct EpiSwiGLU {
    static constexpr bool PERM = true, AFTER_DRAIN = false; static constexpr int NST = -1;     typedef NoPre Pre;
    struct Seed { f32x4 g0, g1, l0, l1; };
    __device__ __forceinline__ void seed_load(Seed& sd, const Unit& u, int wr, int wc, int fr, int fq) const {
        asm volatile("" : "+v"(fq));
        const int e = u.e, jt = u.pn - e * 8; const int colc = jt * 128 + wc * 32 + 8 * fq; const float* bp = b1 + (size_t)e * 2048 + colc;
        sd.g0 = *(const f32x4*)bp; sd.g1 = *(const f32x4*)(bp + 4); sd.l0 = *(const f32x4*)(bp + 1024); sd.l1 = *(const f32x4*)(bp + 1028);
    }
    __device__ __forceinline__ void seed_acc(f32x4 (&acc)[2][2][4][2], const Seed& sd) const {
        const float inv = QS_H1 * QS_W; const f32x4 g0 = sd.g0 * inv, g1 = sd.g1 * inv, l0 = sd.l0 * inv, l1 = sd.l1 * inv;
#pragma unroll
        for (int ai = 0; ai < 2; ++ai)
#pragma unroll
            for (int m = 0; m < 4; ++m) { acc[ai][0][m][0] = g0; acc[ai][0][m][1] = g1; acc[ai][1][m][0] = l0; acc[ai][1][m][1] = l1; }
    }
    __device__ __forceinline__ void prefetch(Pre&, const Unit&, int, int, int, int) const {}
    unsigned char* ACT; const float* b1; float asc;
    __device__ __forceinline__ void operator()(const f32x4 (&acc)[2][2][4][2], const Unit& u, int wr, int wc, int fr, int fq, const Pre& pre) const {
        asm volatile("" : "+v"(fr), "+v"(fq));
        const int e = u.e, jt = u.pn - e * 8; const int colc = jt * 128 + wc * 32 + 8 * fq;
        const int row0 = u.pm * BM + wr * 64 + fr;
        const float inv = QS_H1 * QS_W; const f2 kc = {asc * (-1.702f * 1.4426950408889634f), asc * (-1.702f * 1.4426950408889634f)}, one = {1.0f, 1.0f}, q2 = {QS_ACT * asc * asc, QS_ACT * asc * asc}, q1 = {QS_ACT * asc, QS_ACT * asc};
#pragma unroll
        for (int ai = 0; ai < 2; ++ai)
#pragma unroll
            for (int m = 0; m < 4; ++m) { typedef unsigned u32x2_t __attribute__((ext_vector_type(2))); u32x2_t w;
#pragma unroll
                for (int n = 0; n < 2; ++n) { int wv = 0;
#pragma unroll
                    for (int p = 0; p < 2; ++p) {
                        f2 mg, ml, ex, rc; const f32x4 ag = acc[ai][0][m][n], al = acc[ai][1][m][n];
                        mg.x = __builtin_amdgcn_fmed3f(ag[2 * p], -3.0e38f, 7.0f * inv); mg.y = __builtin_amdgcn_fmed3f(ag[2 * p + 1], -3.0e38f, 7.0f * inv);
                        ml.x = __builtin_amdgcn_fmed3f(al[2 * p], -7.0f * inv, 7.0f * inv); ml.y = __builtin_amdgcn_fmed3f(al[2 * p + 1], -7.0f * inv, 7.0f * inv);
                        const f2 t = mg * kc;
                        ex.x = __builtin_amdgcn_exp2f(t.x); ex.y = __builtin_amdgcn_exp2f(t.y);
                        const f2 dn = ex + one;
                        rc.x = __builtin_amdgcn_rcpf(dn.x); rc.y = __builtin_amdgcn_rcpf(dn.y);
                        const f2 o = (mg * rc) * (ml * q2 + q1);
                        wv = p ? __builtin_amdgcn_cvt_pk_fp8_f32(o.x, o.y, wv, true) : __builtin_amdgcn_cvt_pk_fp8_f32(o.x, o.y, 0, false); }
                    w[n] = (unsigned)wv; }
                *(u32x2_t*)(ACT + (size_t)(row0 + ai * HALF + m * 16) * DFF + colc) = w; }
    }
};

struct EpiMoeOut {
    static constexpr bool PERM = true, AFTER_DRAIN = false; static constexpr int NST = 8;     typedef NoPre Pre;
    struct Seed { f32x4 bv[2][2]; };
    __device__ __forceinline__ void seed_load(Seed& sd, const Unit& u, int wr, int wc, int fr, int fq) const {
        asm volatile("" : "+v"(fq));
        const int e = u.e, jt = u.pn - e * 4; const int col0 = jt * 256 + wc * 32 + 8 * fq;
#pragma unroll
        for (int bj = 0; bj < 2; ++bj)
#pragma unroll
            for (int n = 0; n < 2; ++n) sd.bv[bj][n] = *(const f32x4*)(b2 + (size_t)e * D + col0 + bj * HALF + 4 * n);
    }
    __device__ __forceinline__ void seed_acc(f32x4 (&acc)[2][2][4][2], const Seed& sd) const {
        const float inv = QS_ACT * QS_W;
#pragma unroll
        for (int bj = 0; bj < 2; ++bj)
#pragma unroll
            for (int n = 0; n < 2; ++n) { const f32x4 v = sd.bv[bj][n] * inv;
#pragma unroll
                for (int ai = 0; ai < 2; ++ai)
#pragma unroll
                    for (int m = 0; m < 4; ++m) acc[ai][bj][m][n] = v; }
    }
    __device__ __forceinline__ void prefetch(Pre&, const Unit&, int, int, int, int) const {}
    unsigned char* Y; const float* b2; const PG8_LAS float* gtab; float asc;
    __device__ __forceinline__ void operator()(const f32x4 (&acc)[2][2][4][2], const Unit& u, int wr, int wc, int fr, int fq, const Pre& pre) const {
        asm volatile("" : "+v"(fr), "+v"(fq));
        const int e = u.e, jt = u.pn - e * 4; const int colp = jt * 256 + wc * 64 + 16 * fq;
        const int row0 = u.pm * BM + wr * 64 + fr; const PG8_LAS float* gp = gtab + u.ui * 256 + wr * 64 + fr;
#pragma unroll
        for (int ai = 0; ai < 2; ++ai)
#pragma unroll
            for (int m = 0; m < 4; ++m) { const float gt = gp[ai * HALF + m * 16] * (QS_Y * asc); u32x4 w;
#pragma unroll
                for (int bj = 0; bj < 2; ++bj) { const f32x4 v0 = acc[ai][bj][m][0] * gt, v1 = acc[ai][bj][m][1] * gt;
                    const unsigned lo = pk4_fp8(v0[0], v0[1], v0[2], v0[3]), hi = pk4_fp8(v1[0], v1[1], v1[2], v1[3]);
                    if (bj == 0) { w.x = lo; w.y = hi; } else { w.z = lo; w.w = hi; } }
                *(u32x4*)(Y + (size_t)(row0 + ai * HALF + m * 16) * D + colp) = w; }
    }
};

template <class Epi, class Sched, bool ALIGN_EPI = false, bool SP2 = false, int ES = 2, bool GATHER = false>
__device__ __forceinline__ void gemm_phase(PG8_LAS unsigned char* lds, const Gemm g, const Sched& S, const Epi& E) {
    const int tid = threadIdx.x, wid = __builtin_amdgcn_readfirstlane(tid >> 6), lane = tid & 63, wr = wid >> 2, wc = wid & 3, fr = lane & 15, fq = lane >> 4;
    const int K = g.K * ES / 2, nt = K / BK;
    unsigned voffA[2], voffB[2]; int gR[2]; unsigned gC[2];
#pragma unroll
    for (int i = 0; i < 2; ++i) { int R, C; stage_rc(tid * 16 + i * 8192, R, C); const int Rb = Epi::PERM ? ((R & ~31) + perm32(R & 31)) : R;
        voffA[i] = (unsigned)(R * K + C) * 2u; voffB[i] = (unsigned)(Rb * K + C) * 2u; gR[i] = R; gC[i] = (unsigned)C * 2u; }
    unsigned vAc[2][2], vAn[2][2], vAs[2][2];
#define PG8_GLOAD(dst, ui_) do { _Pragma("unroll") for (int h_ = 0; h_ < 2; ++h_) _Pragma("unroll") for (int i_ = 0; i_ < 2; ++i_) dst[h_][i_] = g.gtab[(ui_) * 256 + h_ * HALF + gR[i_]] + gC[i_]; } while (0)
#define PG8_STAGE_A(b, h, soff, V) do { if constexpr (GATHER) { PG8_STAGE_R(PG8_SA(b, h), rA, soff, V[h]); } else { PG8_STAGE_R(PG8_SA(b, h), rA, (soff) + (h) * hstep, voffA); } } while (0)
    const unsigned kstep = (unsigned)(BK * 2);
    const unsigned hstep = (unsigned)HALF * K * 2;
    const unsigned tstep = 2 * hstep;
    const unsigned ldsw = (unsigned)wid * 1024u;
    const int aoff = lds_byte(wr * 64 + fr, fq * 8), boff = lds_byte(wc * 32 + fr, fq * 8);
#define PG8_SA(b, h) (((b) * 2 + (h)) * HTB)
#define PG8_SB(b, h) ((4 + (b) * 2 + (h)) * HTB)
    const __amdgpu_buffer_rsrc_t rA = __builtin_amdgcn_make_buffer_rsrc((void*)g.A, (short)0, 0x7fffffff, 0x00020000);
    const __amdgpu_buffer_rsrc_t rB = __builtin_amdgcn_make_buffer_rsrc((void*)g.Bt, (short)0, 0x7fffffff, 0x00020000);
#define PG8_STAGE_R(bufoff, rsrc, soff, voff) do { _Pragma("unroll") for (int _i = 0; _i < 2; ++_i) \
        __builtin_amdgcn_raw_ptr_buffer_load_lds(rsrc, (PG8_LAS void*)(lds + (bufoff) + ldsw + _i * 8192), 16, (int)(voff)[_i], (int)(soff), 0, 0); } while (0)
#define PG8_LDA(dst, b, h) do { _Pragma("unroll") for (int m = 0; m < 4; ++m) _Pragma("unroll") for (int k = 0; k < 2; ++k) dst[m][k] = *(const PG8_LAS bf16x8*)(lds + PG8_SA(b, h) + aoff + m * 2048 + k * 1024); } while (0)
#define PG8_LDB(dst, b, h) do { _Pragma("unroll") for (int n = 0; n < 2; ++n) _Pragma("unroll") for (int k = 0; k < 2; ++k) dst[n][k] = *(const PG8_LAS bf16x8*)(lds + PG8_SB(b, h) + boff + n * 2048 + k * 1024); } while (0)
#define PG8_PIN12(At, Bt) asm volatile("" : "+v"(At[0][0]), "+v"(At[0][1]), "+v"(At[1][0]), "+v"(At[1][1]), "+v"(At[2][0]), "+v"(At[2][1]), "+v"(At[3][0]), "+v"(At[3][1]), "+v"(Bt[0][0]), "+v"(Bt[0][1]), "+v"(Bt[1][0]), "+v"(Bt[1][1]))
#define PG8_PINACC(ai, bj) asm volatile("" : "+v"(acc[ai][bj][0][0]), "+v"(acc[ai][bj][0][1]), "+v"(acc[ai][bj][1][0]), "+v"(acc[ai][bj][1][1]), "+v"(acc[ai][bj][2][0]), "+v"(acc[ai][bj][2][1]), "+v"(acc[ai][bj][3][0]), "+v"(acc[ai][bj][3][1]))
#define PG8_MMA(ai, bj, At, Bt) do { if constexpr (ES == 1) { PG8_PIN12(At, Bt); __builtin_amdgcn_sched_barrier(0); } __builtin_amdgcn_s_setprio(1); _Pragma("unroll") for (int m = 0; m < 4; ++m) _Pragma("unroll") for (int n = 0; n < 2; ++n) { \
        if constexpr (ES == 2) { _Pragma("unroll") for (int k = 0; k < 2; ++k) acc[ai][bj][m][n] = __builtin_amdgcn_mfma_f32_16x16x32_bf16(Bt[n][k], At[m][k], acc[ai][bj][m][n], 0, 0, 0); } \
        else { acc[ai][bj][m][n] = __builtin_amdgcn_mfma_scale_f32_16x16x128_f8f6f4(cat8(Bt[n][0], Bt[n][1]), cat8(At[m][0], At[m][1]), acc[ai][bj][m][n], 0, 0, 0, 0x7f7f7f7f, 0, 0x7f7f7f7f); } } \
        __builtin_amdgcn_s_setprio(0); if constexpr (ES == 1) { PG8_PINACC(ai, bj); __builtin_amdgcn_sched_barrier(0); } } while (0)
#define PG8_WAIT_V(n) asm volatile("s_waitcnt vmcnt(" #n ")" ::: "memory")
#define PG8_WAIT_L(n) asm volatile("s_waitcnt lgkmcnt(" #n ")" ::: "memory")
#define PG8_BAR __builtin_amdgcn_s_barrier()
#define PG8_SCHED __builtin_amdgcn_sched_barrier(0)
    Unit cur, nxt; int ui = 0;
    if (!S.next(0, cur)) return;
    typename Epi::Pre pre; E.prefetch(pre, cur, wr, wc, fr, fq);
    typename Epi::Seed sd; E.seed_load(sd, cur, wr, wc, fr, fq);
    f32x4 acc[2][2][4][2]; E.seed_acc(acc, sd);
    bf16x8 At[4][2], B0[2][2], B1[2][2];
    unsigned cA = GATHER ? 0u : (unsigned)cur.pm * tstep, cB = (unsigned)cur.pn * tstep;
    if constexpr (GATHER) PG8_GLOAD(vAc, 0);
    S.a_ready(cur);
    if constexpr (SP2) {
        PG8_STAGE_R(PG8_SB(0, 0), rB, cB, voffB); PG8_STAGE_R(PG8_SB(0, 1), rB, cB + hstep, voffB); PG8_STAGE_A(0, 0, cA, vAc); PG8_STAGE_A(0, 1, cA, vAc);
        if (wr == 1) PG8_BAR;
        PG8_WAIT_V(2); PG8_BAR;
        PG8_STAGE_R(PG8_SB(1, 0), rB, cB + kstep, voffB); PG8_STAGE_A(1, 0, cA + kstep, vAc); PG8_STAGE_R(PG8_SB(1, 1), rB, cB + hstep + kstep, voffB);
        if constexpr (Epi::NST >= 0) PG8_WAIT_V(0); else PG8_WAIT_V(6);
        PG8_BAR;
    } else {
        PG8_STAGE_R(PG8_SB(0, 0), rB, cB, voffB); PG8_STAGE_A(0, 0, cA, vAc); PG8_STAGE_R(PG8_SB(0, 1), rB, cB + hstep, voffB); PG8_STAGE_A(0, 1, cA, vAc);
        if (wr == 1) PG8_BAR;
        PG8_WAIT_V(4); PG8_BAR;
        PG8_STAGE_R(PG8_SB(1, 0), rB, cB + kstep, voffB); PG8_STAGE_A(1, 0, cA + kstep, vAc); PG8_STAGE_R(PG8_SB(1, 1), rB, cB + hstep + kstep, voffB);
        PG8_WAIT_V(6); PG8_BAR;
    }
    for (;;) {
        const bool has_next = S.next(ui + 1, nxt);
        const unsigned nA = (has_next && !GATHER) ? (unsigned)nxt.pm * tstep : cA, nB = has_next ? (unsigned)nxt.pn * tstep : cB;
        if constexpr (GATHER) { if (has_next) PG8_GLOAD(vAn, ui + 1); else { _Pragma("unroll") for (int h_ = 0; h_ < 2; ++h_) _Pragma("unroll") for (int i_ = 0; i_ < 2; ++i_) vAn[h_][i_] = vAc[h_][i_]; } }
#define PG8_ITER_HEAD(t, LAST) \
            const bool last = (LAST); \
            if constexpr (GATHER) { _Pragma("unroll") for (int h_ = 0; h_ < 2; ++h_) _Pragma("unroll") for (int i_ = 0; i_ < 2; ++i_) vAs[h_][i_] = last ? vAn[h_][i_] : vAc[h_][i_]; } \
            const unsigned a1 = cA + (unsigned)((t) + 1) * kstep;                                             \
            const unsigned a2 = last ? nA : cA + (unsigned)((t) + 2) * kstep, b2 = last ? nB : cB + (unsigned)((t) + 2) * kstep;     \
            const unsigned a3 = a2 + kstep, b3 = b2 + kstep;                                \
            if (last && has_next) S.a_ready(nxt);
#define PG8_ITER_SP2(W01) \
            PG8_LDB(B0, 0, 0); PG8_LDB(B1, 0, 1); PG8_SCHED; PG8_LDA(At, 0, 0); PG8_STAGE_A(1, 1, a1, vAc); \
            W01; PG8_WAIT_L(0); PG8_BAR; PG8_MMA(0, 0, At, B0); PG8_MMA(0, 1, At, B1); PG8_BAR; PG8_SCHED; \
            PG8_LDA(At, 0, 1); PG8_STAGE_R(PG8_SB(0, 0), rB, b2, voffB); PG8_STAGE_R(PG8_SB(0, 1), rB, b2 + hstep, voffB); PG8_STAGE_A(0, 0, a2, vAs); \
            W01; PG8_WAIT_L(0); PG8_BAR; PG8_MMA(1, 0, At, B0); PG8_MMA(1, 1, At, B1); PG8_BAR; PG8_SCHED; \
            PG8_LDB(B0, 1, 0); PG8_LDB(B1, 1, 1); PG8_SCHED; PG8_LDA(At, 1, 0); PG8_STAGE_A(0, 1, a2, vAs); \
            PG8_WAIT_V(8); PG8_WAIT_L(0); PG8_BAR; PG8_MMA(0, 0, At, B0); PG8_MMA(0, 1, At, B1); PG8_BAR; PG8_SCHED; \
            PG8_LDA(At, 1, 1); PG8_STAGE_R(PG8_SB(1, 0), rB, b3, voffB); PG8_STAGE_R(PG8_SB(1, 1), rB, b3 + hstep, voffB); PG8_STAGE_A(1, 0, a3, vAs); \
            PG8_WAIT_V(8); PG8_WAIT_L(0); PG8_BAR; PG8_MMA(1, 0, At, B0); PG8_MMA(1, 1, At, B1); PG8_BAR; PG8_SCHED;
        if constexpr (SP2 && Epi::NST >= 0) {
            { PG8_ITER_HEAD(0, false) PG8_ITER_SP2(asm volatile("s_waitcnt vmcnt(%0)" :: "n"(8 + Epi::NST) : "memory")) }
            for (int t = 2; t < nt; t += 2) { PG8_ITER_HEAD(t, t == nt - 2) PG8_ITER_SP2(PG8_WAIT_V(8)) }
        } else if constexpr (SP2) {
            for (int t = 0; t < nt; t += 2) { PG8_ITER_HEAD(t, t == nt - 2) PG8_ITER_SP2(PG8_WAIT_V(8)) }
        } else {
            for (int t = 0; t < nt; t += 2) { PG8_ITER_HEAD(t, t == nt - 2)
            PG8_LDB(B0, 0, 0); PG8_SCHED; PG8_LDA(At, 0, 0); PG8_STAGE_A(1, 1, a1, vAc);
            PG8_WAIT_L(8); PG8_BAR; PG8_WAIT_L(0); PG8_MMA(0, 0, At, B0); PG8_BAR; PG8_SCHED;
            PG8_LDB(B1, 0, 1); PG8_STAGE_R(PG8_SB(0, 0), rB, b2, voffB);
            PG8_BAR; PG8_WAIT_L(0); PG8_MMA(0, 1, At, B1); PG8_BAR;
            PG8_LDA(At, 0, 1); PG8_STAGE_A(0, 0, a2, vAs);
            PG8_BAR; PG8_WAIT_L(0); PG8_MMA(1, 0, At, B0); PG8_BAR; PG8_SCHED;
            PG8_STAGE_R(PG8_SB(0, 1), rB, b2 + hstep, voffB);
            PG8_WAIT_V(6); PG8_BAR; PG8_MMA(1, 1, At, B1); PG8_BAR;
            PG8_LDB(B0, 1, 0); PG8_SCHED; PG8_LDA(At, 1, 0); PG8_STAGE_A(0, 1, a2, vAs);
            PG8_WAIT_L(8); PG8_BAR; PG8_WAIT_L(0); PG8_MMA(0, 0, At, B0); PG8_BAR; PG8_SCHED;
            PG8_LDB(B1, 1, 1); PG8_STAGE_R(PG8_SB(1, 0), rB, b3, voffB);
            PG8_BAR; PG8_WAIT_L(0); PG8_MMA(0, 1, At, B1); PG8_BAR;
            PG8_LDA(At, 1, 1); PG8_STAGE_A(1, 0, a3, vAs);
            PG8_BAR; PG8_WAIT_L(0); PG8_MMA(1, 0, At, B0); PG8_BAR; PG8_SCHED;
            PG8_STAGE_R(PG8_SB(1, 1), rB, b3 + hstep, voffB);
            PG8_WAIT_V(6); PG8_BAR; PG8_MMA(1, 1, At, B1); PG8_BAR;
            }
        }
#undef PG8_ITER_HEAD
#undef PG8_ITER_SP2
        if constexpr (ALIGN_EPI) { if (wr == 0) PG8_BAR; }
        if (has_next) E.seed_load(sd, nxt, wr, wc, fr, fq);
        if constexpr (!Epi::AFTER_DRAIN) { E(acc, cur, wr, wc, fr, fq, pre); S.done(cur); }
        if (!has_next) break;
        E.seed_acc(acc, sd);
        cur = nxt; cA = nA; cB = nB; ++ui;
        if constexpr (GATHER) { _Pragma("unroll") for (int h_ = 0; h_ < 2; ++h_) _Pragma("unroll") for (int i_ = 0; i_ < 2; ++i_) vAc[h_][i_] = vAn[h_][i_]; }
        E.prefetch(pre, cur, wr, wc, fr, fq);
        if constexpr (ALIGN_EPI) { if (wr == 1) PG8_BAR; }
    }
    PG8_WAIT_V(0);
    if constexpr (!ALIGN_EPI) { if (wr == 0) PG8_BAR; }
    PG8_BAR;
#undef PG8_SA
#undef PG8_SB
#undef PG8_STAGE_R
#undef PG8_STAGE_A
#undef PG8_GLOAD
#undef PG8_LDA
#undef PG8_LDB
#undef PG8_MMA
#undef PG8_PIN12
#undef PG8_PINACC
#undef PG8_WAIT_V
#undef PG8_WAIT_L
#undef PG8_BAR
#undef PG8_SCHED
}
}


constexpr size_t MiB = 1u << 20;
constexpr size_t WS_CTL = 0, CTL_ZERO_BYTES = 1 * MiB;
constexpr size_t WS_STATS0 = 1 * MiB, WS_COS = 2 * MiB, WS_SIN = 6 * MiB;
constexpr size_t WS_WINT = 10 * MiB, WS_WOT = 17 * MiB, WS_W1T = 20 * MiB, WS_W2T = 148 * MiB;
constexpr size_t WS_H0B = 212 * MiB, WS_MIXED = 534 * MiB;
constexpr size_t WS_PROJ = 276 * MiB;
constexpr size_t WS_ST = 470 * MiB, WS_DEC = 598 * MiB;
constexpr size_t WS_PRE1 = 212 * MiB;
constexpr size_t WS_AGG = 599 * MiB, WS_SINS = 615 * MiB, WS_DAGG = 631 * MiB;
constexpr size_t WS_H1B = 599 * MiB, WS_LIST = 663 * MiB, WS_GATES = 667 * MiB;
constexpr size_t WS_XS = 276 * MiB, WS_SLOTG = 668 * MiB, WS_ACT = 672 * MiB, WS_Y = 276 * MiB, WS_END = 940 * MiB;
constexpr size_t PJ_GQ = 0, PJ_GK = 16 * MiB, PJ_GV = 32 * MiB, PJ_GG = 64 * MiB, PJ_RQ = 96 * MiB, PJ_RK = 112 * MiB, PJ_RV = 128 * MiB, PJ_RG = 160 * MiB, PJ_GLR = 192 * MiB;
constexpr int CW_TMO = 0, CW_CODE = 1, CW_COUNTS = 64, CW_BAR = 4096;
constexpr int RING_OFF = 0, RING_BYTES = 131072;
constexpr int LDSCTL_OFF = RING_BYTES, MISC_OFF = LDSCTL_OFF + 320;
constexpr int X_TSTART = LDSCTL_OFF + 512, X_CNT = LDSCTL_OFF + 768, X_LCNT = LDSCTL_OFF + 1024, X_LBASE = LDSCTL_OFF + 1280, X_NASG = LDSCTL_OFF + 1536, X_ASG = LDSCTL_OFF + 2048;
constexpr int X_GTAB = LDSCTL_OFF + 8192, GT_MAXU = 17;
constexpr int LDS_BYTES = 157696;
constexpr int NWAVES = 8;
constexpr int NPH = 11;
#define GAS __attribute__((address_space(1)))
#define LAS __attribute__((address_space(3)))
typedef unsigned short bf16;
typedef unsigned v4u __attribute__((ext_vector_type(4)));
typedef float f32x4 __attribute__((ext_vector_type(4)));
typedef short bf16x8 __attribute__((ext_vector_type(8)));
typedef GAS unsigned gu32;
typedef GAS unsigned long long gu64;
#define RLX_AGENT __ATOMIC_RELAXED, __HIP_MEMORY_SCOPE_AGENT
#define LDS_WAIT() asm volatile("s_waitcnt lgkmcnt(0)" ::: "memory")
#define VM_WAIT() asm volatile("s_waitcnt vmcnt(0)" ::: "memory")
__device__ __forceinline__ unsigned long long rt() { return __builtin_amdgcn_s_memrealtime(); }
typedef __bf16 hwbf16x2 __attribute__((ext_vector_type(2)));
typedef float f32x2_t __attribute__((ext_vector_type(2)));
__device__ __forceinline__ unsigned pk2(float lo, float hi) { return __builtin_bit_cast(unsigned, __builtin_convertvector((f32x2_t){lo, hi}, hwbf16x2)); }
__device__ __forceinline__ unsigned f2bf(float f) { return pk2(f, 0.f) & 0xffffu; }

#define XB_TMO      128
#define XB_XCNT(j)  (256  + 64 * (j))
#define XB_XSUB(j)  (1280 + 64 * (j))
#define XB_XGEN(j)  (2304 + 64 * (j))
#define XB_TOP      3328
#define XB_TOPGEN   3392
#define XCD_BAR_WORDS 3456
#define XB_SPIN_CAP (1u << 18)

__device__ __forceinline__ unsigned xb_ld(unsigned* p)              { return __hip_atomic_load(p, __ATOMIC_RELAXED, __HIP_MEMORY_SCOPE_AGENT); }
__device__ __forceinline__ unsigned xb_add(unsigned* p, unsigned v) { return __hip_atomic_fetch_add(p, v, __ATOMIC_RELAXED, __HIP_MEMORY_SCOPE_AGENT); }
__device__ __forceinline__ unsigned xb_xcc_id() { return (unsigned)__builtin_amdgcn_s_getreg((3 << 11) | 20) & 0xFu; }
#define XB_SPIN(cond, bar) do { unsigned _sp = 0; while (cond) { __builtin_amdgcn_s_sleep(1); \
    if ((++_sp & 255u) == 0u) { if (xb_ld(&(bar)[XB_TMO])) break; if (_sp > XB_SPIN_CAP) { atomicAdd(&(bar)[XB_TMO], 1u); break; } } } } while (0)

struct XcdBarrier {
    unsigned* bar; unsigned x;
    volatile LAS unsigned* st;
};

__device__ __forceinline__ XcdBarrier xcd_barrier_post(unsigned* bar, volatile LAS unsigned* st) {
    XcdBarrier b; b.bar = bar; b.x = xb_xcc_id(); b.st = st;
    if (threadIdx.x == 0) (void)xb_add(&bar[XB_XCNT(b.x)], 1u);
    return b;
}
__device__ __forceinline__ void xcd_barrier_complete(unsigned* bar, unsigned x, unsigned& nloc, unsigned& nx) {
    const unsigned G = gridDim.x * gridDim.y * gridDim.z;
    unsigned sum, cnt, mine, sp = 0u;
    for (;;) {
        sum = 0u; cnt = 0u; mine = 0u;
#pragma unroll
        for (unsigned j = 0; j < 16; ++j) { const unsigned c = xb_ld(&bar[XB_XCNT(j)]); sum += c; cnt += (c > 0u) ? 1u : 0u; mine = (j == x) ? c : mine; }
        if (sum == G) break;
        __builtin_amdgcn_s_sleep(1);
        if ((++sp & 255u) == 0u) { if (xb_ld(&bar[XB_TMO])) break; if (sp > XB_SPIN_CAP) { atomicAdd(&bar[XB_TMO], 1u); break; } }
    }
    nloc = mine > 0u ? mine : 1u; nx = cnt > 0u ? cnt : 1u;
}

__device__ __forceinline__ void xcd_barrier_open() {
    asm volatile("s_waitcnt vmcnt(0)" ::: "memory");
    __syncthreads();
}
__device__ __forceinline__ void xcd_barrier_protocol(const XcdBarrier& b) {
    if (threadIdx.x == 0) {
        unsigned* bar = b.bar;
        __builtin_amdgcn_s_waitcnt(0);
        unsigned nloc = b.st[0], nx = b.st[1];
        if (nloc == 0u) { xcd_barrier_complete(bar, b.x, nloc, nx); b.st[0] = nloc; b.st[1] = nx; }
        const unsigned old = xb_add(&bar[XB_XSUB(b.x)], 1u);
        const unsigned gen = old / nloc;
        if (old + 1u == (gen + 1u) * nloc) {
            __builtin_amdgcn_fence(__ATOMIC_RELEASE, "agent");
            asm volatile("s_waitcnt vmcnt(0)" ::: "memory");
            const unsigned og = xb_add(&bar[XB_TOP], 1u);
            const unsigned tg = og / nx;
            if (og + 1u == (tg + 1u) * nx) xb_add(&bar[XB_TOPGEN], 1u);
            else XB_SPIN(xb_ld(&bar[XB_TOPGEN]) == tg, bar);
            __builtin_amdgcn_fence(__ATOMIC_ACQUIRE, "agent");
            xb_add(&bar[XB_XGEN(b.x)], 1u);
            asm volatile("s_waitcnt vmcnt(0)" ::: "memory");
        } else {
            XB_SPIN(xb_ld(&bar[XB_XGEN(b.x)]) == gen, bar);
            __builtin_amdgcn_fence(__ATOMIC_ACQUIRE, "agent");
            asm volatile("s_waitcnt vmcnt(0)" ::: "memory");
        }
    }
}
__device__ __forceinline__ void xcd_barrier(const XcdBarrier& b) { xcd_barrier_open(); xcd_barrier_protocol(b); __syncthreads(); }
#define XCD_BARRIER_WITH(b, wave, WORK) do { xcd_barrier_open(); \
        _Pragma("nounroll") for (int pass_ = 0; pass_ < 2; ++pass_) { if (((wave) == 0) == (pass_ == 1)) { WORK; } if (pass_ == 0) xcd_barrier_protocol(b); } \
        __syncthreads(); } while (0)

struct Frame {
    LAS unsigned char* lds;
    volatile LAS unsigned* MISC;
    gu32* ctl;
    int tid, lane, wave, vcu, G;
    const float *x; const int* positions; const float *ln_in_g, *ln_in_b, *w_in, *gate_w, *gate_b, *gla_g, *ret_g, *ret_b, *w_out, *ln1_g, *ln1_b, *router_w, *router_b, *w1, *b1, *w2, *b2, *ln2_g, *ln2_b;
    float* out;
    float *stats0, *cosT, *sinT, *ST, *DEC, *PRE1, *GLR, *gates, *AGG, *DAGG; bf16* SIN;
    bf16 *WinT, *WoT, *W1T, *W2T, *H0B, *MIXED, *GQ, *GK, *GV, *GG, *RQ, *RK, *RV, *RG, *H1B, *XS, *ACT, *Y;
    int* list; unsigned* counts; float* slotg; int* tkslot;
};
template <int CTRL> __device__ __forceinline__ float dppf(float v) { return __builtin_bit_cast(float, __builtin_amdgcn_update_dpp(0, __builtin_bit_cast(int, v), CTRL, 0xF, 0xF, true)); }
template <int CTRL> __device__ __forceinline__ int dppi(int v) { return __builtin_amdgcn_update_dpp(0, v, CTRL, 0xF, 0xF, true); }
__device__ __forceinline__ float wave_sum(float v) {
    v += dppf<0xB1>(v); v += dppf<0x4E>(v); v += dppf<0x141>(v); v += dppf<0x140>(v);
    const float s0 = __builtin_bit_cast(float, __builtin_amdgcn_readlane(__builtin_bit_cast(int, v), 0)), s1 = __builtin_bit_cast(float, __builtin_amdgcn_readlane(__builtin_bit_cast(int, v), 16));
    const float s2 = __builtin_bit_cast(float, __builtin_amdgcn_readlane(__builtin_bit_cast(int, v), 32)), s3 = __builtin_bit_cast(float, __builtin_amdgcn_readlane(__builtin_bit_cast(int, v), 48));
    return (s0 + s1) + (s2 + s3);
}
__device__ __forceinline__ float bf2f(unsigned h) { return __builtin_bit_cast(float, h << 16); }

struct WinMap { __device__ __forceinline__ int operator()(int n) const {
    if (n < 1536) return n;
    if (n < 1552) return -1;
    if (n < 2064) { const int q = n < 1808 ? 0 : 1, l = n - (q ? 1808 : 1552); return 1536 + 256 * q + ((l >> 5) & 1) * 128 + (l >> 6) * 32 + (l & 31); }
    if (n < 2576) return 2048 + (n - 2064);
    return 2560 + (n - 2576); } };
struct IdMap { int off; __device__ __forceinline__ int operator()(int n) const { return off + n; } };
struct W1Map { int off; __device__ __forceinline__ int operator()(int n) const { const int l = n & 1023; return off + (l >> 7) * 256 + (n >> 10) * 128 + (l & 127); } };
template <bool FP8, class RowMap>
__device__ __forceinline__ void p0_transpose_item(const float* W, int K, int N, bf16* WT, const RowMap rm, int item, int lane) {
    const int nblk = (N + 31) / 32, kb = item / nblk, nb = item % nblk, k0 = 128 * kb, n0 = 32 * nb;
    const int q = lane & 7, n4 = n0 + 4 * (lane >> 3);
    f32x4 a[16];
    if (n4 < N) {
#pragma unroll
        for (int i = 0; i < 16; ++i) a[i] = __builtin_nontemporal_load((const GAS f32x4*)(W + (size_t)(k0 + 16 * q + i) * N + n4)); }
    else {
#pragma unroll
        for (int i = 0; i < 16; ++i) a[i] = (f32x4){0.f, 0.f, 0.f, 0.f}; }
#pragma unroll
    for (int c = 0; c < 4; ++c) { const int n = n4 + c; const int row = (n < N) ? rm(n) : -1;
        if (row >= 0) {
            if constexpr (FP8) { v4u w;
                w.x = pk4_fp8(a[0][c] * QS_W, a[1][c] * QS_W, a[2][c] * QS_W, a[3][c] * QS_W); w.y = pk4_fp8(a[4][c] * QS_W, a[5][c] * QS_W, a[6][c] * QS_W, a[7][c] * QS_W);
                w.z = pk4_fp8(a[8][c] * QS_W, a[9][c] * QS_W, a[10][c] * QS_W, a[11][c] * QS_W); w.w = pk4_fp8(a[12][c] * QS_W, a[13][c] * QS_W, a[14][c] * QS_W, a[15][c] * QS_W);
                *(GAS v4u*)((GAS unsigned char*)WT + (size_t)row * K + k0 + 16 * q) = w; }
            else { GAS v4u* dst = (GAS v4u*)(WT + (size_t)row * K + k0 + 16 * q);
                dst[0] = (v4u){pk2(a[0][c], a[1][c]), pk2(a[2][c], a[3][c]), pk2(a[4][c], a[5][c]), pk2(a[6][c], a[7][c])};
                dst[1] = (v4u){pk2(a[8][c], a[9][c]), pk2(a[10][c], a[11][c]), pk2(a[12][c], a[13][c]), pk2(a[14][c], a[15][c])}; } } }
}
__device__ __forceinline__ void p0_prologue(Frame& F) {
    const int gw = F.vcu * NWAVES + F.wave, NGW = F.G * NWAVES;
    constexpr int I_IN = (D / 128) * ((PW + 31) / 32), I_OUT = (D / 128) * (D / 32), I_1 = (D / 128) * (2 * DFF / 32), I_2 = (DFF / 128) * (D / 32);
    constexpr int NITEMS = I_IN + I_OUT + NE * (I_1 + I_2);
    for (int it = gw; it < NITEMS; it += NGW) {
        int r = it;
        if (r < I_IN) { p0_transpose_item<false>(F.w_in, D, PW, F.WinT, WinMap{}, r, F.lane); continue; } r -= I_IN;
        if (r < I_OUT) { p0_transpose_item<true>(F.w_out, D, D, F.WoT, IdMap{0}, r, F.lane); continue; } r -= I_OUT;
        if (r < NE * I_1) { const int e = r / I_1; p0_transpose_item<true>(F.w1 + (size_t)e * D * 2 * DFF, D, 2 * DFF, F.W1T, W1Map{e * 2 * DFF}, r % I_1, F.lane); continue; } r -= NE * I_1;
        { const int e = r / I_2; p0_transpose_item<true>(F.w2 + (size_t)e * DFF * D, DFF, D, F.W2T, IdMap{e * D}, r % I_2, F.lane); }
    }
    __syncthreads();
    { LAS float* WG = (LAS float*)(F.lds + RING_OFF);
        for (int idx = F.tid; idx < D * 4; idx += 512) { const int c = idx >> 2, ch = idx & 3; *(LAS f32x4*)(WG + c * 20 + ((ch + ((c >> 4) & 3)) & 3) * 4) = *(const GAS f32x4*)(F.w_in + (size_t)c * PW + 1536 + 4 * ch); } }
    __syncthreads();
    { f32x4 g4[4], b4[4];
#pragma unroll
        for (int j = 0; j < 4; ++j) { g4[j] = *((const GAS f32x4*)F.ln_in_g + F.lane + 64 * j); b4[j] = *((const GAS f32x4*)F.ln_in_b + F.lane + 64 * j); }
        f32x4 nx[4], nx2[4]; int m = gw;
        if (m < M) {
#pragma unroll
            for (int j = 0; j < 4; ++j) nx[j] = __builtin_nontemporal_load((const GAS f32x4*)(F.x + (size_t)m * D) + F.lane + 64 * j); }
        if (m + NGW < M) {
#pragma unroll
            for (int j = 0; j < 4; ++j) nx2[j] = __builtin_nontemporal_load((const GAS f32x4*)(F.x + (size_t)(m + NGW) * D) + F.lane + 64 * j); }
        for (; m < M; m += NGW) {
            f32x4 v[4]; float s = 0.f;
#pragma unroll
            for (int j = 0; j < 4; ++j) { v[j] = nx[j]; nx[j] = nx2[j]; s += (v[j].x + v[j].y) + (v[j].z + v[j].w); }
            if (m + 2 * NGW < M) {
#pragma unroll
                for (int j = 0; j < 4; ++j) nx2[j] = __builtin_nontemporal_load((const GAS f32x4*)(F.x + (size_t)(m + 2 * NGW) * D) + F.lane + 64 * j); }
            const float mean = wave_sum(s) * (1.f / D); float s2 = 0.f;
#pragma unroll
            for (int j = 0; j < 4; ++j) { v[j] = v[j] - mean; s2 += (v[j].x * v[j].x + v[j].y * v[j].y) + (v[j].z * v[j].z + v[j].w * v[j].w); }
            const float rstd = 1.f / sqrtf(wave_sum(s2) * (1.f / D) + LN_EPS);
            if (F.lane == 0) { F.stats0[2 * m] = mean; F.stats0[2 * m + 1] = rstd; }
            GAS unsigned long long* o8 = (GAS unsigned long long*)(F.H0B + (size_t)m * D) + F.lane;
#pragma unroll
            for (int j = 0; j < 4; ++j) { const f32x4 h = v[j] * rstd * g4[j] + b4[j]; v[j] = h;
                o8[64 * j] = (unsigned long long)pk2(h.x, h.y) | ((unsigned long long)pk2(h.z, h.w) << 32); }
            { const LAS float* WG = (const LAS float*)(F.lds + RING_OFF); float acc[16];
#pragma unroll
                for (int r = 0; r < 16; ++r) acc[r] = 0.f;
#pragma unroll
                for (int ci = 0; ci < 16; ++ci) { const int c = 4 * F.lane + 256 * (ci >> 2) + (ci & 3); const float hv = v[ci >> 2][ci & 3]; f32x4 wc[4];
#pragma unroll
                    for (int ch = 0; ch < 4; ++ch) wc[ch] = *(const LAS f32x4*)(WG + c * 20 + ((ch + ((c >> 4) & 3)) & 3) * 4);
#pragma unroll
                    for (int ch = 0; ch < 4; ++ch)
#pragma unroll
                        for (int x = 0; x < 4; ++x) acc[4 * ch + x] += hv * wc[ch][x];
                    if ((ci & 3) == 3) asm volatile("" ::: "memory"); }
                float red[8];
#pragma unroll
                for (int e = 0; e < 8; ++e) { float pa = acc[e], pb = acc[e + 8]; asm volatile("v_nop\n\tv_nop\n\tv_permlane32_swap_b32 %0, %1" : "+v"(pa), "+v"(pb)); red[e] = pa + pb; }
#define P0_SEL(MSK, A, B) __builtin_bit_cast(float, (__builtin_bit_cast(unsigned, (A)) & (MSK)) | (__builtin_bit_cast(unsigned, (B)) & ~(MSK)))
                { const unsigned hm = (F.lane & 16) ? 0xffffffffu : 0u; float snd[4], rcv[4];
#pragma unroll
                    for (int e = 0; e < 4; ++e) snd[e] = P0_SEL(hm, red[e], red[e + 4]);
#pragma unroll
                    for (int e = 0; e < 4; ++e) rcv[e] = __shfl_xor(snd[e], 16);
#pragma unroll
                    for (int e = 0; e < 4; ++e) red[e] = P0_SEL(hm, red[e + 4], red[e]) + rcv[e]; }
                { const unsigned hm = (F.lane & 8) ? 0xffffffffu : 0u;
#pragma unroll
                    for (int e = 0; e < 2; ++e) { const float keep = P0_SEL(hm, red[e + 2], red[e]), snd = P0_SEL(hm, red[e], red[e + 2]); red[e] = keep + dppf<0x128>(snd); } }
                { const unsigned hm = (F.lane & 4) ? 0xffffffffu : 0u; const float keep = P0_SEL(hm, red[1], red[0]), snd = P0_SEL(hm, red[0], red[1]); red[0] = keep + dppf<0x141>(snd); }
#undef P0_SEL
                red[0] += dppf<0x4E>(red[0]); red[0] += dppf<0xB1>(red[0]);
                if ((F.lane & 3) == 0) F.GLR[(size_t)m * 16 + ((F.lane >> 5) * 8 + ((F.lane >> 4) & 1) * 4 + ((F.lane >> 3) & 1) * 2 + ((F.lane >> 2) & 1))] = red[0]; }
        } }
    const double inv_freq = pow(10000.0, -(double)(F.tid & 31) / 31.0);
    for (int idx = F.vcu * 512 + F.tid; idx < M * 32; idx += F.G * 512) { const int t = idx >> 5;
        const double rev = (double)F.positions[t] * inv_freq * 0.15915494309189535;
        const float fr = (float)(rev - floor(rev));
        F.cosT[idx] = __builtin_amdgcn_cosf(fr); F.sinT[idx] = __builtin_amdgcn_sinf(fr); }
}

constexpr int MS = 72;
constexpr int MX_QE = 0, MX_QN = 9216, MX_KE = 18432, MX_KN = 27648, MX_VT = 36864, MX_PT = 55296, MX_B = 73728, MX_RED = 90368, MX_GW = 91392, MX_P = 95744;
constexpr int MX_NP = MX_P + 64 * 132 * 4;
constexpr int MX_OUT = MX_P, OUTS = 132;
static_assert(MX_GW + 4096 + 256 <= MX_P && MX_OUT + 64 * OUTS * 4 <= MX_NP && MX_NP + 3 * 128 * 4 <= RING_BYTES, "mixer LDS");
constexpr float LOG2E = 1.4426950408889634f, LN2 = 0.6931471805599453f;
__device__ __forceinline__ float log2_gamma(int h) { return log2f(1.0f - exp2f(-5.0f - (float)h)); }
__device__ __forceinline__ float fexp2(float x) { return __builtin_amdgcn_exp2f(x); }
__device__ __forceinline__ float bflo(unsigned w) { return __builtin_bit_cast(float, w << 16); }
__device__ __forceinline__ float bfhi(unsigned w) { return __builtin_bit_cast(float, w & 0xffff0000u); }
__device__ __forceinline__ int tsw(int row, int j) { return row * MS + ((((j >> 3) ^ (row >> 3)) & 7) << 3) + (j & 7); }
struct MixItem { int b, h, h8, c, item; bool gla; size_t t0; };
__device__ __forceinline__ MixItem mix_item(int vb, int k) {
    MixItem m; m.b = vb >> 6; m.h = (vb >> 4) & 3; m.c = (vb & 15) * 8 + (k >> 1); m.gla = (k & 1) == 0; m.h8 = m.gla ? m.h : 4 + m.h;
    m.item = ((m.b * 8 + m.h8) << 7) + m.c; m.t0 = (size_t)m.b * SEQ + (size_t)m.c * CH; return m; }
__device__ __forceinline__ void mixer_stage_gate(Frame& F, int h) {
    LAS float* GW = (LAS float*)(F.lds + MX_GW);
    for (int i = F.tid; i < 1024; i += 512) { const int d = i >> 4, r = i & 15; GW[d * 16 + r] = F.gate_w[r * 256 + h * 64 + d]; }
    if (F.tid < 64) GW[1024 + F.tid] = F.gate_b[h * 64 + F.tid];
}
__device__ __forceinline__ void mixer_bcum(Frame& F, const f32x4 (&g)[4]) {
    LAS float* B = (LAS float*)(F.lds + MX_B); const LAS float* GW = (const LAS float*)(F.lds + MX_GW);
#pragma unroll
    for (int dd = 0; dd < 8; ++dd) { const int d = F.wave * 8 + dd; const LAS f32x4* w = (const LAS f32x4*)(GW + d * 16);
        const f32x4 w0 = w[0], w1 = w[1], w2 = w[2], w3 = w[3];
        float z = GW[1024 + d];
        z += (g[0][0] * w0[0] + g[0][1] * w0[1]) + (g[0][2] * w0[2] + g[0][3] * w0[3]);
        z += (g[1][0] * w1[0] + g[1][1] * w1[1]) + (g[1][2] * w1[2] + g[1][3] * w1[3]);
        z += (g[2][0] * w2[0] + g[2][1] * w2[1]) + (g[2][2] * w2[2] + g[2][3] * w2[3]);
        z += (g[3][0] * w3[0] + g[3][1] * w3[1]) + (g[3][2] * w3[2] + g[3][3] * w3[3]);
        float la = (fminf(z, 0.f) * LOG2E - __builtin_amdgcn_logf(1.0f + fexp2(-fabsf(z) * LOG2E))) * (1.0f / 16.0f);
        la += dppf<0x111>(la); la += dppf<0x112>(la); la += dppf<0x114>(la); la += dppf<0x118>(la);
        la += __builtin_bit_cast(float, __builtin_amdgcn_update_dpp(0, __builtin_bit_cast(int, la), 0x142, 0xA, 0xF, false));
        la += __builtin_bit_cast(float, __builtin_amdgcn_update_dpp(0, __builtin_bit_cast(int, la), 0x143, 0xC, 0xF, false));
        B[F.lane * 65 + d] = la; }
}
struct MixKvRegs { v4u k8, v8[2]; f32x4 g[4]; };
__device__ __forceinline__ void mixer_kv_load(Frame& F, const MixItem& m, MixKvRegs& R) {
    const bf16* K = m.gla ? F.GK : F.RK; const bf16* V = m.gla ? F.GV : F.RV;
    const int jq = F.tid >> 3, dq = (F.tid & 7) * 8;
    R.k8 = *(const GAS v4u*)(K + (m.t0 + jq) * 256 + m.h * 64 + dq);
#pragma unroll
    for (int i = 0; i < 2; ++i) { const int p = F.tid + 512 * i; R.v8[i] = *(const GAS v4u*)(V + (m.t0 + (p >> 4)) * 512 + m.h * 128 + (p & 15) * 8); }
    if (m.gla) { const GAS f32x4* gr = (const GAS f32x4*)(F.GLR + (m.t0 + F.lane) * 16); R.g[0] = gr[0]; R.g[1] = gr[1]; R.g[2] = gr[2]; R.g[3] = gr[3]; }
}
__device__ __forceinline__ void mixer_vt_write(Frame& F, const v4u (&v8)[2]) {
    LAS bf16* VT = (LAS bf16*)(F.lds + MX_VT);
#pragma unroll
    for (int i = 0; i < 2; ++i) { const int p = F.tid + 512 * i, jv = p >> 4, ev = (p & 15) * 8;
#pragma unroll
        for (int x = 0; x < 8; ++x) { const unsigned wv = (x < 2 ? v8[i].x : x < 4 ? v8[i].y : x < 6 ? v8[i].z : v8[i].w); VT[tsw(ev + x, jv)] = (bf16)((x & 1) ? (wv >> 16) : (wv & 0xffffu)); } }
}
#define KV_ITEM(K, GLA, ACC) do { const MixItem m = mix_item(vb, (K)); \
        if (GLA) mixer_bcum(F, R.g); \
        const v4u k8 = R.k8, va = R.v8[0], vbv = R.v8[1]; \
        __syncthreads();                                                      \
        { const int jq = F.tid >> 3, dq = (F.tid & 7) * 8; \
          _Pragma("unroll") for (int x = 0; x < 8; ++x) { const int d = dq + x; const unsigned wk = (x < 2 ? k8.x : x < 4 ? k8.y : x < 6 ? k8.z : k8.w); const float kf = (x & 1) ? bfhi(wk) : bflo(wk); \
              const float sc = (GLA) ? fexp2(B[63 * 65 + d] - B[jq * 65 + d]) : fexp2((float)(63 - jq) * l2g); \
              KL[tsw(d, jq)] = (bf16)f2bf(kf * sc); } } \
        { const v4u vv[2] = {va, vbv}; mixer_vt_write(F, vv); } \
        float dec4[4]; \
        _Pragma("unroll") for (int t = 0; t < 4; ++t) dec4[t] = (GLA) ? fexp2(B[63 * 65 + 16 * t + fr]) : g64; \
        if ((GLA) && F.tid < 64) { F.DEC[(size_t)m.item * 64 + F.tid] = cdG; cdG *= fexp2(B[63 * 65 + F.tid]); }     \
        if ((K) < 15) mixer_kv_load(F, mix_item(vb, (K) + 1), R);            \
        _Pragma("unroll") for (int t = 0; t < 4; ++t) _Pragma("unroll") for (int r = 0; r < 4; ++r) OT[(16 * F.wave + 4 * fq + r) * MS + 16 * t + fr] = (bf16)f2bf(ACC[t][r]);     \
        __syncthreads(); \
        { bf16* st = (bf16*)F.ST + (size_t)m.item * 8192; \
          _Pragma("unroll") for (int i = 0; i < 2; ++i) { const int idx = F.tid + 512 * i, e = idx >> 3, d = (idx & 7) * 8; *(GAS v4u*)(st + e * 64 + d) = *(const LAS v4u*)(OT + e * MS + d); } } \
        _Pragma("unroll") for (int t = 0; t < 4; ++t) ACC[t] = ACC[t] * dec4[t]; \
        _Pragma("unroll") for (int ks = 0; ks < 2; ++ks) { const bf16x8 aV = *(const LAS bf16x8*)(VT + tsw(16 * F.wave + fr, 32 * ks + 8 * fq)); \
            _Pragma("unroll") for (int t = 0; t < 4; ++t) { const bf16x8 bK = *(const LAS bf16x8*)(KL + tsw(16 * t + fr, 32 * ks + 8 * fq)); ACC[t] = __builtin_amdgcn_mfma_f32_16x16x32_bf16(aV, bK, ACC[t], 0, 0, 0); } } \
    } while (0)
__device__ __forceinline__ void mixer_kv_phase(Frame& F) {
    const int fr = F.lane & 15, fq = F.lane >> 4;
    LAS float* B = (LAS float*)(F.lds + MX_B); LAS bf16* KL = (LAS bf16*)(F.lds + MX_KE); LAS bf16* VT = (LAS bf16*)(F.lds + MX_VT); LAS bf16* OT = (LAS bf16*)(F.lds + MX_PT);
    for (int vb = F.vcu; vb < 256; vb += F.G) {
        __syncthreads();
        const int h = (vb >> 4) & 3; const float l2g = log2_gamma(h), g64 = fexp2(64.0f * l2g);
        mixer_stage_gate(F, h);
        MixKvRegs R; mixer_kv_load(F, mix_item(vb, 0), R);
        f32x4 accG[4], accR[4]; float cdG = 1.0f;
#pragma unroll
        for (int t = 0; t < 4; ++t) { accG[t] = (f32x4){0.f, 0.f, 0.f, 0.f}; accR[t] = (f32x4){0.f, 0.f, 0.f, 0.f}; }
        __syncthreads();
        for (int kk = 0; kk < 8; ++kk) { KV_ITEM(2 * kk, true, accG); KV_ITEM(2 * kk + 1, false, accR); }
        { const int b = vb >> 6, cg = vb & 15; const size_t gG = (size_t)((b * 8 + h) * 16 + cg), gR = (size_t)((b * 8 + 4 + h) * 16 + cg);
#pragma unroll
            for (int t = 0; t < 4; ++t)
#pragma unroll
                for (int r = 0; r < 4; ++r) { const int o = (16 * F.wave + 4 * fq + r) * 64 + 16 * t + fr; F.AGG[gG * 8192 + o] = accG[t][r]; F.AGG[gR * 8192 + o] = accR[t][r]; }
            if (F.tid < 64) { F.DAGG[gG * 64 + F.tid] = cdG; F.DAGG[gR * 64 + F.tid] = fexp2(512.0f * l2g); } }
    }
}
#undef KV_ITEM
__device__ __forceinline__ void mixer_scan(Frame& F) {
    for (int idx = F.vcu * 512 + F.tid; idx < NB * 8 * 4096; idx += F.G * 512) {
        const int bh = idx >> 12, ed = (idx & 4095) * 2, d = ed & 63; float s0 = 0.f, s1 = 0.f;
        f32x2_t a[16], dg[16];
#pragma unroll
        for (int g = 0; g < 16; ++g) { a[g] = *(const GAS f32x2_t*)(F.AGG + (size_t)(bh * 16 + g) * 8192 + ed); dg[g] = *(const GAS f32x2_t*)(F.DAGG + (size_t)(bh * 16 + g) * 64 + d); }
#pragma unroll
        for (int g = 0; g < 16; ++g) { *(GAS unsigned*)(F.SIN + (size_t)(bh * 16 + g) * 8192 + ed) = pk2(s0, s1); s0 = s0 * dg[g][0] + a[g][0]; s1 = s1 * dg[g][1] + a[g][1]; }
    }
}
struct MixOutRegs { v4u q8, k8, v8[2], p8[2], gt[2]; f32x4 g[4]; f32x4 cd[2]; };
__device__ __forceinline__ void mixer_out_load(Frame& F, const MixItem& m, MixOutRegs& R) {
    const bf16* Q = m.gla ? F.GQ : F.RQ; const bf16* K = m.gla ? F.GK : F.RK; const bf16* V = m.gla ? F.GV : F.RV; const bf16* GT = m.gla ? F.GG : F.RG;
    const int jq = F.tid >> 3, dq = (F.tid & 7) * 8;
    R.q8 = __builtin_nontemporal_load((const GAS v4u*)(Q + (m.t0 + jq) * 256 + m.h * 64 + dq));
    R.k8 = __builtin_nontemporal_load((const GAS v4u*)(K + (m.t0 + jq) * 256 + m.h * 64 + dq));
#pragma unroll
    for (int i = 0; i < 2; ++i) { const int p = F.tid + 512 * i; R.v8[i] = __builtin_nontemporal_load((const GAS v4u*)(V + (m.t0 + (p >> 4)) * 512 + m.h * 128 + (p & 15) * 8)); }
#pragma unroll
    for (int i = 0; i < 2; ++i) R.p8[i] = __builtin_nontemporal_load((const GAS v4u*)((const bf16*)F.ST + (size_t)m.item * 8192) + F.tid + 512 * i);
#pragma unroll
    for (int i = 0; i < 2; ++i) R.gt[i] = __builtin_nontemporal_load((const GAS v4u*)(GT + (m.t0 + jq) * 512 + m.h * 128 + (F.tid & 7) * 8 + 64 * i));
    if (m.gla) { const GAS f32x4* gr = (const GAS f32x4*)(F.GLR + (m.t0 + F.lane) * 16); R.g[0] = gr[0]; R.g[1] = gr[1]; R.g[2] = gr[2]; R.g[3] = gr[3];
        const GAS f32x4* cp = (const GAS f32x4*)(F.DEC + (size_t)m.item * 64 + (F.tid & 7) * 8); R.cd[0] = cp[0]; R.cd[1] = cp[1]; }
}
__device__ __forceinline__ void mixer_out_pre(Frame& F, int vb, MixOutRegs& R) {
    LAS float* NP = (LAS float*)(F.lds + MX_NP);
    mixer_stage_gate(F, (vb >> 4) & 3);
    if (F.tid < 384) { const int hh = (vb >> 4) & 3, e_ = F.tid & 127; NP[F.tid] = F.tid < 128 ? F.gla_g[e_] : F.tid < 256 ? F.ret_g[hh * 128 + e_] : F.ret_b[hh * 128 + e_]; }
    mixer_out_load(F, mix_item(vb, 0), R);
}
__device__ __forceinline__ void mixer_out_phase(Frame& F, MixOutRegs& R, const bool pre) {
    const int fr = F.lane & 15, fq = F.lane >> 4, w = F.wave;
    LAS bf16* QE = (LAS bf16*)(F.lds + MX_QE); LAS bf16* QN = (LAS bf16*)(F.lds + MX_QN); LAS bf16* KE = (LAS bf16*)(F.lds + MX_KE); LAS bf16* KN = (LAS bf16*)(F.lds + MX_KN);
    LAS bf16* VT = (LAS bf16*)(F.lds + MX_VT); LAS bf16* PT = (LAS bf16*)(F.lds + MX_PT); LAS bf16* P = (LAS bf16*)(F.lds + X_GTAB);
    LAS float* B = (LAS float*)(F.lds + MX_B); LAS float* RED = (LAS float*)(F.lds + MX_RED); LAS float* OUT = (LAS float*)(F.lds + MX_OUT); LAS float* NP = (LAS float*)(F.lds + MX_NP);
    const int jq = F.tid >> 3, dq = (F.tid & 7) * 8;
#define MO_SEL(MSK, A, B) __builtin_bit_cast(float, (__builtin_bit_cast(unsigned, (A)) & (MSK)) | (__builtin_bit_cast(unsigned, (B)) & ~(MSK)))
#define MO_STAGE1(GLA, KC) do { const unsigned gm_ = (GLA) ? 0xffffffffu : 0u; const float rc_ = fexp2(64.0f * (float)(KC) * l2gb); \
        float cd_[8]; _Pragma("unroll") for (int x = 0; x < 8; ++x) { const float cg_ = (x < 4) ? R.cd[0][x & 3] : R.cd[1][x & 3]; cd_[x] = MO_SEL(gm_, cg_, rc_); } \
        _Pragma("unroll") for (int i_ = 0; i_ < 2; ++i_) { const int idx_ = F.tid + 512 * i_, e_ = idx_ >> 3, d_ = (idx_ & 7) * 8; const v4u l_ = R.p8[i_]; float v_[8]; \
            v_[0] = bflo(l_.x); v_[1] = bfhi(l_.x); v_[2] = bflo(l_.y); v_[3] = bfhi(l_.y); v_[4] = bflo(l_.z); v_[5] = bfhi(l_.z); v_[6] = bflo(l_.w); v_[7] = bfhi(l_.w); \
            { const v4u sg_ = sinG[i_], sr_ = sinR[i_]; const unsigned w0_ = (sg_.x & gm_) | (sr_.x & ~gm_), w1_ = (sg_.y & gm_) | (sr_.y & ~gm_), w2_ = (sg_.z & gm_) | (sr_.z & ~gm_), w3_ = (sg_.w & gm_) | (sr_.w & ~gm_); \
              v_[0] += cd_[0] * bflo(w0_); v_[1] += cd_[1] * bfhi(w0_); v_[2] += cd_[2] * bflo(w1_); v_[3] += cd_[3] * bfhi(w1_); \
              v_[4] += cd_[4] * bflo(w2_); v_[5] += cd_[5] * bfhi(w2_); v_[6] += cd_[6] * bflo(w3_); v_[7] += cd_[7] * bfhi(w3_); }     \
            *(LAS v4u*)(PT + e_ * MS + d_) = (v4u){pk2(v_[0], v_[1]), pk2(v_[2], v_[3]), pk2(v_[4], v_[5]), pk2(v_[6], v_[7])}; } \
        if (GLA) mixer_bcum(F, R.g); mixer_vt_write(F, R.v8); } while (0)
#define MO_IMAGES(GLA) do { const v4u q8_ = R.q8, k8_ = R.k8; \
        if (GLA) { float qf[8], kf[8], eb[8], en[8]; \
            _Pragma("unroll") for (int x = 0; x < 8; ++x) { const unsigned wq = (x < 2 ? q8_.x : x < 4 ? q8_.y : x < 6 ? q8_.z : q8_.w), wk = (x < 2 ? k8_.x : x < 4 ? k8_.y : x < 6 ? k8_.z : k8_.w); \
                qf[x] = (x & 1) ? bfhi(wq) : bflo(wq); kf[x] = (x & 1) ? bfhi(wk) : bflo(wk); const float bv = B[jq * 65 + dq + x]; eb[x] = fexp2(bv); en[x] = fexp2(-bv); } \
            *(LAS v4u*)(QE + jq * MS + dq) = (v4u){pk2(qf[0] * eb[0], qf[1] * eb[1]), pk2(qf[2] * eb[2], qf[3] * eb[3]), pk2(qf[4] * eb[4], qf[5] * eb[5]), pk2(qf[6] * eb[6], qf[7] * eb[7])}; \
            *(LAS v4u*)(QN + jq * MS + dq) = (v4u){pk2(qf[0] * en[0], qf[1] * en[1]), pk2(qf[2] * en[2], qf[3] * en[3]), pk2(qf[4] * en[4], qf[5] * en[5]), pk2(qf[6] * en[6], qf[7] * en[7])}; \
            *(LAS v4u*)(KE + jq * MS + dq) = (v4u){pk2(kf[0] * eb[0], kf[1] * eb[1]), pk2(kf[2] * eb[2], kf[3] * eb[3]), pk2(kf[4] * eb[4], kf[5] * eb[5]), pk2(kf[6] * eb[6], kf[7] * eb[7])}; \
            *(LAS v4u*)(KN + jq * MS + dq) = (v4u){pk2(kf[0] * en[0], kf[1] * en[1]), pk2(kf[2] * en[2], kf[3] * en[3]), pk2(kf[4] * en[4], kf[5] * en[5]), pk2(kf[6] * en[6], kf[7] * en[7])}; \
        } else { *(LAS v4u*)(QE + jq * MS + dq) = q8_; *(LAS v4u*)(KN + jq * MS + dq) = k8_; } } while (0)
    for (int vb = F.vcu; vb < 256; vb += F.G) {
        if (!(pre && vb == F.vcu)) { __syncthreads(); mixer_out_pre(F, vb, R); }
        const float l2gb = log2_gamma((vb >> 4) & 3);
        v4u sinG[2], sinR[2];
        { const int b_ = vb >> 6, h_ = (vb >> 4) & 3, cg_ = vb & 15; const size_t gG = (size_t)((b_ * 8 + h_) * 16 + cg_), gR = (size_t)((b_ * 8 + 4 + h_) * 16 + cg_);
#pragma unroll
            for (int i = 0; i < 2; ++i) { const int idx = F.tid + 512 * i, e = idx >> 3, d = (idx & 7) * 8;
                sinG[i] = *(const GAS v4u*)(F.SIN + gG * 8192 + e * 64 + d); sinR[i] = *(const GAS v4u*)(F.SIN + gR * 8192 + e * 64 + d); } }
        __syncthreads();
        v4u gc0, gc1, gn0, gn1;
        { const MixItem m0 = mix_item(vb, 0); MO_STAGE1(m0.gla, 0); gc0 = R.gt[0]; gc1 = R.gt[1]; gn0 = gc0; gn1 = gc1;
            __syncthreads();
            MO_IMAGES(m0.gla); mixer_out_load(F, mix_item(vb, 1), R);
            __syncthreads(); }
        for (int k = 0; k < 16; ++k) { const MixItem m = mix_item(vb, k); const bool gla = m.gla; const int h = m.h;
            const float l2g = log2_gamma(h);
            { const int mi = w >> 1; f32x4 lo[2], up[2];
                bf16x8 aE[2], bN[2][2];
#pragma unroll
                for (int ks = 0; ks < 2; ++ks) { aE[ks] = *(const LAS bf16x8*)(QE + (16 * mi + fr) * MS + 32 * ks + 8 * fq);
#pragma unroll
                    for (int t = 0; t < 2; ++t) bN[t][ks] = *(const LAS bf16x8*)(KN + (16 * ((w & 1) * 2 + t) + fr) * MS + 32 * ks + 8 * fq); }
                if (gla) { bf16x8 aN[2], bE[2][2];
#pragma unroll
                    for (int ks = 0; ks < 2; ++ks) { aN[ks] = *(const LAS bf16x8*)(QN + (16 * mi + fr) * MS + 32 * ks + 8 * fq);
#pragma unroll
                        for (int t = 0; t < 2; ++t) bE[t][ks] = *(const LAS bf16x8*)(KE + (16 * ((w & 1) * 2 + t) + fr) * MS + 32 * ks + 8 * fq); }
#pragma unroll
                    for (int t = 0; t < 2; ++t) { lo[t] = (f32x4){0.f, 0.f, 0.f, 0.f}; up[t] = (f32x4){0.f, 0.f, 0.f, 0.f};
#pragma unroll
                        for (int ks = 0; ks < 2; ++ks) { lo[t] = __builtin_amdgcn_mfma_f32_16x16x32_bf16(aE[ks], bN[t][ks], lo[t], 0, 0, 0); up[t] = __builtin_amdgcn_mfma_f32_16x16x32_bf16(aN[ks], bE[t][ks], up[t], 0, 0, 0); } }
#pragma unroll
                    for (int t = 0; t < 2; ++t)
#pragma unroll
                        for (int r = 0; r < 4; ++r) { const int i = 16 * mi + 4 * fq + r, j = 16 * ((w & 1) * 2 + t) + fr; P[i * MS + j] = (bf16)f2bf((i >= j) ? lo[t][r] : up[t][r]); }
                } else {
#pragma unroll
                    for (int t = 0; t < 2; ++t) { lo[t] = (f32x4){0.f, 0.f, 0.f, 0.f};
#pragma unroll
                        for (int ks = 0; ks < 2; ++ks) lo[t] = __builtin_amdgcn_mfma_f32_16x16x32_bf16(aE[ks], bN[t][ks], lo[t], 0, 0, 0); }
#pragma unroll
                    for (int t = 0; t < 2; ++t)
#pragma unroll
                        for (int r = 0; r < 4; ++r) { const int i = 16 * mi + 4 * fq + r, j = 16 * ((w & 1) * 2 + t) + fr; P[i * MS + j] = (bf16)f2bf(lo[t][r] * fexp2((float)(i >= j ? i - j : j - i) * l2g)); }
                } }
            __syncthreads();
            const int mi = w & 3, nt0 = (w >> 2) * 4;
            f32x4 oi[4], oe[4];
#pragma unroll
            for (int t = 0; t < 4; ++t) { oi[t] = (f32x4){0.f, 0.f, 0.f, 0.f}; oe[t] = (f32x4){0.f, 0.f, 0.f, 0.f}; }
#pragma unroll
            for (int ks = 0; ks < 2; ++ks) { const int ao = (16 * mi + fr) * MS + 32 * ks + 8 * fq; const bf16x8 aP = *(const LAS bf16x8*)(P + ao), aQ = *(const LAS bf16x8*)(QE + ao);
#pragma unroll
                for (int t = 0; t < 4; ++t) { const int bo = (16 * (nt0 + t) + fr) * MS + 32 * ks + 8 * fq;
                    oi[t] = __builtin_amdgcn_mfma_f32_16x16x32_bf16(aP, *(const LAS bf16x8*)(VT + tsw(16 * (nt0 + t) + fr, 32 * ks + 8 * fq)), oi[t], 0, 0, 0);
                    oe[t] = __builtin_amdgcn_mfma_f32_16x16x32_bf16(aQ, *(const LAS bf16x8*)(PT + bo), oe[t], 0, 0, 0); } }
#pragma unroll
            for (int r = 0; r < 4; ++r) { const int i = 16 * mi + 4 * fq + r; const float rs = gla ? 1.0f : fexp2((float)(i + 1) * l2g);
#pragma unroll
                for (int t = 0; t < 4; ++t) OUT[i * OUTS + 16 * (nt0 + t) + fr] = oi[t][r] + rs * oe[t][r]; }
            __syncthreads();
            if (k < 15) { const MixItem mn = mix_item(vb, k + 1); MO_STAGE1(mn.gla, (k + 1) >> 1); gn0 = R.gt[0]; gn1 = R.gt[1]; }
            { const int e0 = (F.tid & 7) * 8; const LAS f32x4* op = (const LAS f32x4*)(OUT + jq * OUTS + e0); float val[16];
#pragma unroll
                for (int x4 = 0; x4 < 4; ++x4) { const f32x4 o = op[(x4 & 1) + 16 * (x4 >> 1)]; val[4 * x4] = o.x; val[4 * x4 + 1] = o.y; val[4 * x4 + 2] = o.z; val[4 * x4 + 3] = o.w; }
                float s1 = 0.f, s2 = 0.f;
#pragma unroll
                for (int x = 0; x < 16; ++x) { s1 += val[x]; s2 += val[x] * val[x]; }
                s1 += dppf<0xB1>(s1); s1 += dppf<0x4E>(s1); s1 += dppf<0x141>(s1);
                s2 += dppf<0xB1>(s2); s2 += dppf<0x4E>(s2); s2 += dppf<0x141>(s2);
                const float mu = gla ? 0.f : s1 * (1.f / 128.f); const float var = s2 * (1.f / 128.f) - mu * mu; const float rstd = 1.0f / sqrtf(var + LN_EPS);
                const LAS f32x4* gp4 = (const LAS f32x4*)(NP + (gla ? 0 : 128) + e0); const LAS f32x4* bp4 = (const LAS f32x4*)(NP + 256 + e0);
#pragma unroll
                for (int x4 = 0; x4 < 4; ++x4) { const f32x4 gq = gp4[(x4 & 1) + 16 * (x4 >> 1)]; f32x4 bq = bp4[(x4 & 1) + 16 * (x4 >> 1)]; if (gla) bq = (f32x4){0.f, 0.f, 0.f, 0.f};
#pragma unroll
                    for (int c = 0; c < 4; ++c) val[4 * x4 + c] = (val[4 * x4 + c] - mu) * rstd * gq[c] + bq[c]; }
#pragma unroll
                for (int x = 0; x < 16; ++x) { const v4u gv = x < 8 ? gc0 : gc1; const int xx = x & 7; const unsigned wg = (xx < 2 ? gv.x : xx < 4 ? gv.y : xx < 6 ? gv.z : gv.w); const float g = (xx & 1) ? bfhi(wg) : bflo(wg);
                    val[x] *= g * __builtin_amdgcn_rcpf(1.0f + fexp2(-g * LOG2E)); }
                typedef unsigned u32x2_t __attribute__((ext_vector_type(2)));
                const u32x2_t o0 = {pk4_fp8(val[0] * QS_M, val[1] * QS_M, val[2] * QS_M, val[3] * QS_M), pk4_fp8(val[4] * QS_M, val[5] * QS_M, val[6] * QS_M, val[7] * QS_M)};
                const u32x2_t o1 = {pk4_fp8(val[8] * QS_M, val[9] * QS_M, val[10] * QS_M, val[11] * QS_M), pk4_fp8(val[12] * QS_M, val[13] * QS_M, val[14] * QS_M, val[15] * QS_M)};
                GAS unsigned char* dst = (GAS unsigned char*)F.MIXED + (m.t0 + jq) * D + m.h8 * 128 + e0; *(GAS u32x2_t*)dst = o0; *(GAS u32x2_t*)(dst + 64) = o1; }
            __syncthreads();
            if (k < 15) { const MixItem mn = mix_item(vb, k + 1); MO_IMAGES(mn.gla); if (k < 14) mixer_out_load(F, mix_item(vb, k + 2), R); }
            gc0 = gn0; gc1 = gn1;
            __syncthreads();
        }
    }
#undef MO_STAGE1
#undef MO_SEL
#undef MO_IMAGES
}

__device__ __forceinline__ void p6_stage(Frame& F) {
    LAS bf16* WB = (LAS bf16*)(F.lds + RING_OFF);
    f32x4 rw[16];
#pragma unroll
    for (int u = 0; u < 16; ++u) rw[u] = *((const GAS f32x4*)F.router_w + F.tid + 512 * u);
#pragma unroll
    for (int u = 0; u < 16; ++u) { const int idx = F.tid + 512 * u; const int c = idx >> 3, ch = idx & 7; const f32x4 wv = rw[u];
#pragma unroll
        for (int x = 0; x < 4; ++x) { const int e = 4 * ch + x; const float w = wv[x]; const unsigned hi = f2bf(w); const float rem = w - bf2f(hi);
            const int off = e * 2048 + ((((c >> 3) ^ (e & 15)) << 3) | (c & 7)); WB[off] = (bf16)hi; WB[off + 1024] = (bf16)f2bf(rem); } }
    LAS float* LNP = (LAS float*)(F.lds + X_GTAB);
    for (int i = F.tid; i < 2 * D; i += 512) LNP[i] = i < D ? F.ln1_g[i] : F.ln1_b[i - D];
}
__device__ __forceinline__ void p6_ln1_route(Frame& F) {
    LAS bf16* WB = (LAS bf16*)(F.lds + RING_OFF); LAS float* LNP = (LAS float*)(F.lds + X_GTAB);
    LAS unsigned* lcnt = (LAS unsigned*)(F.lds + X_LCNT); LAS unsigned* lbase = (LAS unsigned*)(F.lds + X_LBASE); LAS unsigned* nasg = (LAS unsigned*)(F.lds + X_NASG); LAS unsigned* asg = (LAS unsigned*)(F.lds + X_ASG);
    const int gw = F.vcu * NWAVES + F.wave, NGW = F.G * NWAVES, lane = F.lane, r16 = lane & 15, cq = lane >> 4;
    const float rb0 = F.router_b[r16], rb1 = F.router_b[16 + r16];
    for (int base = 0; base < M / 16; base += NGW) {
        if (F.tid < 32) lcnt[F.tid] = 0u; if (F.tid == 32) nasg[0] = 0u;
        __syncthreads();
        const int tile = base + gw;
        if (tile < M / 16) {
            const int row = 16 * tile + r16;
            const bf16* xrow = (const bf16*)F.PRE1 + (size_t)row * D + 8 * cq;
            float sum = 0.f, sq = 0.f;
#pragma unroll 8
            for (int s = 0; s < 32; ++s) { const v4u x = *(const GAS v4u*)(xrow + 32 * s);
                const float f0 = bflo(x.x), f1 = bfhi(x.x), f2 = bflo(x.y), f3 = bfhi(x.y), f4 = bflo(x.z), f5 = bfhi(x.z), f6 = bflo(x.w), f7 = bfhi(x.w);
                sum += ((f0 + f1) + (f2 + f3)) + ((f4 + f5) + (f6 + f7)); sq += ((f0 * f0 + f1 * f1) + (f2 * f2 + f3 * f3)) + ((f4 * f4 + f5 * f5) + (f6 * f6 + f7 * f7)); }
            sum += __shfl_xor(sum, 16); sum += __shfl_xor(sum, 32); sq += __shfl_xor(sq, 16); sq += __shfl_xor(sq, 32);
            const float mean = sum * (1.f / D); const float rstd = 1.0f / sqrtf(fmaxf(sq * (1.f / D) - mean * mean, 0.f) + LN_EPS);
            f32x4 acc[2]; acc[0] = (f32x4){0.f, 0.f, 0.f, 0.f}; acc[1] = (f32x4){0.f, 0.f, 0.f, 0.f};
            int bt[2][4];
#pragma unroll
            for (int nt = 0; nt < 2; ++nt)
#pragma unroll
                for (int j = 0; j < 4; ++j) bt[nt][j] = (16 * nt + r16) * 2048 + (((4 * j + cq) ^ r16) << 3);
            GAS unsigned char* hq = (GAS unsigned char*)F.H1B + (size_t)row * D + 8 * cq;
            for (int s4 = 0; s4 < 8; ++s4) {
#pragma unroll
                for (int j = 0; j < 4; ++j) { const int s = 4 * s4 + j, c0 = 32 * s + 8 * cq; const v4u x = *(const GAS v4u*)(xrow + 32 * s);
                    const f32x4 ga = *(const LAS f32x4*)(LNP + c0), gb = *(const LAS f32x4*)(LNP + c0 + 4), ba = *(const LAS f32x4*)(LNP + D + c0), bb = *(const LAS f32x4*)(LNP + D + c0 + 4);
                    float h[8];
                    h[0] = (bflo(x.x) - mean) * rstd * ga[0] + ba[0]; h[1] = (bfhi(x.x) - mean) * rstd * ga[1] + ba[1]; h[2] = (bflo(x.y) - mean) * rstd * ga[2] + ba[2]; h[3] = (bfhi(x.y) - mean) * rstd * ga[3] + ba[3];
                    h[4] = (bflo(x.z) - mean) * rstd * gb[0] + bb[0]; h[5] = (bfhi(x.z) - mean) * rstd * gb[1] + bb[1]; h[6] = (bflo(x.w) - mean) * rstd * gb[2] + bb[2]; h[7] = (bfhi(x.w) - mean) * rstd * gb[3] + bb[3];
                    typedef unsigned u32x2_t __attribute__((ext_vector_type(2)));
                    *(GAS u32x2_t*)(hq + 32 * s) = (u32x2_t){pk4_fp8(h[0] * QS_H1, h[1] * QS_H1, h[2] * QS_H1, h[3] * QS_H1), pk4_fp8(h[4] * QS_H1, h[5] * QS_H1, h[6] * QS_H1, h[7] * QS_H1)};
                    v4u ahi, alo;
                    ahi.x = pk2(h[0], h[1]); ahi.y = pk2(h[2], h[3]); ahi.z = pk2(h[4], h[5]); ahi.w = pk2(h[6], h[7]);
                    alo.x = pk2(h[0] - bflo(ahi.x), h[1] - bfhi(ahi.x)); alo.y = pk2(h[2] - bflo(ahi.y), h[3] - bfhi(ahi.y)); alo.z = pk2(h[4] - bflo(ahi.z), h[5] - bfhi(ahi.z)); alo.w = pk2(h[6] - bflo(ahi.w), h[7] - bfhi(ahi.w));
                    const bf16x8 Ah = __builtin_bit_cast(bf16x8, ahi), Al = __builtin_bit_cast(bf16x8, alo);
#pragma unroll
                    for (int nt = 0; nt < 2; ++nt) { const LAS bf16* wp = WB + bt[nt][j] + s4 * 128;
                        const bf16x8 Bh = *(const LAS bf16x8*)wp, Bl = *(const LAS bf16x8*)(wp + 1024);
                        acc[nt] = __builtin_amdgcn_mfma_f32_16x16x32_bf16(Ah, Bh, acc[nt], 0, 0, 0);
                        acc[nt] = __builtin_amdgcn_mfma_f32_16x16x32_bf16(Ah, Bl, acc[nt], 0, 0, 0);
                        acc[nt] = __builtin_amdgcn_mfma_f32_16x16x32_bf16(Al, Bh, acc[nt], 0, 0, 0); } } }
#pragma unroll
            for (int reg = 0; reg < 4; ++reg) { const int trow = 16 * tile + 4 * cq + reg;
                float a0 = acc[0][reg] + rb0, a1 = acc[1][reg] + rb1; float tv[4]; int ti[4];
#pragma unroll
                for (int k = 0; k < 4; ++k) { float mx; int idx; if (a1 > a0) { mx = a1; idx = 16 + r16; } else { mx = a0; idx = r16; }
#define P6_STEP(OM, OI) { const float om = (OM); const int oi = (OI); if (om > mx || (om == mx && oi < idx)) { mx = om; idx = oi; } }
                    P6_STEP(dppf<0xB1>(mx), dppi<0xB1>(idx)) P6_STEP(dppf<0x4E>(mx), dppi<0x4E>(idx)) P6_STEP(dppf<0x141>(mx), dppi<0x141>(idx)) P6_STEP(dppf<0x140>(mx), dppi<0x140>(idx))
#undef P6_STEP
                    tv[k] = mx; ti[k] = idx; if (idx == r16) a0 = -3.0e38f; if (idx == 16 + r16) a1 = -3.0e38f; }
                const float e1 = expf(tv[1] - tv[0]), e2 = expf(tv[2] - tv[0]), e3 = expf(tv[3] - tv[0]); const float inv = 1.f / (1.f + e1 + e2 + e3);
                if (r16 < 4) { const float gk = (r16 == 0 ? 1.f : r16 == 1 ? e1 : r16 == 2 ? e2 : e3) * inv; const int ek = (r16 == 0 ? ti[0] : r16 == 1 ? ti[1] : r16 == 2 ? ti[2] : ti[3]);
                    const unsigned tk = (unsigned)(trow * 4 + r16);
                    const unsigned lp = __hip_atomic_fetch_add(lcnt + ek, 1u, __ATOMIC_RELAXED, __HIP_MEMORY_SCOPE_WORKGROUP); const unsigned sl = __hip_atomic_fetch_add(nasg, 1u, __ATOMIC_RELAXED, __HIP_MEMORY_SCOPE_WORKGROUP);
                    asg[sl] = tk | ((unsigned)ek << 17) | (lp << 22); asg[512 + sl] = __builtin_bit_cast(unsigned, gk); } }
        }
        __syncthreads();
        if (F.tid < 32) { const unsigned n = lcnt[F.tid]; lbase[F.tid] = n ? __hip_atomic_fetch_add(F.counts + 64 * F.tid, n, __ATOMIC_RELAXED, __HIP_MEMORY_SCOPE_AGENT) : 0u; }
        __syncthreads();
        const unsigned na = nasg[0];
        for (unsigned i = F.tid; i < na; i += 512) { const unsigned a = asg[i]; const unsigned tk = a & 0x1ffffu, e = (a >> 17) & 31u, lp = a >> 22; const size_t o = (size_t)e * M + lbase[e] + lp; F.list[o] = (int)tk; F.slotg[o] = __builtin_bit_cast(float, asg[512 + i]); F.tkslot[tk] = (int)((e << 20) | (lbase[e] + lp)); }
        __syncthreads();
    }
}
__device__ __forceinline__ int moe_tables(Frame& F) {
    LAS int* cnt = (LAS int*)(F.lds + X_CNT); LAS int* ts = (LAS int*)(F.lds + X_TSTART);
    __syncthreads();
    if (F.tid < 32) cnt[F.tid] = (int)__hip_atomic_load(F.counts + 64 * F.tid, __ATOMIC_RELAXED, __HIP_MEMORY_SCOPE_AGENT);
    __syncthreads();
    if (F.tid <= 32) { int a = 0;
#pragma unroll
        for (int k = 0; k < 32; ++k) a += (k < F.tid) ? ((cnt[k] + 255) >> 8) : 0;
        ts[F.tid] = a; }
    __syncthreads();
    static_assert(X_ASG - X_TSTART == 4 * pg8::ETAB_OFF, "expert table offset");
    for (int pm = F.tid; pm < ts[32]; pm += 512) { int e = 0;
#pragma unroll
        for (int k = 1; k < 32; ++k) e += (pm >= ts[k]) ? 1 : 0;
        ts[pg8::ETAB_OFF + pm] = e; }
    __syncthreads();
    return __builtin_amdgcn_readfirstlane(ts[32]);
}
typedef int p10_i32x4 __attribute__((ext_vector_type(4)));
struct P10Params { f32x4 g4[4], b4[4], g1[4], b1[4]; p10_i32x4 ns0, ns1; };
__device__ __forceinline__ void p10_params(Frame& F, P10Params& P) {
    const int lane = F.lane; const int cb = ((lane >> 1) & 1) * 128 + (lane >> 4) * 32 + ((lane >> 2) & 3) * 8 + 4 * (lane & 1);
#pragma unroll
    for (int j = 0; j < 4; ++j) { P.g4[j] = *(const GAS f32x4*)(F.ln2_g + 256 * j + cb); P.b4[j] = *(const GAS f32x4*)(F.ln2_b + 256 * j + cb);
        P.g1[j] = *(const GAS f32x4*)(F.ln1_g + 256 * j + cb); P.b1[j] = *(const GAS f32x4*)(F.ln1_b + 256 * j + cb); }
    const int gw = F.vcu * NWAVES + F.wave, NGW = F.G * NWAVES;
    P.ns0 = (gw < M) ? *((const GAS p10_i32x4*)F.tkslot + gw) : (p10_i32x4){0, 0, 0, 0};
    P.ns1 = (gw + NGW < M) ? *((const GAS p10_i32x4*)F.tkslot + gw + NGW) : (p10_i32x4){0, 0, 0, 0};
}
__device__ __forceinline__ void p10_final(Frame& F, const P10Params& PP, const bool tables_in_lds) {
    if (!tables_in_lds) (void)moe_tables(F);
    const LAS int* ts = (const LAS int*)(F.lds + X_TSTART);
    const int gw = F.vcu * NWAVES + F.wave, NGW = F.G * NWAVES, lane = F.lane;
    typedef unsigned long long u64; typedef int i32x4v __attribute__((ext_vector_type(4))); typedef float f32x2v __attribute__((ext_vector_type(2)));
    const int cb = ((lane >> 1) & 1) * 128 + (lane >> 4) * 32 + ((lane >> 2) & 3) * 8 + 4 * (lane & 1);
    f32x4 g4[4], b4[4], g1[4], b1[4];
#pragma unroll
    for (int j = 0; j < 4; ++j) { g4[j] = PP.g4[j]; b4[j] = PP.b4[j]; g1[j] = PP.g1[j]; b1[j] = PP.b1[j]; }
    u64 nh[4]; unsigned ny[4][4]; i32x4v ns; int row = gw;
#define P10_SLOTS(R) do { ns = *((const GAS i32x4v*)F.tkslot + (R)); } while (0)
#define P10_LOAD(R) do { int sl_[4]; sl_[0] = ts[ns.x >> 20] * 256 + (ns.x & 0xfffff); sl_[1] = ts[ns.y >> 20] * 256 + (ns.y & 0xfffff); sl_[2] = ts[ns.z >> 20] * 256 + (ns.z & 0xfffff); sl_[3] = ts[ns.w >> 20] * 256 + (ns.w & 0xfffff); \
        _Pragma("unroll") for (int j = 0; j < 4; ++j) { nh[j] = __builtin_nontemporal_load((const GAS u64*)((const bf16*)F.PRE1 + (size_t)(R) * D + 256 * j + cb)); \
        _Pragma("unroll") for (int k = 0; k < 4; ++k) ny[j][k] = __builtin_nontemporal_load((const GAS unsigned*)((const GAS unsigned char*)F.Y + (size_t)sl_[k] * D) + lane + 64 * j); } } while (0)
    if (row < M) { ns = PP.ns0; P10_LOAD(row); if (row + NGW < M) ns = PP.ns1; }
    for (; row < M; row += NGW) {
        f32x4 v[4], y[4]; float s = 0.f;
#pragma unroll
        for (int j = 0; j < 4; ++j) { const unsigned lo = (unsigned)nh[j], hi = (unsigned)(nh[j] >> 32);
            v[j] = (f32x4){__builtin_bit_cast(float, lo << 16), __builtin_bit_cast(float, lo & 0xffff0000u), __builtin_bit_cast(float, hi << 16), __builtin_bit_cast(float, hi & 0xffff0000u)};
            s += (v[j].x + v[j].y) + (v[j].z + v[j].w);
            y[j] = (f32x4){0.f, 0.f, 0.f, 0.f};
#pragma unroll
            for (int k = 0; k < 4; ++k) { const f32x2v p0 = __builtin_amdgcn_cvt_pk_f32_fp8((int)ny[j][k], false), p1 = __builtin_amdgcn_cvt_pk_f32_fp8((int)ny[j][k], true);
                y[j].x += p0.x; y[j].y += p0.y; y[j].z += p1.x; y[j].w += p1.y; } }
        if (row + NGW < M) { P10_LOAD(row + NGW); if (row + 2 * NGW < M) P10_SLOTS(row + 2 * NGW); }
        const float mean1 = wave_sum(s) * (1.f / D); float q1 = 0.f;
#pragma unroll
        for (int j = 0; j < 4; ++j) { v[j] = v[j] - mean1; q1 += (v[j].x * v[j].x + v[j].y * v[j].y) + (v[j].z * v[j].z + v[j].w * v[j].w); }
        const float rstd1 = 1.f / sqrtf(wave_sum(q1) * (1.f / D) + LN_EPS);
        float s2 = 0.f;
#pragma unroll
        for (int j = 0; j < 4; ++j) { v[j] = (v[j] * rstd1 * g1[j] + b1[j]) * ALPHA + y[j] * (1.0f / QS_Y); s2 += (v[j].x + v[j].y) + (v[j].z + v[j].w); }
        const float mean = wave_sum(s2) * (1.f / D); float q2 = 0.f;
#pragma unroll
        for (int j = 0; j < 4; ++j) { v[j] = v[j] - mean; q2 += (v[j].x * v[j].x + v[j].y * v[j].y) + (v[j].z * v[j].z + v[j].w * v[j].w); }
        const float rstd = 1.f / sqrtf(wave_sum(q2) * (1.f / D) + LN_EPS);
        float* hr = F.out + (size_t)row * D + cb;
#pragma unroll
        for (int j = 0; j < 4; ++j) __builtin_nontemporal_store(v[j] * rstd * g4[j] + b4[j], (GAS f32x4*)(hr + 256 * j));
    }
#undef P10_LOAD
#undef P10_SLOTS
}

__device__ __forceinline__ void p9_gate_table(Frame& F, const pg8::GroupedOrder& S) {
    { LAS float* gt = (LAS float*)(F.lds + X_GTAB); const LAS int* cntl = (const LAS int*)(F.lds + X_CNT);
            float gv[(GT_MAXU + 1) / 2]; bool ok[(GT_MAXU + 1) / 2];
#pragma unroll
            for (int j = 0; j < (GT_MAXU + 1) / 2; ++j) { const int i = 2 * j + (F.tid >> 8); pg8::Unit u; gv[j] = 0.f; ok[j] = i < GT_MAXU && S.next(i, u);
                if (ok[j]) { const int lr = u.lt * 256 + (F.tid & 255); if (lr < cntl[u.e]) gv[j] = F.slotg[(size_t)u.e * M + lr]; } }
#pragma unroll
            for (int j = 0; j < (GT_MAXU + 1) / 2; ++j) { const int i = 2 * j + (F.tid >> 8); if (ok[j]) gt[i * 256 + (F.tid & 255)] = gv[j]; } }
}
struct Args { const void* in[21]; float* out; unsigned char* ws; int ph_lo, ph_hi; };
__global__ void __launch_bounds__(NWAVES * 64, 2) fwd_kernel(Args args) {
    extern __shared__ __attribute__((aligned(16))) unsigned char lds[];
    Frame F;
    F.lds = (LAS unsigned char*)lds;
    F.MISC = (volatile LAS unsigned*)(F.lds + MISC_OFF);
    F.tid = threadIdx.x; F.lane = F.tid & 63; F.wave = __builtin_amdgcn_readfirstlane(F.tid >> 6);
    F.G = gridDim.x; { const int bx = blockIdx.x; F.vcu = (F.G % 8 == 0) ? (bx % 8) * (F.G / 8) + bx / 8 : bx; }
    unsigned char* ws = args.ws;
    F.ctl = (gu32*)(ws + WS_CTL);
    F.x = (const float*)args.in[0]; F.positions = (const int*)args.in[1]; F.ln_in_g = (const float*)args.in[2]; F.ln_in_b = (const float*)args.in[3];
    F.w_in = (const float*)args.in[4]; F.gate_w = (const float*)args.in[5]; F.gate_b = (const float*)args.in[6]; F.gla_g = (const float*)args.in[7];
    F.ret_g = (const float*)args.in[8]; F.ret_b = (const float*)args.in[9]; F.w_out = (const float*)args.in[10]; F.ln1_g = (const float*)args.in[11]; F.ln1_b = (const float*)args.in[12];
    F.router_w = (const float*)args.in[13]; F.router_b = (const float*)args.in[14]; F.w1 = (const float*)args.in[15]; F.b1 = (const float*)args.in[16];
    F.w2 = (const float*)args.in[17]; F.b2 = (const float*)args.in[18]; F.ln2_g = (const float*)args.in[19]; F.ln2_b = (const float*)args.in[20];
    F.out = args.out;
    F.stats0 = (float*)(ws + WS_STATS0); F.cosT = (float*)(ws + WS_COS); F.sinT = (float*)(ws + WS_SIN); F.ST = (float*)(ws + WS_ST); F.DEC = (float*)(ws + WS_DEC); F.PRE1 = (float*)(ws + WS_PRE1);
    F.AGG = (float*)(ws + WS_AGG); F.SIN = (bf16*)(ws + WS_SINS); F.DAGG = (float*)(ws + WS_DAGG); F.GLR = (float*)(ws + WS_PROJ + PJ_GLR); F.gates = (float*)(ws + WS_GATES);
    F.WinT = (bf16*)(ws + WS_WINT); F.WoT = (bf16*)(ws + WS_WOT); F.W1T = (bf16*)(ws + WS_W1T); F.W2T = (bf16*)(ws + WS_W2T); F.H0B = (bf16*)(ws + WS_H0B); F.MIXED = (bf16*)(ws + WS_MIXED);
    F.GQ = (bf16*)(ws + WS_PROJ + PJ_GQ); F.GK = (bf16*)(ws + WS_PROJ + PJ_GK); F.GV = (bf16*)(ws + WS_PROJ + PJ_GV); F.GG = (bf16*)(ws + WS_PROJ + PJ_GG);
    F.RQ = (bf16*)(ws + WS_PROJ + PJ_RQ); F.RK = (bf16*)(ws + WS_PROJ + PJ_RK); F.RV = (bf16*)(ws + WS_PROJ + PJ_RV); F.RG = (bf16*)(ws + WS_PROJ + PJ_RG);
    F.H1B = (bf16*)(ws + WS_H1B); F.XS = (bf16*)(ws + WS_XS); F.ACT = (bf16*)(ws + WS_ACT); F.Y = (bf16*)(ws + WS_Y);
    F.list = (int*)(ws + WS_LIST); F.slotg = (float*)(ws + WS_SLOTG); F.tkslot = (int*)(ws + WS_GATES); F.counts = (unsigned*)(ws + WS_CTL) + CW_COUNTS;
    for (int u = F.tid; u < (LDS_BYTES - LDSCTL_OFF) / 4; u += NWAVES * 64) ((LAS unsigned*)(F.lds + LDSCTL_OFF))[u] = 0u;
    __syncthreads();
    const int lo = args.ph_lo, hi = args.ph_hi;
    const bool multi = (hi - lo) > 1;
    XcdBarrier bar; bar.bar = (unsigned*)(F.ctl + CW_BAR); bar.x = 0; bar.st = nullptr;
    if (multi) bar = xcd_barrier_post((unsigned*)(F.ctl + CW_BAR), F.MISC + 8);
#define IN(k) (lo <= (k) && (k) < hi)
#define SEAM(k) do { if (IN(k) && (IN((k) + 1) || ((k) == 6 && IN(8)))) xcd_barrier(bar); } while (0)
#define SEAM_WITH(k, WORK) do { if (IN(k) && IN((k) + 1)) XCD_BARRIER_WITH(bar, F.wave, WORK); } while (0)

    if (IN(0)) { p0_prologue(F); SEAM(0); }
    if (IN(1)) { {
        pg8::Gemm g{F.H0B, F.WinT, M, NPROJ_T * 256, D, nullptr}; pg8::StaticOrder S; S.init(M, NPROJ_T * 256, F.G, (int)blockIdx.x);
        pg8::EpiProj E{F.GQ, F.GK, F.GV, F.GG, F.RQ, F.RK, F.RV, F.RG, F.GLR, F.cosT, F.sinT};
        pg8::gemm_phase<pg8::EpiProj, pg8::StaticOrder, true, true>(F.lds + RING_OFF, g, S, E); }
        SEAM(1);
    }
    if (IN(2)) { mixer_kv_phase(F); SEAM(2); }
    MixOutRegs R4; bool pre4 = false; P10Params P10;
    if (IN(3)) { mixer_scan(F); pre4 = IN(4) && F.vcu < 256; SEAM_WITH(3, if (pre4) mixer_out_pre(F, F.vcu, R4)); }
    if (IN(4)) { mixer_out_phase(F, R4, pre4); SEAM(4); }
    if (IN(5)) { {
        pg8::Gemm g{F.MIXED, F.WoT, M, D, D, nullptr}; pg8::StaticOrder S; S.init(M, D, F.G, (int)blockIdx.x);
        pg8::EpiOutProj E{F.H0B, (bf16*)F.PRE1, ALPHA, 1.0f / (QS_M * QS_W)};
        pg8::gemm_phase<pg8::EpiOutProj, pg8::StaticOrder, true, true, 1>(F.lds + RING_OFF, g, S, E); }
        SEAM_WITH(5, p6_stage(F));
    }
    if (IN(6)) { if (!IN(5)) { p6_stage(F); } p6_ln1_route(F); SEAM(6); }
    if (IN(8)) {
        const int ntiles = moe_tables(F);
        pg8::GroupedOrder S; S.init(ntiles, 8, F.G, (int)blockIdx.x, (const LAS int*)(F.lds + X_TSTART));
        { LAS unsigned* gtab = (LAS unsigned*)(F.lds + X_GTAB); const LAS int* cntl = (const LAS int*)(F.lds + X_CNT);
            int tok[(GT_MAXU + 1) / 2];
#pragma unroll
            for (int j = 0; j < (GT_MAXU + 1) / 2; ++j) { const int i = 2 * j + (F.tid >> 8); pg8::Unit u; tok[j] = -1;
                if (i < GT_MAXU && S.next(i, u)) { const int lr = u.lt * 256 + (F.tid & 255); tok[j] = (lr < cntl[u.e]) ? (F.list[(size_t)u.e * M + lr] >> 2) : 0; } }
#pragma unroll
            for (int j = 0; j < (GT_MAXU + 1) / 2; ++j) { const int i = 2 * j + (F.tid >> 8); if (tok[j] >= 0) gtab[i * 256 + (F.tid & 255)] = (unsigned)tok[j] * (unsigned)D; }
            __syncthreads(); }
        pg8::Gemm g{F.H1B, F.W1T, M, 2 * DFF, D, (const LAS unsigned*)(F.lds + X_GTAB)};
        pg8::EpiSwiGLU E{(unsigned char*)F.ACT, F.b1, 1.0f / (QS_H1 * QS_W)};
        pg8::gemm_phase<pg8::EpiSwiGLU, pg8::GroupedOrder, true, true, 1, true>(F.lds + RING_OFF, g, S, E);
        { pg8::GroupedOrder S2; S2.init(ntiles, 4, F.G, (int)blockIdx.x, (const LAS int*)(F.lds + X_TSTART)); SEAM_WITH(8, p9_gate_table(F, S2)); }
    }
    if (IN(9)) { {
        const int ntiles = IN(8) ? __builtin_amdgcn_readfirstlane(((const LAS int*)(F.lds + X_TSTART))[32]) : moe_tables(F);
        pg8::Gemm g{F.ACT, F.W2T, ntiles * 256, D, DFF, nullptr}; pg8::GroupedOrder S; S.init(ntiles, 4, F.G, (int)blockIdx.x, (const LAS int*)(F.lds + X_TSTART));
        if (!IN(8)) { p9_gate_table(F, S); __syncthreads(); }
        pg8::EpiMoeOut E{(unsigned char*)F.Y, F.b2, (const LAS float*)(F.lds + X_GTAB), 1.0f / (QS_ACT * QS_W)};
        pg8::gemm_phase<pg8::EpiMoeOut, pg8::GroupedOrder, true, true, 1>(F.lds + RING_OFF, g, S, E); }
        SEAM_WITH(9, p10_params(F, P10));
    }
    if (IN(10)) { if (!IN(9)) p10_params(F, P10); p10_final(F, P10, IN(8) || IN(9)); }
#undef IN
#undef SEAM
}

extern "C" void kernel_launch(void* const* d_in, const int* in_sizes, int n_in, void* d_out, int out_size, void* d_ws, size_t ws_size, hipStream_t stream) {
    static int grid = 0;
    if (grid == 0) {
        if (n_in != 21 || out_size != M * D || ws_size < WS_END) { fprintf(stderr, "kernel_launch: unexpected problem (n_in %d, out %d, ws %zu)\n", n_in, out_size, ws_size); grid = -1; return; }
        int dev = 0, cus = 0;
        if (hipGetDevice(&dev) != hipSuccess || hipDeviceGetAttribute(&cus, hipDeviceAttributeMultiprocessorCount, dev) != hipSuccess) { grid = -1; return; }
        if (hipFuncSetAttribute((const void*)fwd_kernel, hipFuncAttributeMaxDynamicSharedMemorySize, LDS_BYTES) != hipSuccess) { fprintf(stderr, "kernel_launch: hipFuncSetAttribute failed\n"); grid = -1; return; }
        (void)hipGetLastError();
        grid = cus;
    }
    if (grid < 0) return;
    if (hipMemsetAsync((char*)d_ws + WS_CTL, 0, CTL_ZERO_BYTES, stream) != hipSuccess) return;
    Args a{};
    for (int i = 0; i < 21; ++i) a.in[i] = d_in[i];
    a.out = (float*)d_out; a.ws = (unsigned char*)d_ws;
    constexpr int NL = MK_N_LAUNCHES;
    for (int li = 0; li < NL; ++li) {
        a.ph_lo = (NL == 1) ? 0 : li; a.ph_hi = (NL == 1) ? NPH : li + 1;
        hipLaunchKernelGGL(fwd_kernel, dim3(grid), dim3(NWAVES * 64), LDS_BYTES, stream, a);
    }
}
```
